# Optimizing an MI355X kernel written in HIP

```python
import jax, jax.numpy as jnp
from jax import lax
import numpy as np

D_MODEL = 1024
BATCH = 2
SEQ = 8192
DEPTH = 1

HEAD_DIM = 64
A_Q_HEADS = 8
A_KV_HEADS = 2
B_Q_HEADS = 8
B_KV_HEADS = 2
A_Q = A_Q_HEADS * HEAD_DIM
A_KV = A_KV_HEADS * HEAD_DIM
B_Q = B_Q_HEADS * HEAD_DIM
B_KV = B_KV_HEADS * HEAD_DIM
IN_COLS = A_Q + 2 * A_KV + B_Q + 2 * B_KV + 2 * D_MODEL
Q_BLOCK = 128
WINDOW = 128
GRID_W = 64
ROPE_THETA = 10000.0
N_EXPERTS = 32
TOP_K = 4
D_FF = 1024
SWIGLU_LIMIT = 7.0
SWIGLU_ALPHA = 1.702
MOE_BLOCK = 128
EPS = 1e-6
NEG_INF = -1e30

kernel_name = "hybrid_gated_gqa_window_sink_moe_encoder"


def rmsnorm(x, g):
    xf = x.astype(jnp.float32)
    y = xf * lax.rsqrt(jnp.mean(xf * xf, axis=-1, keepdims=True) + EPS)
    return (y * g.astype(jnp.float32)).astype(x.dtype)


def rope_rotate(x, cos, sin):
    half = x.shape[-1] // 2
    xf = x.astype(jnp.float32)
    x1, x2 = xf[..., :half], xf[..., half:]
    c = cos[:, None, :]
    s = sin[:, None, :]
    return jnp.concatenate([x1 * c - x2 * s, x2 * c + x1 * s], axis=-1).astype(x.dtype)


def rope_1d_tables(seq):
    pos = jnp.arange(seq, dtype=jnp.float32)
    inv = ROPE_THETA ** (-jnp.arange(0, HEAD_DIM, 2, dtype=jnp.float32) / HEAD_DIM)
    ang = pos[:, None] * inv[None, :]
    return jnp.cos(ang), jnp.sin(ang)


def rope_axial_tables(seq):
    rows = seq // GRID_W
    row = jnp.broadcast_to(jnp.arange(rows, dtype=jnp.float32)[:, None], (rows, GRID_W)).reshape(-1)
    col = jnp.broadcast_to(jnp.arange(GRID_W, dtype=jnp.float32)[None, :], (rows, GRID_W)).reshape(-1)
    axis_dim = HEAD_DIM // 2
    inv = ROPE_THETA ** (-jnp.arange(0, axis_dim, 2, dtype=jnp.float32) / axis_dim)
    ang = jnp.concatenate([row[:, None] * inv[None, :], col[:, None] * inv[None, :]], axis=-1)
    return jnp.cos(ang), jnp.sin(ang)


def global_axial_gqa(q, k, v, q_gain, k_gain, cos, sin):
    bsz, seq = q.shape[0], q.shape[1]
    q = rope_rotate(rmsnorm(q, q_gain), cos, sin)
    k = rope_rotate(rmsnorm(k, k_gain), cos, sin)
    groups = A_Q_HEADS // A_KV_HEADS
    nb = seq // Q_BLOCK
    scale = HEAD_DIM ** -0.5
    qb = q.reshape(bsz, nb, Q_BLOCK, A_KV_HEADS, groups, HEAD_DIM).transpose(1, 0, 2, 3, 4, 5)

    def one_block(qblk):
        s = jnp.einsum('bqkgd,bskd->bkgqs', qblk, k, preferred_element_type=jnp.float32) * scale
        p = jax.nn.softmax(s, axis=-1).astype(v.dtype)
        return jnp.einsum('bkgqs,bskd->bqkgd', p, v)

    o = lax.map(one_block, qb)
    return o.transpose(1, 0, 2, 3, 4, 5).reshape(bsz, seq, A_Q)


def window_sink_gqa(q, k, v, sink, cos, sin):
    bsz, seq = q.shape[0], q.shape[1]
    q = rope_rotate(q, cos, sin)
    k = rope_rotate(k, cos, sin)
    groups = B_Q_HEADS // B_KV_HEADS
    nb = seq // Q_BLOCK
    span = Q_BLOCK + 2 * WINDOW
    scale = HEAD_DIM ** -0.5
    qb = q.reshape(bsz, nb, Q_BLOCK, B_KV_HEADS, groups, HEAD_DIM)
    pad = ((0, 0), (WINDOW, WINDOW), (0, 0), (0, 0))
    kpad = jnp.pad(k, pad)
    vpad = jnp.pad(v, pad)
    kidx = jnp.arange(nb)[:, None] * Q_BLOCK + jnp.arange(span)[None, :]
    kwin = kpad[:, kidx]
    vwin = vpad[:, kidx]
    n = jnp.arange(nb)[:, None, None]
    qpos = n * Q_BLOCK + jnp.arange(Q_BLOCK)[None, :, None]
    kpos = n * Q_BLOCK - WINDOW + jnp.arange(span)[None, None, :]
    mask = (jnp.abs(kpos - qpos) <= WINDOW) & (kpos >= 0) & (kpos < seq)
    s = jnp.einsum('bnqkgd,bnjkd->bnkgqj', qb, kwin, preferred_element_type=jnp.float32) * scale
    s = jnp.where(mask[None, :, None, None], s, NEG_INF)
    sink_logit = jnp.broadcast_to(
        sink.astype(jnp.float32).reshape(1, 1, B_KV_HEADS, groups, 1, 1), s.shape[:-1] + (1,))
    p = jax.nn.softmax(jnp.concatenate([s, sink_logit], axis=-1), axis=-1)[..., :-1]
    o = jnp.einsum('bnkgqj,bnjkd->bnqkgd', p.astype(v.dtype), vwin)
    return o.reshape(bsz, seq, B_Q)


def clamped_swiglu(gu):
    gate, up = gu[..., :D_FF], gu[..., D_FF:]
    gate = jnp.minimum(gate, SWIGLU_LIMIT)
    up = jnp.clip(up, -SWIGLU_LIMIT, SWIGLU_LIMIT)
    return (up + 1.0) * (gate * jax.nn.sigmoid(SWIGLU_ALPHA * gate))


def moe(h, w_router, b_router, w_gate_up, b_gate_up, w_down, b_down):
    bsz, seq, d = h.shape
    T = bsz * seq
    hf = h.reshape(T, d)
    logits = jnp.einsum('td,de->te', hf, w_router, preferred_element_type=jnp.float32) \
        + b_router.astype(jnp.float32)
    top_vals, top_idx = lax.top_k(logits, TOP_K)
    gate = jax.nn.softmax(top_vals, axis=-1)
    A = T * TOP_K
    e_flat = top_idx.reshape(A)
    tok_flat = jnp.arange(A, dtype=jnp.int32) // TOP_K
    g_flat = gate.reshape(A)
    order = jnp.argsort(e_flat, stable=True)
    e_sorted = e_flat[order]
    counts = jnp.bincount(e_flat, length=N_EXPERTS)
    padded = (counts + MOE_BLOCK - 1) // MOE_BLOCK * MOE_BLOCK
    ends_p = jnp.cumsum(padded)
    starts_p = ends_p - padded
    starts = jnp.cumsum(counts) - counts
    rank = jnp.arange(A, dtype=jnp.int32) - starts[e_sorted]
    dest = starts_p[e_sorted] + rank
    n_blocks = -(-A // MOE_BLOCK) + N_EXPERTS
    R = n_blocks * MOE_BLOCK
    row_tok = jnp.full((R,), T, jnp.int32).at[dest].set(tok_flat[order])
    row_gate = jnp.zeros((R,), jnp.float32).at[dest].set(g_flat[order])
    block_exp = jnp.minimum(
        jnp.searchsorted(ends_p, jnp.arange(n_blocks) * MOE_BLOCK, side='right'), N_EXPERTS - 1)
    h_pad = jnp.concatenate([hf, jnp.zeros((1, d), hf.dtype)], axis=0)
    xs = h_pad[row_tok].reshape(n_blocks, MOE_BLOCK, d)

    def run_block(args):
        xb, e = args
        gu = xb @ w_gate_up[e] + b_gate_up[e]
        return clamped_swiglu(gu) @ w_down[e] + b_down[e]

    ys = lax.map(run_block, (xs, block_exp)).reshape(R, d)
    ys = ys.astype(jnp.float32) * row_gate[:, None]
    out = jax.ops.segment_sum(ys, row_tok, num_segments=T + 1)[:T]
    return out.astype(h.dtype).reshape(bsz, seq, d)


def setup_inputs(seed: int = 0) -> dict:
    key = jax.random.key(seed)
    ks = jax.random.split(key, 20)
    f32 = jnp.float32
    nrm = lambda k, shape: jax.random.normal(k, shape, dtype=f32)
    L, D, E, F = DEPTH, D_MODEL, N_EXPERTS, D_FF
    return {
        "x": nrm(ks[0], (BATCH, SEQ, D)),
        "g_mix": 1.0 + 0.02 * nrm(ks[1], (L, D)),
        "w_in": nrm(ks[2], (L, D, IN_COLS)) * D ** -0.5,
        "qa_norm": 1.0 + 0.02 * nrm(ks[3], (L, HEAD_DIM)),
        "ka_norm": 1.0 + 0.02 * nrm(ks[4], (L, HEAD_DIM)),
        "sink_b": 0.5 * nrm(ks[5], (L, B_Q_HEADS)),
        "w_branch_a": nrm(ks[6], (L, A_Q, D)) * A_Q ** -0.5,
        "w_branch_b": nrm(ks[7], (L, B_Q, D)) * B_Q ** -0.5,
        "w_out": nrm(ks[8], (L, D, D)) * D ** -0.5,
        "g_ffn": 1.0 + 0.02 * nrm(ks[9], (L, D)),
        "w_router": nrm(ks[10], (L, D, E)) * D ** -0.5,
        "b_router": 0.01 * nrm(ks[11], (L, E)),
        "w_gate_up": nrm(ks[12], (L, E, D, 2 * F)) * D ** -0.5,
        "b_gate_up": 0.01 * nrm(ks[13], (L, E, 2 * F)),
        "w_down": nrm(ks[14], (L, E, F, D)) * F ** -0.5,
        "b_down": 0.01 * nrm(ks[15], (L, E, D)),
        "g_final": 1.0 + 0.02 * nrm(ks[16], (D,)),
    }


def reference(x, g_mix, w_in, qa_norm, ka_norm, sink_b, w_branch_a, w_branch_b, w_out,
              g_ffn, w_router, b_router, w_gate_up, b_gate_up, w_down, b_down, g_final):
    bsz, seq, _ = x.shape
    cos_ax, sin_ax = rope_axial_tables(seq)
    cos_1d, sin_1d = rope_1d_tables(seq)
    splits = np.cumsum([A_Q, A_KV, A_KV, B_Q, B_KV, B_KV, D_MODEL]).tolist()
    for l in range(DEPTH):
        h = rmsnorm(x, g_mix[l])
        proj = h @ w_in[l]
        qa, ka, va, qb, kb, vb, gate_a, gate_b = jnp.split(proj, splits, axis=-1)
        qa = qa.reshape(bsz, seq, A_Q_HEADS, HEAD_DIM)
        ka = ka.reshape(bsz, seq, A_KV_HEADS, HEAD_DIM)
        va = va.reshape(bsz, seq, A_KV_HEADS, HEAD_DIM)
        qb = qb.reshape(bsz, seq, B_Q_HEADS, HEAD_DIM)
        kb = kb.reshape(bsz, seq, B_KV_HEADS, HEAD_DIM)
        vb = vb.reshape(bsz, seq, B_KV_HEADS, HEAD_DIM)
        oa = global_axial_gqa(qa, ka, va, qa_norm[l], ka_norm[l], cos_ax, sin_ax)
        ob = window_sink_gqa(qb, kb, vb, sink_b[l], cos_1d, sin_1d)
        merged = jax.nn.sigmoid(gate_a) * (oa @ w_branch_a[l]) \
            + jax.nn.sigmoid(gate_b) * (ob @ w_branch_b[l])
        x = x + merged @ w_out[l]
        h2 = rmsnorm(x, g_ffn[l])
        x = x + moe(h2, w_router[l], b_router[l], w_gate_up[l], b_gate_up[l], w_down[l], b_down[l])
    return rmsnorm(x, g_final)
```

```cpp
#include <hip/hip_runtime.h>
#include <hip/hip_bf16.h>
#include <cstdio>
#include <cstdint>
#include <cmath>

#ifndef MK_N_LAUNCHES
#define MK_N_LAUNCHES 1
#endif

constexpr int BATCH = 2, SEQ = 8192, DM = 1024, MTOK = BATCH * SEQ;
constexpr int HD = 64, NQH = 8, NKVH = 2, QW = NQH * HD  , KVW = NKVH * HD  ;
constexpr int IN_COLS = 3584, NEXP = 32, TOPK = 4, DFF = 1024;
constexpr int NSLOT_ASSIGN = MTOK * TOPK;
constexpr int ACT_ROWS = NSLOT_ASSIGN + NEXP * 256;
constexpr float EPS = 1e-6f;
constexpr float C2 = 0.125f * 1.4426950408889634f;

#define LAS __attribute__((address_space(3)))
#define GAS __attribute__((address_space(1)))
typedef unsigned short bf16_t;
typedef short bf16x8 __attribute__((ext_vector_type(8)));
typedef float f32x4 __attribute__((ext_vector_type(4)));
typedef float f32x2 __attribute__((ext_vector_type(2)));
typedef unsigned u32x4 __attribute__((ext_vector_type(4)));
typedef unsigned u32x2 __attribute__((ext_vector_type(2)));
typedef int i32x8 __attribute__((ext_vector_type(8)));
typedef int i32x4 __attribute__((ext_vector_type(4)));
typedef i32x8 i32x8_a16 __attribute__((aligned(16)));
__device__ __forceinline__ unsigned pk4_fp8(float a, float b, float c, float d) { int w = 0; w = __builtin_amdgcn_cvt_pk_fp8_f32(a, b, w, false); w = __builtin_amdgcn_cvt_pk_fp8_f32(c, d, w, true); return (unsigned)w; }

__device__ __forceinline__ unsigned f2bf(float f) { unsigned u = __builtin_bit_cast(unsigned, f); return (u + 0x7fffu + ((u >> 16) & 1u)) >> 16; }
typedef __bf16 bf16x2_hw __attribute__((ext_vector_type(2)));
__device__ __forceinline__ unsigned pk2(float lo, float hi) { f32x2 v = {lo, hi}; bf16x2_hw b = __builtin_convertvector(v, bf16x2_hw); return __builtin_bit_cast(unsigned, b); }
__device__ __forceinline__ float bf2f(unsigned short b) { return __builtin_bit_cast(float, (unsigned)b << 16); }
__device__ __forceinline__ float bflo(unsigned w) { return __builtin_bit_cast(float, w << 16); }
__device__ __forceinline__ float bfhi(unsigned w) { return __builtin_bit_cast(float, w & 0xffff0000u); }
constexpr float SWI_C = -1.702f * 1.4426950408889634f;
__device__ __forceinline__ float sigmoidf_(float v) { return __builtin_amdgcn_rcpf(1.0f + __builtin_amdgcn_exp2f(v * -1.4426950408889634f)); }
__device__ __forceinline__ int lane_fresh() { int l; asm volatile("v_mbcnt_lo_u32_b32 %0, -1, 0\n\tv_mbcnt_hi_u32_b32 %0, -1, %0" : "=v"(l)); return l; }
template <int CTRL> __device__ __forceinline__ float dpp_f(float v) { return __builtin_bit_cast(float, __builtin_amdgcn_update_dpp(0, __builtin_bit_cast(int, v), CTRL, 0xf, 0xf, true)); }
__device__ __forceinline__ float row_sum16(float v) { v += dpp_f<0xB1>(v); v += dpp_f<0x4E>(v); v += dpp_f<0x141>(v); v += dpp_f<0x140>(v); return v; }
__device__ __forceinline__ float row_max16(float v) { v = fmaxf(v, dpp_f<0xB1>(v)); v = fmaxf(v, dpp_f<0x4E>(v)); v = fmaxf(v, dpp_f<0x141>(v)); v = fmaxf(v, dpp_f<0x140>(v)); return v; }
__device__ __forceinline__ float swap16_sum(float v) { const auto r = __builtin_amdgcn_permlane16_swap(__float_as_uint(v), __float_as_uint(v), false, false); return __uint_as_float(r[0]) + __uint_as_float(r[1]); }
__device__ __forceinline__ float swap32_sum(float v) { const auto r = __builtin_amdgcn_permlane32_swap(__float_as_uint(v), __float_as_uint(v), false, false); return __uint_as_float(r[0]) + __uint_as_float(r[1]); }
__device__ __forceinline__ float swap16_max(float v) { const auto r = __builtin_amdgcn_permlane16_swap(__float_as_uint(v), __float_as_uint(v), false, false); return fmaxf(__uint_as_float(r[0]), __uint_as_float(r[1])); }
__device__ __forceinline__ float swap32_max(float v) { const auto r = __builtin_amdgcn_permlane32_swap(__float_as_uint(v), __float_as_uint(v), false, false); return fmaxf(__uint_as_float(r[0]), __uint_as_float(r[1])); }
__device__ __forceinline__ float wave_sum(float v) { return swap32_sum(swap16_sum(row_sum16(v))); }
__device__ __forceinline__ float wave_max(float v) { return swap32_max(swap16_max(row_max16(v))); }

namespace pg8 {
constexpr int BM = 256, BK = 64, HALF = 128, HTB = HALF * BK * 2, STAGE_BYTES = 8 * HTB, NXCD = 8, WGM = 8;
__host__ __device__ __forceinline__ int lds_byte(int r, int c) { const int st = (r >> 4) * 2 + (c >> 5), rr = r & 15, cc = c & 31, ob = rr * 64 + cc * 2; return st * 1024 + (ob ^ (((ob >> 9) & 1) << 5)); }
__host__ __device__ __forceinline__ void stage_rc(int b, int& R, int& C) { const int st = b / 1024, sb = b % 1024, swz = sb ^ (((sb >> 9) & 1) << 5); R = (st >> 1) * 16 + swz / 64; C = (st & 1) * 32 + (swz % 64) / 2; }
__host__ __device__ __forceinline__ int perm32(int rho) { const int n = rho >> 4, i = rho & 15; return 8 * (i >> 2) + 4 * n + (i & 3); }

struct Unit { int pm, pn, e, pml; };

struct StaticOrder {
    int nM, nN, nwg, G, c;
    __device__ void init(int M, int N, int G_, int c_) { nM = M / BM; nN = N / BM; nwg = nM * nN; G = G_; c = c_; }
    __device__ bool next(int i, Unit& u) const {
        const long L = (long)i * G + c; if (L >= nwg) return false;
        int wgid = (int)L; { const int q = nwg / NXCD, r = nwg % NXCD, xcd = wgid % NXCD, off = wgid / NXCD; wgid = (xcd < r ? xcd * (q + 1) : r * (q + 1) + (xcd - r) * q) + off; }
        const int nig = WGM * nN, gid = wgid / nig, fm = gid * WGM, gsz = (nM - fm) < WGM ? (nM - fm) : WGM;
        u.pm = fm + ((wgid % nig) % gsz); u.pn = (wgid % nig) / gsz; u.e = 0; u.pml = u.pm; return true;
    }
    __device__ __forceinline__ unsigned a_rowoff(const Unit&, int) const { return 0u; }
    static constexpr bool LAZY = false;
    __device__ __forceinline__ void prefetch(int) const {}
};

struct PairOrder {
    StaticOrder so; int nM;
    static constexpr bool LAZY = false;
    __device__ void init(int M, int N, int G, int c) { so.init(M, N, G, c); nM = M / BM; }
    __device__ bool next(int i, Unit& u) const { if (i >= 2 || !so.next(0, u)) return false; u.e = i; u.pml = u.pm; u.pm = u.pm + i * nM; return true; }
    __device__ __forceinline__ void prefetch(int) const {}
    __device__ __forceinline__ unsigned a_rowoff(const Unit&, int) const { return 0u; }
};

struct TicketOrder {
    StaticOrder so; unsigned* ctr; volatile LAS int* slot; int x, cpx, wave;
    static constexpr bool LAZY = true;
    __device__ void init(int M, int N, int G, int vcu, unsigned* ctr_base, volatile LAS int* slot_, int wave_) { wave = wave_; so.init(M, N, G, 0); cpx = (G % 8 == 0) ? G / 8 : G; x = vcu / cpx; ctr = ctr_base + 64 * x; slot = slot_; }
    __device__ __forceinline__ void prefetch(int i) const { if (wave == 0 && lane_fresh() == 0) { const int t = (int)__hip_atomic_fetch_add(ctr, 1u, __ATOMIC_RELAXED, __HIP_MEMORY_SCOPE_AGENT); slot[i & 1] = t; } }
    __device__ bool next(int i, Unit& u) const {
        const int t = slot[i & 1]; StaticOrder s2 = so; s2.c = 8 * (t % cpx) + x; if (so.G % 8 != 0) s2.c = t % cpx;
        return s2.next(t / cpx, u);
    }
    __device__ __forceinline__ unsigned a_rowoff(const Unit&, int) const { return 0u; }
};

struct MoeOrder {
    const LAS int* pre; const LAS int* cnt; const u32x2* list; int npn, lo, hi, j, cpx; unsigned rowbytes;
    __device__ void init(const LAS int* pre_, const LAS int* cnt_, const u32x2* list_, int npn_, int G, int vcu) {
        pre = pre_; cnt = cnt_; list = list_; npn = npn_; rowbytes = (unsigned)DM;
        const int U = pre[NEXP] * npn; cpx = (G % 8 == 0) ? G / 8 : G; const int nx = G / cpx, x = vcu / cpx; j = vcu % cpx;
        lo = (int)((long)U * x / nx); hi = (int)((long)U * (x + 1) / nx);
    }
    __device__ bool next(int i, Unit& u) const {
        const int L = lo + j + cpx * i; if (L >= hi) return false;
        const int tr = L / npn; u.pn = L % npn; int e = 0;
#pragma unroll
        for (int st = NEXP / 2; st > 0; st >>= 1) { if (pre[e + st] <= tr) e += st; }
        u.e = e; u.pm = tr; u.pml = tr - pre[e]; return true;
    }
    static constexpr bool LAZY = false;
    __device__ __forceinline__ void prefetch(int) const {}
    __device__ __forceinline__ unsigned a_rowoff(const Unit& u, int R) const {
        const int idx = u.pml * BM + R; const int ic = idx < cnt[u.e] ? idx : 0;
        const int slot = (int)list[u.e * MTOK + ic].x;
        return (unsigned)(slot >> 2) * rowbytes;
    }
};

template <class Epi, class Sched, bool ALIGN_EPI, bool SP2, bool GATHER, bool F8 = false>
__device__ __forceinline__ void gemm_phase(LAS unsigned char* lds, const void* Aptr, const void* Btptr, const int K, const int NBT, const Sched& S, const Epi& E, const int wave_, const int scla_ = 0x7f7f7f7f) {
    const int wid = wave_, lane = lane_fresh(), tid = wid * 64 + lane, wr = wid >> 2, wc = wid & 3, fr = lane & 15, fq = lane >> 4;
    constexpr int EB = F8 ? 1 : 2; const int nt = K * EB / (BK * 2);
    unsigned voffA[2], voffB[2]; int R0, C0;
#pragma unroll
    for (int i = 0; i < 2; ++i) { const int R = 8 * wid + 64 * i + (lane >> 3), cl = (lane & 7) ^ ((R >> 1) & 7); const int Rb = Epi::PERM ? ((R & ~31) + perm32(R & 31)) : R;
        voffA[i] = (unsigned)(R * K * EB + cl * 16); voffB[i] = (unsigned)(Rb * K * EB + cl * 16); if (i == 0) { R0 = R; C0 = cl * 8; } }
    const size_t kstep = (size_t)(BK * 2);
    const size_t hstep = (size_t)HALF * K * EB;
    const size_t tstep = 2 * hstep;
    const unsigned ldsw = (unsigned)wid * 1024u;
    const int sw_ = (fr >> 1) & 7; int aoffk[2], boffk[2];
#pragma unroll
    for (int k = 0; k < 2; ++k) { aoffk[k] = (wr * 64 + fr) * 128 + (((fq + 4 * k) ^ sw_) << 4); boffk[k] = (wc * 32 + fr) * 128 + (((fq + 4 * k) ^ sw_) << 4); }
    unsigned gc[2][2], gn[2][2];
#define PG8_SA(b, h) (((b) * 2 + (h)) * HTB)
#define PG8_SB(b, h) ((4 + (b) * 2 + (h)) * HTB)
#define PG8_GLDS(src, dstoff) __builtin_amdgcn_global_load_lds((const unsigned*)(src), (LAS unsigned*)(lds + (dstoff)), 16, 0, 0)
#define PG8_STAGE(bufoff, gbase, voff) do { _Pragma("unroll") for (int _i = 0; _i < 2; ++_i) PG8_GLDS((const char*)(gbase) + (voff)[_i], (bufoff) + ldsw + _i * 8192); } while (0)
#define PG8_STAGE_A(bufoff, kbase, h, usen) do { if constexpr (GATHER) { _Pragma("unroll") for (int _i = 0; _i < 2; ++_i) { const unsigned _o = (usen) ? gn[h][_i] : gc[h][_i]; PG8_GLDS((const char*)(kbase) + _o, (bufoff) + ldsw + _i * 8192); } } \
        else { PG8_STAGE(bufoff, (const char*)(kbase) + (h) * hstep, voffA); } } while (0)
#define PG8_GOFFS(g, u) do { _Pragma("unroll") for (int _h = 0; _h < 2; ++_h) _Pragma("unroll") for (int _i = 0; _i < 2; ++_i) g[_h][_i] = S.a_rowoff(u, _h * HALF + R0 + 64 * _i) + (unsigned)(C0 * 2); } while (0)
#define PG8_LDA8(dst, b, h) do { _Pragma("unroll") for (int m = 0; m < 4; ++m) { const i32x4 _lo = *(const LAS i32x4*)(lds + PG8_SA(b, h) + aoffk[0] + m * 2048), _hi = *(const LAS i32x4*)(lds + PG8_SA(b, h) + aoffk[1] + m * 2048); dst[m] = (i32x8){_lo.x, _lo.y, _lo.z, _lo.w, _hi.x, _hi.y, _hi.z, _hi.w}; } } while (0)
#define PG8_LDB8(dst, b, h) do { _Pragma("unroll") for (int n = 0; n < 2; ++n) { const i32x4 _lo = *(const LAS i32x4*)(lds + PG8_SB(b, h) + boffk[0] + n * 2048), _hi = *(const LAS i32x4*)(lds + PG8_SB(b, h) + boffk[1] + n * 2048); dst[n] = (i32x8){_lo.x, _lo.y, _lo.z, _lo.w, _hi.x, _hi.y, _hi.z, _hi.w}; } } while (0)
#define PG8_MMA8(ai, bj, At, Bt) do { __builtin_amdgcn_s_setprio(1); _Pragma("unroll") for (int m = 0; m < 4; ++m) _Pragma("unroll") for (int n = 0; n < 2; ++n) \
        asm volatile("v_mfma_scale_f32_16x16x128_f8f6f4 %0, %1, %2, %0, %3, %4 op_sel_hi:[0,0,0]" : "+v"(acc[ai][bj][m][n]) : "v"(Bt[n]), "v"(At[m]), "v"(sclw), "v"(scla)); __builtin_amdgcn_s_setprio(0); } while (0)
#define PG8_LDA(dst, b, h) do { _Pragma("unroll") for (int m = 0; m < 4; ++m) _Pragma("unroll") for (int k = 0; k < 2; ++k) dst[m][k] = *(const LAS bf16x8*)(lds + PG8_SA(b, h) + aoffk[k] + m * 2048); } while (0)
#define PG8_LDB(dst, b, h) do { _Pragma("unroll") for (int n = 0; n < 2; ++n) _Pragma("unroll") for (int k = 0; k < 2; ++k) dst[n][k] = *(const LAS bf16x8*)(lds + PG8_SB(b, h) + boffk[k] + n * 2048); } while (0)
#define PG8_MMA(ai, bj, At, Bt) do { __builtin_amdgcn_s_setprio(1); _Pragma("unroll") for (int m = 0; m < 4; ++m) _Pragma("unroll") for (int n = 0; n < 2; ++n) _Pragma("unroll") for (int k = 0; k < 2; ++k) \
        acc[ai][bj][m][n] = __builtin_amdgcn_mfma_f32_16x16x32_bf16(Bt[n][k], At[m][k], acc[ai][bj][m][n], 0, 0, 0); __builtin_amdgcn_s_setprio(0); } while (0)
#define PG8_WAIT_V(n) asm volatile("s_waitcnt vmcnt(" #n ")" ::: "memory")
#define PG8_WAIT_L(n) asm volatile("s_waitcnt lgkmcnt(" #n ")" ::: "memory")
#define PG8_BAR __builtin_amdgcn_s_barrier()
#define PG8_SCHED __builtin_amdgcn_sched_barrier(0)
    constexpr int ROWS_OFF = STAGE_BYTES + 6144;
    constexpr int PRE_OFF = STAGE_BYTES + 4096;
    Unit cur, nxt; int ui = 0;
    if constexpr (Sched::LAZY) { S.prefetch(0); asm volatile("s_waitcnt vmcnt(0) lgkmcnt(0)" ::: "memory"); __builtin_amdgcn_s_barrier(); asm volatile("" ::: "memory"); }
    if (!S.next(0, cur)) return;
    f32x4 acc[2][2][4][2];
#pragma unroll
    for (int a = 0; a < 2; ++a)
#pragma unroll
        for (int b = 0; b < 2; ++b)
#pragma unroll
            for (int m = 0; m < 4; ++m)
#pragma unroll
                for (int n = 0; n < 2; ++n) acc[a][b][m][n] = (f32x4){0.f, 0.f, 0.f, 0.f};
    bf16x8 At[4][2], B0[2][2], B1[2][2]; i32x8 At8[4], B08[2], B18[2];
    int sclw = 0x7a7a7a7a, scla = scla_; asm volatile("" : "+v"(sclw), "+v"(scla));
    const char* cA = GATHER ? (const char*)Aptr : (const char*)Aptr + (size_t)cur.pm * tstep;
    const char* cB = (const char*)Btptr + ((size_t)cur.e * NBT + cur.pn) * tstep;
    if constexpr (GATHER) { PG8_GOFFS(gc, cur); PG8_GOFFS(gn, cur); }
    if constexpr (Epi::HAS_PRE) { if (wid == 0) E.pre(cur, lds + PRE_OFF, lane); }
    static_assert(SP2, "only the SP2 loop is kept here");
    PG8_STAGE(PG8_SB(0, 0), cB, voffB); PG8_STAGE(PG8_SB(0, 1), cB + hstep, voffB); PG8_STAGE_A(PG8_SA(0, 0), cA, 0, false); PG8_STAGE_A(PG8_SA(0, 1), cA, 1, false);
    if (wr == 1) PG8_BAR;
    PG8_WAIT_V(2); PG8_BAR;
    PG8_STAGE(PG8_SB(1, 0), cB + kstep, voffB); PG8_STAGE_A(PG8_SA(1, 0), cA + kstep, 0, false); PG8_STAGE(PG8_SB(1, 1), cB + hstep + kstep, voffB);
    PG8_WAIT_V(6); PG8_BAR;
    if constexpr (Epi::HAS_PRE) E.init(acc, (const LAS float*)(lds + PRE_OFF), wc, fq);
    for (;;) {
        bool has_next = false; const char* nA = cA; const char* nB = cB;
        if constexpr (Epi::HAS_ROWS) E.rows(cur, lds + ROWS_OFF + (ui & 1) * 2048, wid, lane);
        if constexpr (Sched::LAZY) { S.prefetch(ui + 1); }
        else { has_next = S.next(ui + 1, nxt);
            nA = GATHER ? (const char*)Aptr : (has_next ? (const char*)Aptr + (size_t)nxt.pm * tstep : cA);
            nB = has_next ? (const char*)Btptr + ((size_t)nxt.e * NBT + nxt.pn) * tstep : cB;
            if constexpr (GATHER) { if (has_next) { PG8_GOFFS(gn, nxt); } }
            if constexpr (Epi::HAS_PRE) { if (has_next && wid == 0) E.pre(nxt, lds + PRE_OFF + ((ui + 1) & 1) * 1024, lane); } }
        for (int t = 0; t < nt; t += 2) {
            const bool last = (t == nt - 2);
            if constexpr (Sched::LAZY) { if (last) { has_next = S.next(ui + 1, nxt);
                nA = has_next ? (const char*)Aptr + (size_t)nxt.pm * tstep : cA; nB = has_next ? (const char*)Btptr + ((size_t)nxt.e * NBT + nxt.pn) * tstep : cB; } }
            const char* a1 = cA + (size_t)(t + 1) * kstep;
            const char* a2 = last ? nA : cA + (size_t)(t + 2) * kstep; const char* b2 = last ? nB : cB + (size_t)(t + 2) * kstep;
            const char* a3 = a2 + kstep; const char* b3 = b2 + kstep;
            const bool usen = last && has_next;
#define XLDB0(b, h) do { if constexpr (F8) { PG8_LDB8(B08, b, h); } else { PG8_LDB(B0, b, h); } } while (0)
#define XLDB1(b, h) do { if constexpr (F8) { PG8_LDB8(B18, b, h); } else { PG8_LDB(B1, b, h); } } while (0)
#define XLDA(b, h) do { if constexpr (F8) { PG8_LDA8(At8, b, h); } else { PG8_LDA(At, b, h); } } while (0)
#define XMMA0(ai) do { if constexpr (F8) { PG8_MMA8(ai, 0, At8, B08); } else { PG8_MMA(ai, 0, At, B0); } } while (0)
#define XMMA1(ai) do { if constexpr (F8) { PG8_MMA8(ai, 1, At8, B18); } else { PG8_MMA(ai, 1, At, B1); } } while (0)
            XLDB0(0, 0); XLDB1(0, 1); PG8_SCHED; XLDA(0, 0); PG8_STAGE_A(PG8_SA(1, 1), a1, 1, false);
            PG8_WAIT_V(8); PG8_WAIT_L(0); PG8_BAR; XMMA0(0); XMMA1(0); PG8_BAR; PG8_SCHED;
            XLDA(0, 1); PG8_STAGE(PG8_SB(0, 0), b2, voffB); PG8_STAGE(PG8_SB(0, 1), b2 + hstep, voffB); PG8_STAGE_A(PG8_SA(0, 0), a2, 0, usen);
            PG8_WAIT_V(8); PG8_WAIT_L(0); PG8_BAR; XMMA0(1); XMMA1(1); PG8_BAR; PG8_SCHED;
            XLDB0(1, 0); XLDB1(1, 1); PG8_SCHED; XLDA(1, 0); PG8_STAGE_A(PG8_SA(0, 1), a2, 1, usen);
            PG8_WAIT_V(8); PG8_WAIT_L(0); PG8_BAR; XMMA0(0); XMMA1(0); PG8_BAR; PG8_SCHED;
            XLDA(1, 1); PG8_STAGE(PG8_SB(1, 0), b3, voffB); PG8_STAGE(PG8_SB(1, 1), b3 + hstep, voffB); PG8_STAGE_A(PG8_SA(1, 0), a3, 0, usen);
            PG8_WAIT_V(8); PG8_WAIT_L(0); PG8_BAR; XMMA0(1); XMMA1(1); PG8_BAR; PG8_SCHED;
#undef XLDB0
#undef XLDB1
#undef XLDA
#undef XMMA0
#undef XMMA1
        }
        if constexpr (ALIGN_EPI) { if (wr == 0) PG8_BAR; }
        if constexpr (F8) asm volatile("s_nop 15\n\ts_nop 7" ::: "memory");
        if constexpr (Epi::HAS_ROWS) E(acc, cur, wr, wc, fr, fq, lds + ROWS_OFF + (ui & 1) * 2048); else E(acc, cur, wr, wc, fr, fq);
        if (!has_next) break;
        if constexpr (Epi::HAS_PRE) E.init(acc, (const LAS float*)(lds + PRE_OFF + ((ui + 1) & 1) * 1024), wc, fq);
        else if (!Epi::keeps(cur)) {
#pragma unroll
        for (int a = 0; a < 2; ++a)
#pragma unroll
            for (int b = 0; b < 2; ++b)
#pragma unroll
                for (int m = 0; m < 4; ++m)
#pragma unroll
                    for (int n = 0; n < 2; ++n) acc[a][b][m][n] = (f32x4){0.f, 0.f, 0.f, 0.f};
        }
        cur = nxt; cA = nA; cB = nB; ++ui;
        if constexpr (GATHER) {
#pragma unroll
            for (int h = 0; h < 2; ++h)
#pragma unroll
                for (int i = 0; i < 2; ++i) gc[h][i] = gn[h][i];
        }
        if constexpr (ALIGN_EPI) { if (wr == 1) PG8_BAR; }
    }
    PG8_WAIT_V(0);
    if constexpr (!ALIGN_EPI) { if (wr == 0) PG8_BAR; }
    PG8_BAR;
#undef PG8_SA
#undef PG8_SB
#undef PG8_GLDS
#undef PG8_STAGE
#undef PG8_STAGE_A
#undef PG8_GOFFS
#undef PG8_LDA
#undef PG8_LDA8
#undef PG8_LDB8
#undef PG8_MMA8
#undef PG8_LDB
#undef PG8_MMA
#undef PG8_WAIT_V
#undef PG8_WAIT_L
#undef PG8_BAR
#undef PG8_SCHED
}
}

__device__ __forceinline__ u32x4 swap16_pair(u32x2 x, u32x2 y) {
    const auto lo = __builtin_amdgcn_permlane16_swap(x.x, y.x, false, false);
    const auto hi = __builtin_amdgcn_permlane16_swap(x.y, y.y, false, false);
    u32x4 r; r.x = lo[0]; r.y = hi[0]; r.z = lo[1]; r.w = hi[1]; return r;
}

typedef f32x4 AccT[2][2][4][2];

struct EpiInProj {
    static constexpr bool PERM = true, HAS_PRE = false, HAS_ROWS = true;
    __device__ __forceinline__ static bool keeps(const pg8::Unit&) { return false; }
    const float* rstd; const float* qa_g; const float* ka_g; const unsigned* csA; const unsigned* csB;
    unsigned char *QA; bf16_t *KA, *VA; unsigned char *QB; bf16_t *KB, *VB; unsigned char *GA, *GB;
    __device__ __forceinline__ static void store16(bf16_t* rp, const f32x4 (&v)[2][2]) {
#pragma unroll
        for (int bj = 0; bj < 2; ++bj) { u32x4 w; w.x = pk2(v[bj][0][0], v[bj][0][1]); w.y = pk2(v[bj][0][2], v[bj][0][3]); w.z = pk2(v[bj][1][0], v[bj][1][1]); w.w = pk2(v[bj][1][2], v[bj][1][3]);
            *(u32x4*)(rp + 32 * bj) = w; }
    }
    __device__ __forceinline__ static void store_tile(bf16_t* buf, int tmode, int kvh, int row, int fq, const f32x4 (&v)[2][2]) {
        const int t = row & (SEQ - 1), bb = row >> 13, r = t & 63; char* tb = (char*)buf + ((size_t)((bb * NKVH + kvh) * (SEQ / 64) + (t >> 6))) * 8192;
#pragma unroll
        for (int bj = 0; bj < 2; ++bj) { u32x4 w; w.x = pk2(v[bj][0][0], v[bj][0][1]); w.y = pk2(v[bj][0][2], v[bj][0][3]); w.z = pk2(v[bj][1][0], v[bj][1][1]); w.w = pk2(v[bj][1][2], v[bj][1][3]);
            const int off = (tmode == 1) ? ((4 * bj + fq) * 1024 + r * 16) : ((bj * 4 + (r >> 4)) * 1024 + (r & 15) * 64 + 16 * fq);
            *(u32x4*)(tb + off) = w; }
    }
    __device__ __forceinline__ void rows(const pg8::Unit& u, LAS unsigned char* dst, int wid, int lane) const {
        if (wid == 0) __builtin_amdgcn_global_load_lds((const unsigned*)(rstd + u.pm * 256 + lane * 4), (LAS unsigned*)dst, 16, 0, 0);
    }
    __device__ __forceinline__ void operator()(const AccT& acc, const pg8::Unit& u, int wr, int wc, int fr, int fq, const LAS unsigned char* rl) const {
        const LAS float* rsl = (const LAS float*)rl + wr * 64 + fr;
        const int s = 4 * u.pn + wc;
        int kind; bf16_t* dst; int pitch; const float* gain = nullptr; const unsigned* ct = nullptr; float qs = 1.f; int tmode = 0, kvh_ = 0;
        unsigned char* qdst = nullptr;
        if (s < 8) { kind = 0; dst = nullptr; qdst = QA + s * 64; pitch = QW; gain = qa_g; ct = csA; qs = C2 * 8.0f; }
        else if (s < 10) { kind = 0; dst = KA; pitch = KVW; gain = ka_g; ct = csA; tmode = 1; kvh_ = s - 8; }
        else if (s < 12) { kind = 2; dst = VA; pitch = KVW; tmode = 2; kvh_ = s - 10; }
        else if (s < 20) { kind = 1; dst = nullptr; qdst = QB + (s - 12) * 64; pitch = QW; ct = csB; qs = C2 * 8.0f; }
        else if (s < 22) { kind = 1; dst = KB; pitch = KVW; ct = csB; tmode = 1; kvh_ = s - 20; }
        else if (s < 24) { kind = 2; dst = VB; pitch = KVW; tmode = 2; kvh_ = s - 22; }
        else { kind = 3; dst = nullptr; pitch = DM; }
        unsigned char* gdst = (s < 40) ? GA + (s - 24) * 64 : GB + (s - 40) * 64;
        const int row0 = u.pm * 256 + wr * 64 + fr;
        if (kind >= 2) {
#pragma unroll
            for (int ai = 0; ai < 2; ++ai) {
                float rs[2][4];
#pragma unroll
                for (int m = 0; m < 4; ++m) rs[ai][m] = rsl[ai * 128 + m * 16];
#pragma unroll
                for (int m = 0; m < 4; ++m) {
                    const int row = row0 + ai * 128 + m * 16; f32x4 v[2][2];
#pragma unroll
                    for (int bj = 0; bj < 2; ++bj)
#pragma unroll
                        for (int n = 0; n < 2; ++n) {
                            if (kind == 3) { const float rsn = rs[ai][m] * -1.4426950408889634f;
#pragma unroll
                                for (int j = 0; j < 4; ++j) v[bj][n][j] = __builtin_amdgcn_rcpf(1.0f + __builtin_amdgcn_exp2f(acc[ai][bj][m][n][j] * rsn)); }
                            else v[bj][n] = acc[ai][bj][m][n] * rs[ai][m]; }
                    if (kind == 3) {
                        u32x2 w[2];
#pragma unroll
                        for (int bj = 0; bj < 2; ++bj) { w[bj].x = pk4_fp8(v[bj][0][0], v[bj][0][1], v[bj][0][2], v[bj][0][3]); w[bj].y = pk4_fp8(v[bj][1][0], v[bj][1][1], v[bj][1][2], v[bj][1][3]); }
                        const u32x4 q = swap16_pair(w[0], w[1]);
                        *(u32x4*)(gdst + (size_t)row * DM + (fq & 1) * 32 + 16 * (fq >> 1)) = q;
                    }
                    else if (tmode) store_tile(dst, tmode, kvh_, row, fq, v); else store16(dst + (size_t)row * pitch + 8 * fq, v);
                }
            }
            return;
        }
        f32x4 gv[2][2];
        if (kind == 0) {
#pragma unroll
            for (int bj = 0; bj < 2; ++bj)
#pragma unroll
                for (int n = 0; n < 2; ++n) gv[bj][n] = *(const f32x4*)(gain + 32 * bj + 8 * fq + 4 * n);
        }
#pragma unroll
        for (int hm = 0; hm < 4; ++hm) {
            const int ai = hm >> 1, m0 = (hm & 1) * 2;
            float rs[2][4]; rs[ai][m0] = rsl[ai * 128 + m0 * 16]; rs[ai][m0 + 1] = rsl[ai * 128 + (m0 + 1) * 16];
            u32x4 tb[2][2];
#pragma unroll
            for (int mm = 0; mm < 2; ++mm) { const int t = (row0 + ai * 128 + (m0 + mm) * 16) & (SEQ - 1);
#pragma unroll
                for (int n = 0; n < 2; ++n) tb[mm][n] = *(const u32x4*)(ct + t * 32 + 8 * fq + 4 * n); }
#pragma unroll
            for (int mm = 0; mm < 2; ++mm) {
                const int m = m0 + mm; const int row = row0 + ai * 128 + m * 16; f32x4 v[2][2];
#pragma unroll
                for (int bj = 0; bj < 2; ++bj)
#pragma unroll
                    for (int n = 0; n < 2; ++n) v[bj][n] = acc[ai][bj][m][n] * rs[ai][m];
                if (kind == 0) {
                    float ss = 0.f;
#pragma unroll
                    for (int bj = 0; bj < 2; ++bj)
#pragma unroll
                        for (int n = 0; n < 2; ++n) { const f32x4 x = v[bj][n]; ss += (x[0] * x[0] + x[1] * x[1]) + (x[2] * x[2] + x[3] * x[3]); }
                    ss = swap32_sum(swap16_sum(ss));
                    const float r = rsqrtf(ss * (1.0f / 64.0f) + EPS);
#pragma unroll
                    for (int bj = 0; bj < 2; ++bj)
#pragma unroll
                        for (int n = 0; n < 2; ++n) v[bj][n] = v[bj][n] * r * gv[bj][n];
                }
#pragma unroll
                for (int n = 0; n < 2; ++n) { const f32x4 x1 = v[0][n], x2 = v[1][n]; const u32x4 w = tb[mm][n];
                    const f32x4 c_ = {bflo(w.x), bflo(w.y), bflo(w.z), bflo(w.w)}, s_ = {bfhi(w.x), bfhi(w.y), bfhi(w.z), bfhi(w.w)};
                    v[0][n] = (x1 * c_ - x2 * s_) * qs; v[1][n] = (x2 * c_ + x1 * s_) * qs; }
                if (tmode) store_tile(dst, tmode, kvh_, row, fq, v);
                else {
                    u32x2 w[2];
#pragma unroll
                    for (int bj = 0; bj < 2; ++bj) { w[bj].x = pk4_fp8(v[bj][0][0], v[bj][0][1], v[bj][0][2], v[bj][0][3]); w[bj].y = pk4_fp8(v[bj][1][0], v[bj][1][1], v[bj][1][2], v[bj][1][3]); }
                    const u32x4 q = swap16_pair(w[0], w[1]);
                    *(u32x4*)(qdst + (size_t)row * QW + (fq & 1) * 32 + 16 * (fq >> 1)) = q;
                }
            }
        }
    }
};

template <bool FIRST> struct EpiGate {
    static constexpr bool PERM = true, HAS_PRE = false, HAS_ROWS = false;
    __device__ __forceinline__ static bool keeps(const pg8::Unit&) { return false; }
    const bf16_t* G; bf16_t* O;
    __device__ __forceinline__ void operator()(const AccT& acc, const pg8::Unit& u, int wr, int wc, int fr, int fq) const {
#pragma unroll
        for (int ai = 0; ai < 2; ++ai)
#pragma unroll
            for (int m = 0; m < 4; ++m) {
                const size_t row = (size_t)(u.pm * 256 + ai * 128 + wr * 64 + m * 16 + fr);
#pragma unroll
                for (int bj = 0; bj < 2; ++bj) {
                    const size_t off = row * DM + u.pn * 256 + bj * 128 + wc * 32 + 8 * fq;
                    const u32x4 g = *(const u32x4*)(G + off);
                    f32x4 v0 = acc[ai][bj][m][0], v1 = acc[ai][bj][m][1];
                    v0[0] *= bflo(g.x); v0[1] *= bfhi(g.x); v0[2] *= bflo(g.y); v0[3] *= bfhi(g.y);
                    v1[0] *= bflo(g.z); v1[1] *= bfhi(g.z); v1[2] *= bflo(g.w); v1[3] *= bfhi(g.w);
                    if (!FIRST) { const u32x4 p = *(const u32x4*)(O + off);
                        v0[0] += bflo(p.x); v0[1] += bfhi(p.x); v0[2] += bflo(p.y); v0[3] += bfhi(p.y);
                        v1[0] += bflo(p.z); v1[1] += bfhi(p.z); v1[2] += bflo(p.w); v1[3] += bfhi(p.w); }
                    u32x4 w; w.x = pk2(v0[0], v0[1]); w.y = pk2(v0[2], v0[3]); w.z = pk2(v1[0], v1[1]); w.w = pk2(v1[2], v1[3]);
                    *(u32x4*)(O + off) = w;
                }
            }
    }
};

struct EpiGateFused {
    static constexpr bool PERM = true, HAS_PRE = false, HAS_ROWS = false;
    const unsigned char* GA; const unsigned char* GB; unsigned char* O;
    __device__ __forceinline__ static bool keeps(const pg8::Unit& u) { return u.e == 0; }
    __device__ __forceinline__ void operator()(AccT& acc, const pg8::Unit& u, int wr, int wc, int fr, int fq) const {
        const size_t base = (size_t)(u.pml * 256 + wr * 64 + fr) * DM + u.pn * 256 + wc * 32 + 8 * fq;
        if (u.e == 0) {
#pragma unroll
            for (int ai = 0; ai < 2; ++ai)
#pragma unroll
                for (int m = 0; m < 4; ++m)
#pragma unroll
                    for (int bj = 0; bj < 2; ++bj) {
                        const size_t off = base + (size_t)(ai * 128 + m * 16) * DM + bj * 128;
                        const u32x2 a = *(const u32x2*)(GA + off), b = *(const u32x2*)(GB + off);
                        const f32x2 a0 = __builtin_amdgcn_cvt_pk_f32_fp8((int)a.x, false), a1 = __builtin_amdgcn_cvt_pk_f32_fp8((int)a.x, true), a2 = __builtin_amdgcn_cvt_pk_f32_fp8((int)a.y, false), a3 = __builtin_amdgcn_cvt_pk_f32_fp8((int)a.y, true);
                        const f32x2 b0 = __builtin_amdgcn_cvt_pk_f32_fp8((int)b.x, false), b1 = __builtin_amdgcn_cvt_pk_f32_fp8((int)b.x, true), b2 = __builtin_amdgcn_cvt_pk_f32_fp8((int)b.y, false), b3 = __builtin_amdgcn_cvt_pk_f32_fp8((int)b.y, true);
                        f32x4& v0 = acc[ai][bj][m][0]; f32x4& v1 = acc[ai][bj][m][1];
                        v0[0] *= b0.x * __builtin_amdgcn_rcpf(fmaxf(a0.x, 1e-30f)); v0[1] *= b0.y * __builtin_amdgcn_rcpf(fmaxf(a0.y, 1e-30f)); v0[2] *= b1.x * __builtin_amdgcn_rcpf(fmaxf(a1.x, 1e-30f)); v0[3] *= b1.y * __builtin_amdgcn_rcpf(fmaxf(a1.y, 1e-30f));
                        v1[0] *= b2.x * __builtin_amdgcn_rcpf(fmaxf(a2.x, 1e-30f)); v1[1] *= b2.y * __builtin_amdgcn_rcpf(fmaxf(a2.y, 1e-30f)); v1[2] *= b3.x * __builtin_amdgcn_rcpf(fmaxf(a3.x, 1e-30f)); v1[3] *= b3.y * __builtin_amdgcn_rcpf(fmaxf(a3.y, 1e-30f));
                    }
        } else {
#pragma unroll
            for (int ai = 0; ai < 2; ++ai)
#pragma unroll
                for (int m = 0; m < 4; ++m)
                {
                    u32x2 w[2];
#pragma unroll
                    for (int bj = 0; bj < 2; ++bj) {
                        const size_t off = base + (size_t)(ai * 128 + m * 16) * DM + bj * 128;
                        const u32x2 a = *(const u32x2*)(GA + off);
                        const f32x2 a0 = __builtin_amdgcn_cvt_pk_f32_fp8((int)a.x, false), a1 = __builtin_amdgcn_cvt_pk_f32_fp8((int)a.x, true), a2 = __builtin_amdgcn_cvt_pk_f32_fp8((int)a.y, false), a3 = __builtin_amdgcn_cvt_pk_f32_fp8((int)a.y, true);
                        const f32x4 v0 = acc[ai][bj][m][0] * 32.0f, v1 = acc[ai][bj][m][1] * 32.0f;
                        w[bj].x = pk4_fp8(v0[0] * a0.x, v0[1] * a0.y, v0[2] * a1.x, v0[3] * a1.y); w[bj].y = pk4_fp8(v1[0] * a2.x, v1[1] * a2.y, v1[2] * a3.x, v1[3] * a3.y);
                    }
                    const u32x4 q = swap16_pair(w[0], w[1]);
                    *(u32x4*)(O + (size_t)(u.pml * 256 + wr * 64 + fr + ai * 128 + m * 16) * DM + u.pn * 256 + (fq & 1) * 128 + wc * 32 + 16 * (fq >> 1)) = q;
                }
        }
    }
};

struct EpiResid {
    static constexpr bool PERM = true, HAS_PRE = false, HAS_ROWS = false;
    __device__ __forceinline__ static bool keeps(const pg8::Unit&) { return false; }
    const float* X; bf16_t* O;
    __device__ __forceinline__ void operator()(const AccT& acc, const pg8::Unit& u, int wr, int wc, int fr, int fq) const {
#pragma unroll
        for (int ai = 0; ai < 2; ++ai)
#pragma unroll
            for (int m = 0; m < 4; ++m) {
                const size_t row = (size_t)(u.pm * 256 + ai * 128 + wr * 64 + m * 16 + fr);
#pragma unroll
                for (int bj = 0; bj < 2; ++bj) {
                    const size_t off = row * DM + u.pn * 256 + bj * 128 + wc * 32 + 8 * fq;
                    const f32x4 v0 = *(const f32x4*)(X + off) + acc[ai][bj][m][0], v1 = *(const f32x4*)(X + off + 4) + acc[ai][bj][m][1];
                    u32x4 w; w.x = pk2(v0[0], v0[1]); w.y = pk2(v0[2], v0[3]); w.z = pk2(v1[0], v1[1]); w.w = pk2(v1[2], v1[3]);
                    *(u32x4*)(O + off) = w;
                }
            }
    }
};

struct EpiSwiglu {
    static constexpr bool PERM = true, HAS_PRE = true, HAS_ROWS = false;
    __device__ __forceinline__ static bool keeps(const pg8::Unit&) { return false; }
    const float* bgu; unsigned char* ACT;
    __device__ __forceinline__ void pre(const pg8::Unit& u, LAS unsigned char* dst, int lane) const {
        const float* src = bgu + (size_t)u.e * 2048 + (lane >> 5) * 1024 + u.pn * 128 + 4 * (lane & 31);
        __builtin_amdgcn_global_load_lds((const unsigned*)src, (LAS unsigned*)dst, 16, 0, 0);
    }
    __device__ __forceinline__ void init(AccT& acc, const LAS float* pb, int wc, int fq) const {
        const int cl = wc * 32 + 8 * fq;
#pragma unroll
        for (int n = 0; n < 2; ++n) { const f32x4 bg = *(const LAS f32x4*)(pb + cl + 4 * n) * SWI_C, bu = (*(const LAS f32x4*)(pb + 128 + cl + 4 * n) + 1.0f) * (1.0f / SWI_C);
#pragma unroll
            for (int ai = 0; ai < 2; ++ai)
#pragma unroll
                for (int m = 0; m < 4; ++m) { acc[ai][0][m][n] = bg; acc[ai][1][m][n] = bu; } }
    }
    __device__ __forceinline__ void operator()(const AccT& acc, const pg8::Unit& u, int wr, int wc, int fr, int fq) const {
#pragma unroll
        for (int ai = 0; ai < 2; ++ai)
#pragma unroll
            for (int mp = 0; mp < 2; ++mp) {
                u32x2 w[2];
#pragma unroll
                for (int mm = 0; mm < 2; ++mm) { const int m = 2 * mp + mm; float a[8];
#pragma unroll
                    for (int n = 0; n < 2; ++n)
#pragma unroll
                        for (int j = 0; j < 4; ++j) {
                            const float g = fmaxf(acc[ai][0][m][n][j], 7.0f * SWI_C), up1 = __builtin_amdgcn_fmed3f(acc[ai][1][m][n][j], 8.0f / SWI_C, -6.0f / SWI_C);
                            a[4 * n + j] = up1 * (g * __builtin_amdgcn_rcpf(1.0f + __builtin_amdgcn_exp2f(g)));
                        }
                    w[mm].x = pk4_fp8(a[0], a[1], a[2], a[3]); w[mm].y = pk4_fp8(a[4], a[5], a[6], a[7]); }
                const u32x4 q = swap16_pair(w[0], w[1]);
                const size_t row = (size_t)(u.pm * 256 + ai * 128 + wr * 64 + (2 * mp + (fq & 1)) * 16 + fr);
                *(u32x4*)(ACT + row * DFF + u.pn * 128 + wc * 32 + 16 * (fq >> 1)) = q;
            }
    }
};

struct EpiDown {
    static constexpr bool PERM = true, HAS_PRE = true, HAS_ROWS = true;
    __device__ __forceinline__ static bool keeps(const pg8::Unit&) { return false; }
    const float* bd; const u32x2* list2; const LAS int* cnt; unsigned char* Y;
    __device__ __forceinline__ void pre(const pg8::Unit& u, LAS unsigned char* dst, int lane) const {
        const float* src = bd + (size_t)u.e * DM + u.pn * 256 + 4 * lane;
        __builtin_amdgcn_global_load_lds((const unsigned*)src, (LAS unsigned*)dst, 16, 0, 0);
    }
    __device__ __forceinline__ void init(AccT& acc, const LAS float* pb, int wc, int fq) const {
        const int cl = wc * 32 + 8 * fq;
#pragma unroll
        for (int bj = 0; bj < 2; ++bj)
#pragma unroll
            for (int n = 0; n < 2; ++n) { const f32x4 bv = *(const LAS f32x4*)(pb + bj * 128 + cl + 4 * n);
#pragma unroll
                for (int ai = 0; ai < 2; ++ai)
#pragma unroll
                    for (int m = 0; m < 4; ++m) acc[ai][bj][m][n] = bv; }
    }
    __device__ __forceinline__ void rows(const pg8::Unit& u, LAS unsigned char* dst, int wid, int lane) const {
        if (wid < 2) __builtin_amdgcn_global_load_lds((const unsigned*)(list2 + (size_t)u.e * MTOK + u.pml * 256 + wid * 128 + lane * 2), (LAS unsigned*)(dst + wid * 1024), 16, 0, 0);
    }
    __device__ __forceinline__ void operator()(const AccT& acc, const pg8::Unit& u, int wr, int wc, int fr, int fq, const LAS unsigned char* rl) const {
        const int ne = cnt[u.e];
        u32x2 sg[2][4];
#pragma unroll
        for (int ai = 0; ai < 2; ++ai)
#pragma unroll
            for (int m = 0; m < 4; ++m) { const int rloc = ai * 128 + wr * 64 + m * 16 + fr;
                sg[ai][m] = *(const LAS u32x2*)(rl + rloc * 8); if (u.pml * 256 + rloc >= ne) sg[ai][m].x = 0xffffffffu; }
#pragma unroll
        for (int ai = 0; ai < 2; ++ai)
#pragma unroll
            for (int m = 0; m < 4; ++m) {
                const float gg = __uint_as_float(sg[ai][m].y) * 4.0f;
                u32x2 w[2];
#pragma unroll
                for (int bj = 0; bj < 2; ++bj) {
                    const f32x4 v0 = acc[ai][bj][m][0] * gg, v1 = acc[ai][bj][m][1] * gg;
                    w[bj].x = pk4_fp8(v0[0], v0[1], v0[2], v0[3]); w[bj].y = pk4_fp8(v1[0], v1[1], v1[2], v1[3]); }
                const u32x4 q = swap16_pair(w[0], w[1]);
                if (sg[ai][m].x != 0xffffffffu)
                    *(u32x4*)(Y + (size_t)sg[ai][m].x * DM + u.pn * 256 + (fq & 1) * 128 + wc * 32 + 16 * (fq >> 1)) = q;
            }
    }
};

namespace attn_body {
using bf16 = __hip_bfloat16;
using s16x4 = __attribute__((ext_vector_type(4))) short;
using f32x16 = __attribute__((ext_vector_type(16))) float;
constexpr int D = 64, QP = QW, KP = KVW;
constexpr int NW = 8, QBLK = 32, QB = QBLK * NW, KVBLK = 64;
__device__ __forceinline__ int crow(int r, int hi) { return (r & 3) + 8 * (r >> 2) + 4 * hi; }
#define SBAR() __builtin_amdgcn_sched_barrier(0)
constexpr int NSLOT = 3, SLOTB = 8192;
constexpr int LDS_K = 0, LDS_V = NSLOT * SLOTB, LDS_WS = 2 * NSLOT * SLOTB, LDS_OST = LDS_WS + NW * 64 * 4, LDS_BYTES = LDS_OST + NW * 4096;
__device__ __forceinline__ void glds16(const void* gsrc, unsigned lds_dst) { unsigned keep;
    asm volatile("s_mov_b32 %0, m0\n\ts_mov_b32 m0, %2\n\ts_nop 0\n\tglobal_load_lds_dwordx4 %1, off\n\ts_mov_b32 m0, %0" : "=&s"(keep) : "v"(gsrc), "s"(lds_dst) : "memory"); }
__device__ __forceinline__ float max3f(float a, float b, float c) { float r; asm("v_max3_f32 %0, %1, %2, %3" : "=v"(r) : "v"(a), "v"(b), "v"(c)); return r; }
__device__ __forceinline__ float max2f(float a, float b) { float r; asm("v_max_f32_e32 %0, %1, %2" : "=v"(r) : "v"(a), "v"(b)); return r; }
__device__ __forceinline__ float fadd_s(float a, float b) { float r; asm("v_add_f32_e32 %0, %1, %2" : "=v"(r) : "v"(a), "v"(b)); return r; }
__device__ __forceinline__ float fsub_s(float a, float b) { float r; asm("v_sub_f32_e32 %0, %1, %2" : "=v"(r) : "v"(a), "v"(b)); return r; }
typedef float f32x2_t __attribute__((ext_vector_type(2))); typedef __bf16 bf16x2_t __attribute__((ext_vector_type(2)));
__device__ __forceinline__ unsigned cvtpk_s(float lo, float hi) { f32x2_t v = {lo, hi}; bf16x2_t b = __builtin_convertvector(v, bf16x2_t); return __builtin_bit_cast(unsigned, b); }
#define WAIT_BAR(N) asm volatile("s_waitcnt vmcnt(" #N ") lgkmcnt(0)\n\ts_barrier" ::: "memory")

__device__ __forceinline__ void qkt(f32x16& p0, f32x16& p1, const char* Kslot, const bf16x8* qr, const f32x16& negm, int r32, int hi) {
    const char* kb = Kslot + hi * 1024 + r32 * 16;
#pragma unroll
    for (int d0 = 0; d0 < 4; ++d0) {
        const bf16x8 b0 = *reinterpret_cast<const bf16x8*>(kb + d0 * 2048);
        const bf16x8 b1 = *reinterpret_cast<const bf16x8*>(kb + d0 * 2048 + 512);
        if (d0 == 0) { p0 = __builtin_amdgcn_mfma_f32_32x32x16_bf16(b0, qr[0], negm, 0, 0, 0); p1 = __builtin_amdgcn_mfma_f32_32x32x16_bf16(b1, qr[0], negm, 0, 0, 0); }
        else { p0 = __builtin_amdgcn_mfma_f32_32x32x16_bf16(b0, qr[d0], p0, 0, 0, 0); p1 = __builtin_amdgcn_mfma_f32_32x32x16_bf16(b1, qr[d0], p1, 0, 0, 0); } }
}
typedef __attribute__((address_space(3))) const char* lds_cptr;
typedef short v4i16_t __attribute__((ext_vector_type(4)));
__device__ __forceinline__ void kload8(bf16x8* kf, lds_cptr kp) {
    kf[0] = *(const LAS bf16x8*)(kp);        kf[1] = *(const LAS bf16x8*)(kp + 512);
    kf[2] = *(const LAS bf16x8*)(kp + 2048); kf[3] = *(const LAS bf16x8*)(kp + 2560);
    kf[4] = *(const LAS bf16x8*)(kp + 4096); kf[5] = *(const LAS bf16x8*)(kp + 4608);
    kf[6] = *(const LAS bf16x8*)(kp + 6144); kf[7] = *(const LAS bf16x8*)(kp + 6656);
}
__device__ __forceinline__ void kload2(bf16x8* kf, lds_cptr kp, int j) { kf[2 * j] = *(const LAS bf16x8*)(kp + j * 2048); kf[2 * j + 1] = *(const LAS bf16x8*)(kp + j * 2048 + 512); }
__device__ __forceinline__ s16x4 vtr(lds_cptr p) { return __builtin_bit_cast(s16x4, __builtin_amdgcn_ds_read_tr16_b64_v4i16((LAS v4i16_t*)p)); }
__device__ __forceinline__ float rowmax(const f32x16& p0, const f32x16& p1) {
    float a = max3f(p0[0], p0[1], p1[0]), b = max3f(p0[2], p0[3], p1[1]); a = max3f(a, p1[2], p1[3]);
#pragma unroll
    for (int r = 4; r < 16; r += 4) { a = max3f(a, p0[r], p0[r + 1]); b = max3f(b, p0[r + 2], p0[r + 3]); a = max3f(a, p1[r], p1[r + 1]); b = max3f(b, p1[r + 2], p1[r + 3]); }
    const float m = max2f(a, b);
    auto rr = __builtin_amdgcn_permlane32_swap(__float_as_uint(m), __float_as_uint(m), false, false);
    return max2f(__uint_as_float(rr[0]), __uint_as_float(rr[1]));
}
__device__ __forceinline__ void pv(f32x16* o, int vb, bf16x8 pa0, bf16x8 pa1, bf16x8 pa2, bf16x8 pa3) {
#pragma unroll
    for (int d0 = 0; d0 < 2; ++d0) { s16x4 lo[4], hi[4];
#pragma unroll
        for (int ks = 0; ks < 4; ++ks) {
            asm volatile("ds_read_b64_tr_b16 %0,%1 offset:%c2" : "=&v"(lo[ks]) : "v"(vb), "i"(d0 * 4096 + ks * 1024) : "memory");
            asm volatile("ds_read_b64_tr_b16 %0,%1 offset:%c2" : "=&v"(hi[ks]) : "v"(vb), "i"(d0 * 4096 + ks * 1024 + 512) : "memory"); }
        asm volatile("s_waitcnt lgkmcnt(0)" ::: "memory"); SBAR();
#define PK(k) (bf16x8){lo[k][0], lo[k][1], lo[k][2], lo[k][3], hi[k][0], hi[k][1], hi[k][2], hi[k][3]}
        o[d0] = __builtin_amdgcn_mfma_f32_32x32x16_bf16(pa0, PK(0), o[d0], 0, 0, 0);
        o[d0] = __builtin_amdgcn_mfma_f32_32x32x16_bf16(pa1, PK(1), o[d0], 0, 0, 0);
        o[d0] = __builtin_amdgcn_mfma_f32_32x32x16_bf16(pa2, PK(2), o[d0], 0, 0, 0);
        o[d0] = __builtin_amdgcn_mfma_f32_32x32x16_bf16(pa3, PK(3), o[d0], 0, 0, 0);
#undef PK
    }
}
__device__ __forceinline__ void wmask(f32x16& p0, f32x16& p1, int base) {
    const float NEG = -INFINITY;
#pragma unroll
    for (int r = 0; r < 16; ++r) { const int d0 = base + (r & 3) + 8 * (r >> 2), d1 = d0 + 32;
        if (d0 > 128 || d0 < -128) p0[r] = NEG; if (d1 > 128 || d1 < -128) p1[r] = NEG; }
}

struct AttnChain { int s0; bool pre; u32x2 q8[4]; };
template <int MODE, int THRL, bool NOMAX = false> __device__ __forceinline__ void attn_unit(AttnChain& CH, const char* kn, const char* vn, const unsigned char* qn, int b, int h, int qb, const unsigned char* Q, const bf16* __restrict__ K, const bf16* __restrict__ V, unsigned char* O, char* shm, int wave_, float sink2, float mref = 0.f) {
    const int wid = wave_, lane = lane_fresh(), tid = wid * 64 + lane, r32 = lane & 31, hi = lane >> 5;
    const long rowbase = (long)b * SEQ; const int q0 = qb * QB; const int kvh = h >> 2;
    int kt0 = 0, NT = SEQ / KVBLK;
    if (MODE == 1) { kt0 = 4 * qb - 2; int kt1 = 4 * qb + 6; if (kt0 < 0) kt0 = 0; if (kt1 > SEQ / KVBLK) kt1 = SEQ / KVBLK; NT = kt1 - kt0; }
    const unsigned char* Qw = Q + (rowbase + q0 + wid * QBLK) * QP + h * D;
    const unsigned lds0 = (unsigned)(uintptr_t)shm;
    float* wsf = (float*)(shm + LDS_WS) + wid * 64;
    const char* ksrc = (const char*)K + ((size_t)((b * NKVH + kvh) * (SEQ / KVBLK) + kt0)) * 8192 + wid * 1024 + lane * 16;
    const char* vsrc = (const char*)V + ((size_t)((b * NKVH + kvh) * (SEQ / KVBLK) + kt0)) * 8192 + wid * 1024 + lane * 16;
    const unsigned kdst = lds0 + LDS_K + wid * 1024, vdst = lds0 + LDS_V + wid * 1024;
#define DMA_K(t, slot) glds16(ksrc + (size_t)(t) * 8192, (unsigned)__builtin_amdgcn_readfirstlane(kdst + (slot)))
#define DMA_V(t, slot) glds16(vsrc + (size_t)(t) * 8192, (unsigned)__builtin_amdgcn_readfirstlane(vdst + (slot)))
    const bool hasn = (kn != nullptr), pre = CH.pre;
    const char* ksn = (hasn ? kn : (const char*)K) + wid * 1024 + lane * 16; const char* vsn = (hasn ? vn : (const char*)V) + wid * 1024 + lane * 16;
#define DMA_KX(t, slot) glds16(((t) < NT) ? ksrc + (size_t)(t) * 8192 : ksn + (size_t)((t) - NT) * 8192, (unsigned)__builtin_amdgcn_readfirstlane(kdst + (slot)))
#define DMA_VX(t, slot) glds16(((t) < NT) ? vsrc + (size_t)(t) * 8192 : vsn + (size_t)((t) - NT) * 8192, (unsigned)__builtin_amdgcn_readfirstlane(vdst + (slot)))
    const int s0 = CH.s0, s1 = (s0 == (NSLOT - 1) * SLOTB) ? 0 : s0 + SLOTB, s2 = (s1 == (NSLOT - 1) * SLOTB) ? 0 : s1 + SLOTB;
    const int vb0 = (int)(lds0 + LDS_V) + ((lane >> 4) & 1) * 32 + (lane & 3) * 8 + (4 * hi + ((lane & 15) >> 2)) * 64;
    const char* Kbase = shm + LDS_K; bf16x8 kf[8];
    const lds_cptr shm3 = (lds_cptr)shm; const lds_cptr kp0 = shm3 + LDS_K + hi * 1024 + r32 * 16; const lds_cptr vp0 = shm3 + LDS_V + ((lane >> 4) & 1) * 32 + (lane & 3) * 8 + (4 * hi + ((lane & 15) >> 2)) * 64;
    if (!pre) { DMA_K(0, s0); DMA_V(0, s0); DMA_K(1, s1); }
    bf16x8 qr[4];
#pragma unroll
    for (int d0 = 0; d0 < 4; ++d0) { u32x2 w8 = CH.q8[d0]; if (!pre) w8 = *reinterpret_cast<const u32x2*>(&Qw[(long)r32 * QP + d0 * 16 + hi * 8]);
        const f32x2_t a0 = __builtin_amdgcn_cvt_pk_f32_fp8((int)w8.x, false), a1 = __builtin_amdgcn_cvt_pk_f32_fp8((int)w8.x, true), a2 = __builtin_amdgcn_cvt_pk_f32_fp8((int)w8.y, false), a3 = __builtin_amdgcn_cvt_pk_f32_fp8((int)w8.y, true);
        const u32x4 qw = {cvtpk_s(a0.x * 0.125f, a0.y * 0.125f), cvtpk_s(a1.x * 0.125f, a1.y * 0.125f), cvtpk_s(a2.x * 0.125f, a2.y * 0.125f), cvtpk_s(a3.x * 0.125f, a3.y * 0.125f)};
        qr[d0] = __builtin_bit_cast(bf16x8, qw); }
    float mhat = 0.f, l_reg = 0.f; f32x16 o[2]; o[0] = f32x16{}; o[1] = f32x16{}; f32x16 negm = f32x16{}; asm volatile("" : "+v"(negm));
    const int mbase = kt0 * KVBLK + 4 * hi - (q0 + wid * QBLK + r32);
#define CMASK(P0, P1, t) do { if (MODE == 1) wmask(P0, P1, mbase + (t) * KVBLK); } while (0)
    bool resc = false;
#define START(P0, P1) do { const float rm = NOMAX ? mref : rowmax(P0, P1); resc = false; \
    { const float dl = (MODE == 1) ? __builtin_fmaxf(rm, -500.f) : rm; mhat = fadd_s(mhat, dl); \
      _Pragma("unroll") for (int r = 0; r < 16; ++r) { P0[r] = fsub_s(P0[r], dl); P1[r] = fsub_s(P1[r], dl); } \
      _Pragma("unroll") for (int r = 0; r < 16; ++r) negm[r] = -mhat; asm volatile("" : "+v"(negm)); } \
    _Pragma("unroll") for (int r = 0; r < 16; ++r) P0[r] = __builtin_amdgcn_exp2f(P0[r]); } while (0)
#define RESC() do { if (resc) { asm volatile("s_waitcnt lgkmcnt(0)" ::: "memory"); \
      _Pragma("unroll") for (int d_ = 0; d_ < 2; ++d_) _Pragma("unroll") for (int r = 0; r < 16; ++r) o[d_][r] *= wsf[crow(r, hi)]; } } while (0)
    f32x16 pA0, pA1, pB0, pB1;
    int sl_prev = s0, sl_cur = s0, sl_next = s1;
#define ROT() do { sl_prev = sl_cur; sl_cur = sl_next; sl_next = (sl_next == (NSLOT - 1) * SLOTB) ? 0 : sl_next + SLOTB; } while (0)
    if (!pre) { DMA_K(2, s2); WAIT_BAR(3); }
    else { WAIT_BAR(2); }
    qkt(pA0, pA1, Kbase + s0, qr, negm, r32, hi); asm volatile("s_nop 15\n\ts_nop 7" : "+v"(pA0), "+v"(pA1)); CMASK(pA0, pA1, 0);
    START(pA0, pA1);
    _Pragma("unroll") for (int r = 0; r < 16; ++r) pA1[r] = __builtin_amdgcn_exp2f(pA1[r]);
    WAIT_BAR(0);
    DMA_K(3, s0); DMA_V(1, s1);
    ROT();
    kload8(kf, kp0 + sl_cur);
    WAIT_BAR(2);
    s16x4 vlo[8], vhi[8]; u32x4 pw0, pw1, pw2, pw3;
#define PKW(P, B) cvtpk_s(P[B], P[B + 1])
#define PAF(k) __builtin_bit_cast(bf16x8, pw##k)
#define VFR(i) (bf16x8){vlo[i][0], vlo[i][1], vlo[i][2], vlo[i][3], vhi[i][0], vhi[i][1], vhi[i][2], vhi[i][3]}
#define PIN(x) asm volatile("" : "+v"(x))
#define MX3(a, b, c) __builtin_fmaxf(__builtin_fmaxf((a), (b)), (c))
#define GAPA(MF, A0, A1, A2, A3, W0, W1, PW) do { MF; sacc += A0; sacc += A1; sacc += A2; sacc += A3; PIN(sacc); W0; W1; PIN(PW); SBAR(); } while (0)
#define EX(v) __builtin_amdgcn_exp2f(v)
#define GAPB(MF, X, B) do { MF; X[B] = EX(X[B]); X[B + 1] = EX(X[B + 1]); X[B + 2] = EX(X[B + 2]); X[B + 3] = EX(X[B + 3]); PIN(X); SBAR(); } while (0)
#define VRD(i) do { vlo[i] = vtr(vp_ + (((i) >> 2) * 4096 + ((i) & 3) * 1024)); vhi[i] = vtr(vp_ + (((i) >> 2) * 4096 + ((i) & 3) * 1024 + 512)); } while (0)
#define KRD(G, j) do { if (G) { kload2(kf, kp0 + sl_next, j); SBAR(); } } while (0)
#define STEP(C0, C1, P0, P1, t, GK, GV, GL, TAILX) do { SBAR(); \
    const lds_cptr vp_ = vp0 + sl_prev; \
    VRD(0); SBAR(); float sacc = (P0[0] + P0[1]); \
    GAPA(C0 = __builtin_amdgcn_mfma_f32_32x32x16_bf16(kf[0], qr[0], negm, 0, 0, 0), P0[2], P0[3], P0[4], P0[5],     pw0[0] = PKW(P0, 0), pw0[1] = PKW(P0, 2), pw0); \
    VRD(4); SBAR(); GAPA(C1 = __builtin_amdgcn_mfma_f32_32x32x16_bf16(kf[1], qr[0], negm, 0, 0, 0), P0[6], P0[7], P0[8], P0[9],     pw0[2] = PKW(P0, 4), pw0[3] = PKW(P0, 6), pw0); \
    VRD(1); SBAR(); GAPA(C0 = __builtin_amdgcn_mfma_f32_32x32x16_bf16(kf[2], qr[1], C0, 0, 0, 0),   P0[10], P0[11], P0[12], P0[13], pw1[0] = PKW(P0, 8), pw1[1] = PKW(P0, 10), pw1); \
    VRD(5); SBAR(); GAPA(C1 = __builtin_amdgcn_mfma_f32_32x32x16_bf16(kf[3], qr[1], C1, 0, 0, 0),   P0[14], P0[15], P1[0], P1[1],   pw1[2] = PKW(P0, 12), pw1[3] = PKW(P0, 14), pw1); \
    VRD(2); SBAR(); GAPA(C0 = __builtin_amdgcn_mfma_f32_32x32x16_bf16(kf[4], qr[2], C0, 0, 0, 0),   P1[2], P1[3], P1[4], P1[5],     pw2[0] = PKW(P1, 0), pw2[1] = PKW(P1, 2), pw2); \
    VRD(6); SBAR(); GAPA(C1 = __builtin_amdgcn_mfma_f32_32x32x16_bf16(kf[5], qr[2], C1, 0, 0, 0),   P1[6], P1[7], P1[8], P1[9],     pw2[2] = PKW(P1, 4), pw2[3] = PKW(P1, 6), pw2); \
    VRD(3); SBAR(); GAPA(C0 = __builtin_amdgcn_mfma_f32_32x32x16_bf16(kf[6], qr[3], C0, 0, 0, 0),   P1[10], P1[11], P1[12], P1[13], pw3[0] = PKW(P1, 8), pw3[1] = PKW(P1, 10), pw3); \
    VRD(7); SBAR(); GAPA(C1 = __builtin_amdgcn_mfma_f32_32x32x16_bf16(kf[7], qr[3], C1, 0, 0, 0),   P1[14], P1[15], 0.f, 0.f,       pw3[2] = PKW(P1, 12), pw3[3] = PKW(P1, 14), pw3); \
    l_reg += sacc; \
    if (GK) { if (TAILX) { DMA_KX((t) + 3, sl_cur); } else { DMA_K((t) + 3, sl_cur); } } if (GV) { if (TAILX) { DMA_VX((t) + 1, sl_next); } else { DMA_V((t) + 1, sl_next); } } \
    CMASK(C0, C1, t); \
    if (!NOMAX) { float a = MX3(C0[0], C0[1], C1[0]), b = MX3(C0[2], C0[3], C1[1]); a = MX3(a, C1[2], C1[3]); \
      _Pragma("unroll") for (int r = 4; r < 16; r += 4) { a = MX3(a, C0[r], C0[r + 1]); b = MX3(b, C0[r + 2], C0[r + 3]); a = MX3(a, C1[r], C1[r + 1]); b = MX3(b, C1[r + 2], C1[r + 3]); } \
      float rm = __builtin_fmaxf(a, b); { auto rr = __builtin_amdgcn_permlane32_swap(__float_as_uint(rm), __float_as_uint(rm), false, false); rm = __builtin_fmaxf(__uint_as_float(rr[0]), __uint_as_float(rr[1])); } \
      resc = false; \
      if (__builtin_expect(__any(rm > (float)THRL), 0)) { const float dl = __builtin_fmaxf(rm, 0.f); mhat += dl; \
        _Pragma("unroll") for (int r = 0; r < 16; ++r) { C0[r] -= dl; C1[r] -= dl; } \
        _Pragma("unroll") for (int r = 0; r < 16; ++r) negm[r] = -mhat; asm volatile("" : "+v"(negm)); \
        const float f = __builtin_amdgcn_exp2f(-dl); l_reg *= f; if (hi == 0) wsf[r32] = f; resc = true; } } \
    SBAR(); \
    GAPB(o[0] = __builtin_amdgcn_mfma_f32_32x32x16_bf16(PAF(0), VFR(0), o[0], 0, 0, 0), C0, 0); \
    GAPB(o[1] = __builtin_amdgcn_mfma_f32_32x32x16_bf16(PAF(0), VFR(4), o[1], 0, 0, 0), C0, 4); \
    KRD(GL, 0); GAPB(o[0] = __builtin_amdgcn_mfma_f32_32x32x16_bf16(PAF(1), VFR(1), o[0], 0, 0, 0), C0, 8); \
    KRD(GL, 1); GAPB(o[1] = __builtin_amdgcn_mfma_f32_32x32x16_bf16(PAF(1), VFR(5), o[1], 0, 0, 0), C0, 12); \
    KRD(GL, 2); GAPB(o[0] = __builtin_amdgcn_mfma_f32_32x32x16_bf16(PAF(2), VFR(2), o[0], 0, 0, 0), C1, 0); \
    KRD(GL, 3); GAPB(o[1] = __builtin_amdgcn_mfma_f32_32x32x16_bf16(PAF(2), VFR(6), o[1], 0, 0, 0), C1, 4); \
    GAPB(o[0] = __builtin_amdgcn_mfma_f32_32x32x16_bf16(PAF(3), VFR(3), o[0], 0, 0, 0), C1, 8); \
    GAPB(o[1] = __builtin_amdgcn_mfma_f32_32x32x16_bf16(PAF(3), VFR(7), o[1], 0, 0, 0), C1, 12); \
    } while (0)
    int t = 1;
    for (; t + 5 < NT; t += 2) {
        STEP(pB0, pB1, pA0, pA1, t, true, true, true, false);     WAIT_BAR(2); RESC(); ROT();
        STEP(pA0, pA1, pB0, pB1, t + 1, true, true, true, false); WAIT_BAR(2); RESC(); ROT();
    }
#define ENDW(tt) do { if (hasn || (tt) + 3 < NT) { WAIT_BAR(2); } else if ((tt) + 2 < NT) { WAIT_BAR(1); } else { WAIT_BAR(0); } } while (0)
    for (; t + 1 < NT; t += 2) {
        STEP(pB0, pB1, pA0, pA1, t, (hasn || t + 3 < NT), (t + 1 < NT), (t + 1 < NT), true);         ENDW(t);     RESC(); ROT();
        STEP(pA0, pA1, pB0, pB1, t + 1, (hasn || t + 4 < NT), (t + 2 < NT), (t + 2 < NT), true);     ENDW(t + 1); RESC(); ROT();
    }
    STEP(pB0, pB1, pA0, pA1, NT - 1, hasn, hasn, false, true);
    if (hasn) {
        WAIT_BAR(2);
#pragma unroll
        for (int d0 = 0; d0 < 4; ++d0) CH.q8[d0] = *reinterpret_cast<const u32x2*>(qn + ((long)(wid * QBLK + r32) * QP + d0 * 16 + hi * 8));
    }
    CH.pre = hasn; CH.s0 = (s0 + NT * SLOTB) % (NSLOT * SLOTB);
    RESC();
    { float sacc = pB0[0] + pB0[1]; _Pragma("unroll") for (int r = 2; r < 16; ++r) sacc += pB0[r]; _Pragma("unroll") for (int r = 0; r < 16; ++r) sacc += pB1[r]; l_reg += sacc;
      pw0 = (u32x4){PKW(pB0, 0), PKW(pB0, 2), PKW(pB0, 4), PKW(pB0, 6)}; pw1 = (u32x4){PKW(pB0, 8), PKW(pB0, 10), PKW(pB0, 12), PKW(pB0, 14)}; pw2 = (u32x4){PKW(pB1, 0), PKW(pB1, 2), PKW(pB1, 4), PKW(pB1, 6)}; pw3 = (u32x4){PKW(pB1, 8), PKW(pB1, 10), PKW(pB1, 12), PKW(pB1, 14)};
      SBAR(); pv(o, vb0 + sl_cur, PAF(0), PAF(1), PAF(2), PAF(3)); }
#undef PKW
#undef PAF
#undef VFR
#undef PIN
#undef MX3
#undef GAPA
#undef GAPB
#undef EX
#undef VRD
#undef KRD
#undef STEP
#undef ENDW
    { auto rr = __builtin_amdgcn_permlane32_swap(__float_as_uint(l_reg), __float_as_uint(l_reg), false, false); l_reg = __uint_as_float(rr[0]) + __uint_as_float(rr[1]); }
    if (MODE == 1) l_reg += __builtin_amdgcn_exp2f(sink2 - mhat);
    if (hi == 0) wsf[32 + r32] = l_reg; asm volatile("s_waitcnt lgkmcnt(0)" ::: "memory");
    float rli[16];
#pragma unroll
    for (int r = 0; r < 16; ++r) rli[r] = __builtin_amdgcn_rcpf(wsf[32 + crow(r, hi)]);
    unsigned char* Ow = O + (rowbase + q0 + wid * QBLK) * QP + h * D;
    { unsigned char* stg = (unsigned char*)(shm + LDS_OST) + wid * 2048;
#pragma unroll
      for (int r = 0; r < 16; ++r) { const int orow = crow(r, hi); const float sc = rli[r] * 32.0f;
        const unsigned pk = (unsigned)__builtin_amdgcn_cvt_pk_fp8_f32(o[0][r] * sc, o[1][r] * sc, 0, false);
        stg[orow * 64 + r32] = (unsigned char)(pk & 0xffu); stg[orow * 64 + 32 + r32] = (unsigned char)((pk >> 8) & 0xffu); }
      asm volatile("s_waitcnt lgkmcnt(0)" ::: "memory");
#pragma unroll
      for (int i = 0; i < 2; ++i) { const int row = i * 16 + (lane >> 2), ch = lane & 3; const u32x4 v = *(const u32x4*)(stg + row * 64 + ch * 16); *(u32x4*)(Ow + (long)row * QP + ch * 16) = v; } }
    asm volatile("s_waitcnt lgkmcnt(0)\n\ts_barrier" ::: "memory");
#undef DMA_K
#undef DMA_V
#undef DMA_KX
#undef DMA_VX
#undef CMASK
#undef START
#undef RESC
#undef ROT
}
#undef SBAR
#undef WAIT_BAR
}

constexpr size_t MiB = 1u << 20;
constexpr size_t WS_CTL = 0, CTL_ZERO_BYTES = 1 * MiB;
constexpr size_t WS_RSTD = 1 * MiB;
constexpr size_t WS_ROPE = 2 * MiB;
constexpr size_t WS_GATEW = 6 * MiB;
constexpr size_t WS_LIST = 7 * MiB;
constexpr size_t WS_WIN = 10 * MiB;
constexpr size_t WS_WA = 18 * MiB, WS_WB = WS_WA + MiB / 2, WS_WOUT = 20 * MiB;
constexpr size_t WS_XB = 24 * MiB;
constexpr size_t WS_QA = 56 * MiB, WS_QB = 72 * MiB;
constexpr size_t WS_KA = 88 * MiB, WS_VA = 92 * MiB, WS_KB = 96 * MiB, WS_VB = 100 * MiB;
constexpr size_t WS_GA = 104 * MiB, WS_GB = 136 * MiB;
constexpr size_t WS_MERGED = 168 * MiB;
constexpr size_t WS_H2 = 200 * MiB;
constexpr size_t WS_WGU = 232 * MiB;
constexpr size_t WS_WD = 360 * MiB;
constexpr size_t WS_ACT = 424 * MiB;
constexpr size_t WS_Y = 568 * MiB;
constexpr size_t WS_OA = 696 * MiB, WS_OB = 704 * MiB;
constexpr size_t WS_X1 = 728 * MiB;
constexpr size_t WS_LIST2 = 792 * MiB;
constexpr size_t WS_END = 796 * MiB;
static_assert((size_t)ACT_ROWS * DFF * 2 <= WS_Y - WS_ACT, "ACT fits");
constexpr int CW_ECNT = 64;
constexpr int CW_TKT = 512;
constexpr int CW_BAR = 4096;

constexpr int RING_OFF = 0, RING_BYTES = 131072;
constexpr int LDSCTL_OFF = RING_BYTES;
constexpr int L_BARST = 0;
constexpr int L_TKT = 8;
constexpr int L_PRE = 16;
constexpr int L_CNT = 64;
constexpr int L_LCNT = 96;
constexpr int L_LBASE = 128;
constexpr int L_SELE = 256, L_SELR = 512, L_SELG = 768;
constexpr int LDS_BYTES = 147456;
static_assert(LDSCTL_OFF + 1024 * 4 <= LDS_BYTES, "LDS map");

#define XB_TMO      128
#define XB_XCNT(j)  (256  + 64 * (j))
#define XB_XSUB(j)  (1280 + 64 * (j))
#define XB_XGEN(j)  (2304 + 64 * (j))
#define XB_TOP      3328
#define XB_TOPGEN   3392
#define XCD_BAR_WORDS 3456
#define XB_SPIN_CAP (1u << 22)
__device__ __forceinline__ unsigned xb_ld(unsigned* p)              { return __hip_atomic_load(p, __ATOMIC_RELAXED, __HIP_MEMORY_SCOPE_AGENT); }
__device__ __forceinline__ unsigned xb_add(unsigned* p, unsigned v) { return __hip_atomic_fetch_add(p, v, __ATOMIC_RELAXED, __HIP_MEMORY_SCOPE_AGENT); }
__device__ __forceinline__ unsigned xb_xcc_id() { return (unsigned)__builtin_amdgcn_s_getreg((3 << 11) | 20) & 0xFu; }
#define XB_SPIN(cond, bar) do { unsigned _sp = 0; while (cond) { __builtin_amdgcn_s_sleep(1); \
    if ((++_sp & 255u) == 0u) { if (xb_ld(&(bar)[XB_TMO])) break; if (_sp > XB_SPIN_CAP) { atomicAdd(&(bar)[XB_TMO], 1u); break; } } } } while (0)
struct XcdBarrier { unsigned* bar; unsigned x; volatile LAS unsigned* st; };
__device__ __forceinline__ XcdBarrier xcd_barrier_post(unsigned* bar, volatile LAS unsigned* st, int wave) {
    XcdBarrier b; b.bar = bar; b.x = xb_xcc_id(); b.st = st;
    if (wave == 0 && lane_fresh() == 0) st[2] = xb_add(&bar[XB_XCNT(b.x)], 1u);
    return b;
}
__device__ __forceinline__ void xcd_barrier_complete(unsigned* bar, unsigned x, unsigned& nloc, unsigned& nx) {
    const unsigned G = gridDim.x * gridDim.y * gridDim.z;
    unsigned sum, cnt, mine, sp = 0u;
    for (;;) {
        sum = 0u; cnt = 0u; mine = 0u;
#pragma unroll
        for (unsigned j = 0; j < 16; ++j) { const unsigned c = xb_ld(&bar[XB_XCNT(j)]); sum += c; cnt += (c > 0u) ? 1u : 0u; mine = (j == x) ? c : mine; }
        if (sum == G) break;
        __builtin_amdgcn_s_sleep(1);
        if ((++sp & 255u) == 0u) { if (xb_ld(&bar[XB_TMO])) break; if (sp > XB_SPIN_CAP) { atomicAdd(&bar[XB_TMO], 1u); break; } }
    }
    nloc = mine > 0u ? mine : 1u; nx = cnt > 0u ? cnt : 1u;
}
__device__ __forceinline__ void xcd_barrier(const XcdBarrier& b, int wave) {
    asm volatile("s_waitcnt vmcnt(0)" ::: "memory");
    __syncthreads();
    if (wave == 0 && lane_fresh() == 0) {
        unsigned* bar = b.bar;
        __builtin_amdgcn_s_waitcnt(0);
        unsigned nloc = b.st[0], nx = b.st[1];
        if (nloc == 0u) { xcd_barrier_complete(bar, b.x, nloc, nx); b.st[0] = nloc; b.st[1] = nx; }
        const unsigned old = xb_add(&bar[XB_XSUB(b.x)], 1u);
        const unsigned gen = old / nloc;
        if (old + 1u == (gen + 1u) * nloc) {
            __builtin_amdgcn_fence(__ATOMIC_RELEASE, "agent");
            asm volatile("s_waitcnt vmcnt(0)" ::: "memory");
            const unsigned og = xb_add(&bar[XB_TOP], 1u);
            const unsigned tg = og / nx;
            if (og + 1u == (tg + 1u) * nx) xb_add(&bar[XB_TOPGEN], 1u);
            else XB_SPIN(xb_ld(&bar[XB_TOPGEN]) == tg, bar);
            __builtin_amdgcn_fence(__ATOMIC_ACQUIRE, "agent");
            xb_add(&bar[XB_XGEN(b.x)], 1u);
            asm volatile("s_waitcnt vmcnt(0)" ::: "memory");
        } else {
            XB_SPIN(xb_ld(&bar[XB_XGEN(b.x)]) == gen, bar);
            __builtin_amdgcn_fence(__ATOMIC_ACQUIRE, "agent");
            asm volatile("s_waitcnt vmcnt(0)" ::: "memory");
        }
    }
    __syncthreads();
}

struct Args { const float* in[17]; float* out; unsigned char* ws; int ph_lo, ph_hi, li, pad; };
struct Frame {
    LAS unsigned char* lds; int tid, lane, wave, vcu, G;
};

__device__ __forceinline__ void p0_item(const float* W, int ldw, int k0, int nsrc0, bf16_t* WT, int K, int ndst0, const float* gk, LAS float* scr, int lane) {
    f32x4 v[8];
#pragma unroll
    for (int i = 0; i < 8; ++i) v[i] = *(const f32x4*)(W + (size_t)(k0 + 8 * i + (lane >> 3)) * ldw + nsrc0 + 4 * (lane & 7));
    if (gk) {
#pragma unroll
        for (int i = 0; i < 8; ++i) v[i] = v[i] * gk[k0 + 8 * i + (lane >> 3)];
    }
#pragma unroll
    for (int i = 0; i < 8; ++i) { LAS float* s = scr + (8 * i + (lane >> 3)) * 33 + 4 * (lane & 7); s[0] = v[i][0]; s[1] = v[i][1]; s[2] = v[i][2]; s[3] = v[i][3]; }
    asm volatile("s_waitcnt lgkmcnt(0)" ::: "memory");
    const int c = lane & 7;
#pragma unroll
    for (int j = 0; j < 4; ++j) { const int n = (lane >> 3) + 8 * j; const LAS float* s = scr + (8 * c) * 33 + n;
        u32x4 o; o.x = pk2(s[0 * 33], s[1 * 33]); o.y = pk2(s[2 * 33], s[3 * 33]); o.z = pk2(s[4 * 33], s[5 * 33]); o.w = pk2(s[6 * 33], s[7 * 33]);
        *(u32x4*)(WT + (size_t)(ndst0 + n) * K + k0 + 8 * c) = o; }
    asm volatile("s_waitcnt lgkmcnt(0)" ::: "memory");
}
__device__ __forceinline__ void p0_item8(const float* W, int ldw, int k0, int nsrc0, unsigned char* WT, int K, int ndst0, float scale, const float* gk, LAS float* scr, int lane) {
    f32x4 v[8];
#pragma unroll
    for (int i = 0; i < 8; ++i) v[i] = *(const f32x4*)(W + (size_t)(k0 + 8 * i + (lane >> 3)) * ldw + nsrc0 + 4 * (lane & 7));
    if (gk) {
#pragma unroll
        for (int i = 0; i < 8; ++i) v[i] = v[i] * gk[k0 + 8 * i + (lane >> 3)];
    }
#pragma unroll
    for (int i = 0; i < 8; ++i) { LAS float* s = scr + (8 * i + (lane >> 3)) * 33 + 4 * (lane & 7); s[0] = v[i][0] * scale; s[1] = v[i][1] * scale; s[2] = v[i][2] * scale; s[3] = v[i][3] * scale; }
    asm volatile("s_waitcnt lgkmcnt(0)" ::: "memory");
    const int c = lane & 7;
#pragma unroll
    for (int j = 0; j < 4; ++j) { const int n = (lane >> 3) + 8 * j; const LAS float* s = scr + (8 * c) * 33 + n;
        u32x2 o; o.x = pk4_fp8(s[0 * 33], s[1 * 33], s[2 * 33], s[3 * 33]); o.y = pk4_fp8(s[4 * 33], s[5 * 33], s[6 * 33], s[7 * 33]);
        *(u32x2*)(WT + (size_t)(ndst0 + n) * K + k0 + 8 * c) = o; }
    asm volatile("s_waitcnt lgkmcnt(0)" ::: "memory");
}
template <class SrcMap> __device__ __forceinline__ void p0_weight8(const Frame& F, const float* W, int K, int N, unsigned char* WT, float scale, const float* gk, LAS float* scr, SrcMap srcmap) {
    const int gw = F.vcu * 8 + F.wave, NGW = F.G * 8; const int nkb = K / 64, nnb = N / 32, nitems = nkb * nnb;
    for (int it = gw; it < nitems; it += NGW) { const int kb = it / nnb, nb = it % nnb; p0_item8(W, N, kb * 64, srcmap(nb * 32), WT, K, nb * 32, scale, gk, scr, F.lane); }
}
struct W8Task { const float* W; unsigned char* WT; int K, N, ngroups; float scale; const float* gk; int gu; };
template <bool HAS_GK, class SrcMap> __device__ __forceinline__ void p0_w8_load(const W8Task& T, int it, f32x4 (&v)[8], float (&gv)[8], int lane, SrcMap srcmap) {
    const int nnb = T.N / 32, per = (T.K / 64) * nnb; const int g = it / per, r = it - g * per, kb = r / nnb, nb = r - kb * nnb;
    const float* W = T.W + (size_t)g * T.K * T.N; const int nsrc0 = srcmap(nb * 32), k0 = kb * 64;
#pragma unroll
    for (int i = 0; i < 8; ++i) { v[i] = __builtin_nontemporal_load((const f32x4*)(W + (size_t)(k0 + 8 * i + (lane >> 3)) * T.N + nsrc0 + 4 * (lane & 7))); if (HAS_GK) gv[i] = T.gk[k0 + 8 * i + (lane >> 3)]; }
}
template <bool HAS_GK> __device__ __forceinline__ void p0_w8_store(const W8Task& T, int it, const f32x4 (&v)[8], const float (&gv)[8], LAS float* scr, int lane) {
    const int nnb = T.N / 32, per = (T.K / 64) * nnb; const int g = it / per, r = it - g * per, kb = r / nnb, nb = r - kb * nnb;
    unsigned char* WT = T.WT + (size_t)g * T.K * T.N; const int k0 = kb * 64, ndst0 = nb * 32;
    const float gus = T.gu ? (((ndst0 >> 7) & 1) ? 1.0f / SWI_C : SWI_C) : 1.0f;
#pragma unroll
    for (int i = 0; i < 8; ++i) { float sc = T.scale * gus; if (HAS_GK) sc *= gv[i];
        LAS float* s = scr + (8 * i + (lane >> 3)) * 33 + 4 * (lane & 7); s[0] = v[i][0] * sc; s[1] = v[i][1] * sc; s[2] = v[i][2] * sc; s[3] = v[i][3] * sc; }
    asm volatile("s_waitcnt lgkmcnt(0)" ::: "memory");
    const int c = lane & 7;
#pragma unroll
    for (int j = 0; j < 4; ++j) { const int n = (lane >> 3) + 8 * j; const LAS float* s = scr + (8 * c) * 33 + n;
        u32x2 o; o.x = pk4_fp8(s[0 * 33], s[1 * 33], s[2 * 33], s[3 * 33]); o.y = pk4_fp8(s[4 * 33], s[5 * 33], s[6 * 33], s[7 * 33]);
        *(u32x2*)(WT + (size_t)(ndst0 + n) * T.K + k0 + 8 * c) = o; }
    asm volatile("s_waitcnt lgkmcnt(0)" ::: "memory");
}
template <bool HAS_GK, class SrcMap> __device__ __forceinline__ void p0_w8_run(const Frame& F, const W8Task& T, LAS float* scr, SrcMap srcmap, int gw = -1, int NGW = 0) {
    if (gw < 0) { gw = F.vcu * 8 + F.wave; NGW = F.G * 8; } const int total = T.ngroups * (T.K / 64) * (T.N / 32);
    f32x4 va[8], vb_[8]; float ga[8], gb[8]; int it = gw;
    if (it < total) p0_w8_load<HAS_GK>(T, it, va, ga, F.lane, srcmap);
    while (it < total) {
        const int i1 = it + NGW; if (i1 < total) p0_w8_load<HAS_GK>(T, i1, vb_, gb, F.lane, srcmap);
        p0_w8_store<HAS_GK>(T, it, va, ga, scr, F.lane);
        if (i1 >= total) break;
        const int i2 = i1 + NGW; if (i2 < total) p0_w8_load<HAS_GK>(T, i2, va, ga, F.lane, srcmap);
        p0_w8_store<HAS_GK>(T, i1, vb_, gb, scr, F.lane);
        it = i2;
    }
}
template <class SrcMap> __device__ __forceinline__ void p0_weight(const Frame& F, const float* W, int K, int N, bf16_t* WT, const float* gk, LAS float* scr, SrcMap srcmap) {
    const int gw = F.vcu * 8 + F.wave, NGW = F.G * 8; const int nkb = K / 64, nnb = N / 32, nitems = nkb * nnb;
    for (int it = gw; it < nitems; it += NGW) { const int kb = it / nnb, nb = it % nnb; p0_item(W, N, kb * 64, srcmap(nb * 32), WT, K, nb * 32, gk, scr, F.lane); }
}
struct MapId { __device__ __forceinline__ int operator()(int n) const { return n; } };
struct MapInProj { __device__ __forceinline__ int operator()(int n) const { const int pn = n >> 8, c = n & 255; return pn * 256 + 64 * ((c & 127) >> 5) + 32 * (c >> 7) + (c & 31); } };
struct MapGateUp { __device__ __forceinline__ int operator()(int n) const { const int pn = n >> 8, bj = (n >> 7) & 1, j = n & 127; return 1024 * bj + 128 * pn + j; } };

__device__ const double ROPE_INV[32] = {1.0, 0.7498942093324559, 0.5623413251903491, 0.4216965034285822, 0.31622776601683794, 0.23713737056616552, 0.1778279410038923, 0.1333521432163324, 0.1, 0.07498942093324558, 0.05623413251903491, 0.042169650342858224, 0.03162277660168379, 0.023713737056616554, 0.01778279410038923, 0.01333521432163324, 0.01, 0.007498942093324558, 0.005623413251903491, 0.004216965034285823, 0.0031622776601683794, 0.0023713737056616554, 0.0017782794100389228, 0.001333521432163324, 0.001, 0.0007498942093324559, 0.0005623413251903491, 0.00042169650342858224, 0.00031622776601683794, 0.00023713737056616554, 0.00017782794100389227, 0.0001333521432163324};

constexpr int NPHASE = 9;
#ifndef REP_PHASE
#define REP_PHASE -1
#endif
#define NREP(k) ((k) == REP_PHASE ? 2 : 1)
constexpr int N_LAUNCHES = MK_N_LAUNCHES;

__global__ void __launch_bounds__(512, 2) fwd_kernel(Args args) {
    extern __shared__ __attribute__((aligned(16))) unsigned char lds_raw[];
    Frame F;
    F.lds = (LAS unsigned char*)lds_raw;
    F.wave = __builtin_amdgcn_readfirstlane((int)threadIdx.x >> 6); F.lane = lane_fresh(); F.tid = F.wave * 64 + F.lane;
#define REFRESH_ID() do { F.lane = lane_fresh(); F.tid = F.wave * 64 + F.lane; } while (0)
    F.G = gridDim.x; { const int bx = blockIdx.x; F.vcu = (F.G % 8 == 0) ? (bx % 8) * (F.G / 8) + bx / 8 : bx; }
    unsigned char* ws = args.ws;
    unsigned* ctl = (unsigned*)(ws + WS_CTL);
    volatile LAS unsigned* LCTL = (volatile LAS unsigned*)(F.lds + LDSCTL_OFF);
    for (int u = F.tid; u < (LDS_BYTES - LDSCTL_OFF) / 4; u += 512) ((LAS unsigned*)(F.lds + LDSCTL_OFF))[u] = 0u;
    __syncthreads();
    XcdBarrier bar; bar.bar = ctl + CW_BAR; bar.x = 0; bar.st = nullptr;
    if (N_LAUNCHES == 1) bar = xcd_barrier_post(ctl + CW_BAR, LCTL + L_BARST, F.wave);
#define GRID_BAR() do { if (N_LAUNCHES == 1) xcd_barrier(bar, F.wave); } while (0)
    const int lo = args.ph_lo, hi = args.ph_hi;
#ifndef PHASE_MASK
#define PHASE_MASK 0x1ff
#endif
#define IN(k) (((PHASE_MASK >> (k)) & 1) && lo <= (k) && (k) < hi)
#define BOTH(k) (IN(k) && IN((k) + 1))

#define x_in ((const float*)args.in[0])
#define g_mix ((const float*)args.in[1])
#define w_in ((const float*)args.in[2])
#define qa_norm ((const float*)args.in[3])
#define ka_norm ((const float*)args.in[4])
#define sink_b ((const float*)args.in[5])
#define w_br_a ((const float*)args.in[6])
#define w_br_b ((const float*)args.in[7])
#define w_out ((const float*)args.in[8])
#define g_ffn ((const float*)args.in[9])
#define w_router ((const float*)args.in[10])
#define b_router ((const float*)args.in[11])
#define w_gate_up ((const float*)args.in[12])
#define b_gate_up ((const float*)args.in[13])
#define w_down ((const float*)args.in[14])
#define b_down ((const float*)args.in[15])
#define g_final ((const float*)args.in[16])
    float* out = args.out;
    float* RSTD = (float*)(ws + WS_RSTD); float* ROPE = (float*)(ws + WS_ROPE); u32x2* LIST2 = (u32x2*)(ws + WS_LIST2);
    unsigned char* WIN = (unsigned char*)(ws + WS_WIN); unsigned char* WA = (unsigned char*)(ws + WS_WA); unsigned char* WB = (unsigned char*)(ws + WS_WB); unsigned char* WOUT = (unsigned char*)(ws + WS_WOUT);
    unsigned char* XB = (unsigned char*)(ws + WS_XB); unsigned char* QA = (unsigned char*)(ws + WS_QA); unsigned char* QBb = (unsigned char*)(ws + WS_QB);
    bf16_t* KA = (bf16_t*)(ws + WS_KA); bf16_t* VA = (bf16_t*)(ws + WS_VA); bf16_t* KBb = (bf16_t*)(ws + WS_KB); bf16_t* VBb = (bf16_t*)(ws + WS_VB);
    unsigned char* GA = (unsigned char*)(ws + WS_GA); unsigned char* GB = (unsigned char*)(ws + WS_GB); unsigned char* MERGED = (unsigned char*)(ws + WS_MERGED); unsigned char* H2 = (unsigned char*)(ws + WS_H2);
    unsigned char* WGU = (unsigned char*)(ws + WS_WGU); unsigned char* WD = (unsigned char*)(ws + WS_WD); unsigned char* ACT = (unsigned char*)(ws + WS_ACT); unsigned char* YB = (unsigned char*)(ws + WS_Y);
    unsigned char* OA = (unsigned char*)(ws + WS_OA); unsigned char* OB = (unsigned char*)(ws + WS_OB); bf16_t* X1 = (bf16_t*)(ws + WS_X1);
    float* cosA = ROPE, *sinA = ROPE + SEQ * 32, *cosB = ROPE + 2 * SEQ * 32, *sinB = ROPE + 3 * SEQ * 32;
    const int gw = F.vcu * 8 + F.wave, NGW = F.G * 8;

    if (IN(0)) {
        REFRESH_ID();
        LAS float* scr = (LAS float*)(F.lds + RING_OFF + F.wave * 16384);
        for (int rep_ = 0; rep_ < NREP(0); ++rep_) {
        for (int m = gw; m < MTOK; m += 2 * NGW) {
            const int m1 = m + NGW; const bool has1 = m1 < MTOK;
            const f32x4* xr0 = (const f32x4*)(x_in + (size_t)m * DM) + F.lane; const f32x4* xr1 = (const f32x4*)(x_in + (size_t)(has1 ? m1 : m) * DM) + F.lane;
            f32x4 v0[4], v1[4]; float s0 = 0.f, s1 = 0.f;
#pragma unroll
            for (int j = 0; j < 4; ++j) { v0[j] = __builtin_nontemporal_load(xr0 + 64 * j); v1[j] = __builtin_nontemporal_load(xr1 + 64 * j); }
#pragma unroll
            for (int j = 0; j < 4; ++j) { s0 += (v0[j].x * v0[j].x + v0[j].y * v0[j].y) + (v0[j].z * v0[j].z + v0[j].w * v0[j].w); s1 += (v1[j].x * v1[j].x + v1[j].y * v1[j].y) + (v1[j].z * v1[j].z + v1[j].w * v1[j].w); }
            s0 = wave_sum(s0); s1 = wave_sum(s1);
            if (F.lane == 0) { RSTD[m] = rsqrtf(s0 * (1.0f / DM) + EPS); if (has1) RSTD[m1] = rsqrtf(s1 * (1.0f / DM) + EPS); }
            unsigned* o0 = (unsigned*)(XB + (size_t)m * DM) + F.lane; unsigned* o1 = (unsigned*)(XB + (size_t)m1 * DM) + F.lane;
#pragma unroll
            for (int j = 0; j < 4; ++j) { o0[64 * j] = pk4_fp8(v0[j].x, v0[j].y, v0[j].z, v0[j].w); if (has1) o1[64 * j] = pk4_fp8(v1[j].x, v1[j].y, v1[j].z, v1[j].w); }
        }
        { W8Task T{w_in, WIN, DM, IN_COLS, 1, 32.0f, g_mix}; p0_w8_run<true>(F, T, scr, MapInProj()); }
        { W8Task T{w_br_a, WA, QW, DM, 1, 32.0f, nullptr}; p0_w8_run<false>(F, T, scr, MapId()); }
        { W8Task T{w_br_b, WB, QW, DM, 1, 32.0f, nullptr}; p0_w8_run<false>(F, T, scr, MapId()); }
        { W8Task T{w_out, WOUT, DM, DM, 1, 32.0f, nullptr}; p0_w8_run<false>(F, T, scr, MapId()); }
        { W8Task T{w_down, WD, DFF, DM, NEXP, 32.0f, nullptr}; p0_w8_run<false>(F, T, scr, MapId()); }
        {
            for (int it = gw; it < SEQ * 32 / 64; it += NGW) {
                const int idx = it * 64 + F.lane, t = idx >> 5, i = idx & 31;
                const double i2pi = 0.15915494309189535;
                { const double ang = (i < 16) ? (double)(t >> 6) * ROPE_INV[2 * i] : (double)(t & 63) * ROPE_INV[2 * (i - 16)];
                  double rev = ang * i2pi; rev -= rint(rev); const float fr_ = (float)rev;
                  ((unsigned*)ROPE)[idx] = pk2(__builtin_amdgcn_cosf(fr_), __builtin_amdgcn_sinf(fr_)); }
                { const double ang = (double)t * ROPE_INV[i];
                  double rev = ang * i2pi; rev -= rint(rev); const float fr_ = (float)rev;
                  ((unsigned*)ROPE)[SEQ * 32 + idx] = pk2(__builtin_amdgcn_cosf(fr_), __builtin_amdgcn_sinf(fr_)); }
            }
        }
        }
        if (BOTH(0)) GRID_BAR();
    }
    int vb = (int)blockIdx.x;
    if (N_LAUNCHES == 1 && lo == 0 && hi > 1) {
        REFRESH_ID();
        if (F.tid == 0) { unsigned base = 0; for (unsigned j = 0; j < 16; ++j) { const unsigned c = xb_ld(&bar.bar[XB_XCNT(j)]); if (j < bar.x) base += c; } LCTL[L_BARST + 3] = base + LCTL[L_BARST + 2]; }
        __syncthreads();
        F.vcu = (int)LCTL[L_BARST + 3];
        if (F.G % 8 == 0) vb = (F.vcu % (F.G / 8)) * 8 + F.vcu / (F.G / 8); else vb = F.vcu;
    }

    if (IN(1)) {
        constexpr int NCONV = 14;
        { const int cpx_ = (F.G % 8 == 0) ? F.G / 8 : F.G, jj_ = F.vcu % cpx_, xg_ = F.vcu / cpx_, nconv_ = NCONV < cpx_ ? NCONV : cpx_;
          if (jj_ < nconv_) { LAS float* scr = (LAS float*)(F.lds + RING_OFF + F.wave * 16384); const int ngrp_ = F.G / cpx_;
              const int gwc = (xg_ * nconv_ + jj_) * 8 + F.wave, ngwc = ngrp_ * nconv_ * 8;
              { W8Task T{w_gate_up, WGU, DM, 2 * DFF, NEXP, 32.0f, nullptr, 1}; p0_w8_run<false>(F, T, scr, MapGateUp(), gwc, ngwc); }
              asm volatile("s_waitcnt vmcnt(0) lgkmcnt(0)" ::: "memory"); __syncthreads(); } }
        pg8::TicketOrder S; S.init(MTOK, IN_COLS, F.G, F.vcu, ctl + CW_TKT, (volatile LAS int*)(LCTL + L_TKT), F.wave);
        EpiInProj E{RSTD, qa_norm, ka_norm, (const unsigned*)ROPE, (const unsigned*)ROPE + SEQ * 32, QA, KA, VA, QBb, KBb, VBb, GA, GB};
        for (int rep_ = 0; rep_ < NREP(1); ++rep_)
        pg8::gemm_phase<EpiInProj, pg8::TicketOrder, true, true, false, true>(F.lds + RING_OFF, XB, WIN, DM, IN_COLS / 256, S, E, F.wave);
        if (BOTH(1)) GRID_BAR();
    }

    if (IN(2)) {
        REFRESH_ID();
        char* shm = (char*)lds_raw + RING_OFF;
        float gq_ = fabsf(qa_norm[F.lane]), gk_ = fabsf(ka_norm[F.lane]);
        gq_ = wave_max(gq_); gk_ = wave_max(gk_);
        const float mrefA = 64.0f * gq_ * gk_ * C2 * 1.0001f;
        const bool nomax = mrefA < 64.0f;
        auto unit_desc = [&](int k, int& b_, int& h_, int& qb_) -> bool {
            const int uu = F.vcu + F.G * (k & 1); if (uu >= 512) return false;
            if (k < 2) { const int ii = uu >> 8, v = uu & 255, combo = v >> 6, w = (v & 63) + 64 * ii, g = w >> 5; qb_ = w & 31; b_ = combo >> 1; h_ = (combo & 1) * 4 + g; }
            else { qb_ = uu & 31; h_ = (uu >> 5) & 7; b_ = uu >> 8; }
            return true; };
        for (int rep_ = 0; rep_ < NREP(2); ++rep_) {
        attn_body::AttnChain CH; CH.s0 = 0; CH.pre = false;
#pragma unroll
        for (int d0 = 0; d0 < 4; ++d0) CH.q8[d0] = (u32x2){0u, 0u};
#pragma unroll
        for (int k = 0; k < 4; ++k) {
            int b = 0, h = 0, qb = 0; if (!unit_desc(k, b, h, qb)) continue;
            const char* kn = nullptr; const char* vn = nullptr; const unsigned char* qn = nullptr;
#pragma unroll
            for (int k2 = 3; k2 > k; --k2) { int nb = 0, nh = 0, nqb = 0;
                if (unit_desc(k2, nb, nh, nqb)) { const bool nB = k2 >= 2; int kt0n = 0; if (nB) { kt0n = 4 * nqb - 2; if (kt0n < 0) kt0n = 0; }
                    const size_t toff = ((size_t)((nb * NKVH + (nh >> 2)) * (SEQ / 64) + kt0n)) * 8192;
                    kn = (const char*)(nB ? KBb : KA) + toff; vn = (const char*)(nB ? VBb : VA) + toff;
                    qn = (nB ? QBb : QA) + ((size_t)nb * SEQ + (size_t)nqb * 256) * QW + nh * 64; } }
            if (k < 2) {
                if (nomax) attn_body::attn_unit<0, 8, true>(CH, kn, vn, qn, b, h, qb, QA, (const attn_body::bf16*)KA, (const attn_body::bf16*)VA, OA, shm, F.wave, 0.f, mrefA);
                else attn_body::attn_unit<0, 8>(CH, kn, vn, qn, b, h, qb, QA, (const attn_body::bf16*)KA, (const attn_body::bf16*)VA, OA, shm, F.wave, 0.f);
            } else {
                attn_body::attn_unit<1, 8>(CH, kn, vn, qn, b, h, qb, QBb, (const attn_body::bf16*)KBb, (const attn_body::bf16*)VBb, OB, shm, F.wave, sink_b[h] * 1.4426950408889634f);
            }
        }
        }
        if (BOTH(2)) GRID_BAR();
    }

    if (IN(3)) {
        static_assert(WS_OB == WS_OA + (size_t)MTOK * QW && WS_WB == WS_WA + (size_t)DM * QW, "branch B operands follow branch A's");
        pg8::PairOrder S; S.init(MTOK, DM, F.G, vb);
        EpiGateFused E{GB, GA, MERGED};
        for (int rep_ = 0; rep_ < NREP(3); ++rep_)
        pg8::gemm_phase<EpiGateFused, pg8::PairOrder, true, true, false, true>(F.lds + RING_OFF, OA, WA, QW, DM / 256, S, E, F.wave, 0x7a7a7a7a);
        if (BOTH(3)) GRID_BAR();
    }

    u32x4 whi[4][2], wlo[4][2]; float be_r = 0.f;
#define SPLIT2(a_, b_, hi_, lo_) do { const float _a = (a_), _b = (b_); hi_ = pk2(_a, _b); lo_ = pk2(_a - bflo(hi_), _b - bfhi(hi_)); } while (0)
#define LOAD_WREG() do { const float* wp = w_router + (size_t)(F.wave * 128 + 8 * (F.lane >> 4)) * NEXP + (F.lane & 15); \
        _Pragma("unroll") for (int s_ = 0; s_ < 4; ++s_) _Pragma("unroll") for (int h_ = 0; h_ < 2; ++h_) { float w8[8]; \
            _Pragma("unroll") for (int i_ = 0; i_ < 8; ++i_) w8[i_] = wp[(size_t)(32 * s_ + i_) * NEXP + 16 * h_]; \
            SPLIT2(w8[0], w8[1], whi[s_][h_].x, wlo[s_][h_].x); SPLIT2(w8[2], w8[3], whi[s_][h_].y, wlo[s_][h_].y); SPLIT2(w8[4], w8[5], whi[s_][h_].z, wlo[s_][h_].z); SPLIT2(w8[6], w8[7], whi[s_][h_].w, wlo[s_][h_].w); } \
        be_r = b_router[F.lane & 31]; } while (0)
    if (IN(4)) {
        pg8::StaticOrder S; S.init(MTOK, DM, F.G, vb);
        EpiResid E{x_in, X1};
        for (int rep_ = 0; rep_ < NREP(4); ++rep_)
        pg8::gemm_phase<EpiResid, pg8::StaticOrder, true, true, false, true>(F.lds + RING_OFF, MERGED, WOUT, DM, DM / 256, S, E, F.wave, 0x7a7a7a7a);
        if (BOTH(4)) { REFRESH_ID(); LOAD_WREG(); GRID_BAR(); }
    }

    if (IN(5)) {
        REFRESH_ID();
        constexpr int HP = 1028;
        LAS float* hs = (LAS float*)(F.lds + RING_OFF);
        LAS float* part = (LAS float*)(F.lds + RING_OFF + 66560);
        volatile LAS int* lcnt = (volatile LAS int*)(LCTL + L_LCNT); volatile LAS int* lbase = (volatile LAS int*)(LCTL + L_LBASE);
        volatile LAS int* sele = (volatile LAS int*)(LCTL + L_SELE); volatile LAS int* selr = (volatile LAS int*)(LCTL + L_SELR); volatile LAS float* selg = (volatile LAS float*)(LCTL + L_SELG);
        const int e = F.lane & 31, kh = F.lane >> 5;
        if (!IN(4)) { LOAD_WREG(); }
        const float be = be_r;
        f32x4 gff[4];
#pragma unroll
        for (int j = 0; j < 4; ++j) gff[j] = *((const f32x4*)g_ffn + F.lane + 64 * j);
        for (int chunk = F.vcu; chunk < MTOK / 64; chunk += F.G) {
            if (F.tid < 32) lcnt[F.tid] = 0;
            const int row0 = chunk * 64;
            u32x2 xn[2][4];
#pragma unroll
            for (int rr = 0; rr < 2; ++rr)
#pragma unroll
                for (int j = 0; j < 4; ++j) xn[rr][j] = *((const u32x2*)(X1 + (size_t)(row0 + F.wave * 2 + rr) * DM) + F.lane + 64 * j);
            for (int step = 0; step < 4; ++step) {
                u32x2 xc[2][4];
#pragma unroll
                for (int rr = 0; rr < 2; ++rr)
#pragma unroll
                    for (int j = 0; j < 4; ++j) xc[rr][j] = xn[rr][j];
                if (step < 3) {
#pragma unroll
                    for (int rr = 0; rr < 2; ++rr)
#pragma unroll
                        for (int j = 0; j < 4; ++j) xn[rr][j] = *((const u32x2*)(X1 + (size_t)(row0 + (step + 1) * 16 + F.wave * 2 + rr) * DM) + F.lane + 64 * j);
                }
#pragma unroll
                for (int rr = 0; rr < 2; ++rr) {
                    const int rl = F.wave * 2 + rr, m = row0 + step * 16 + rl;
                    f32x4 v[4]; float ssum = 0.f;
#pragma unroll
                    for (int j = 0; j < 4; ++j) { const u32x2 w_ = xc[rr][j]; v[j] = (f32x4){bflo(w_.x), bfhi(w_.x), bflo(w_.y), bfhi(w_.y)}; ssum += (v[j].x * v[j].x + v[j].y * v[j].y) + (v[j].z * v[j].z + v[j].w * v[j].w); }
                    ssum = wave_sum(ssum); const float rs = rsqrtf(ssum * (1.0f / DM) + EPS);
                    unsigned* o8 = (unsigned*)(H2 + (size_t)m * DM) + F.lane;
#pragma unroll
                    for (int j = 0; j < 4; ++j) { const f32x4 hv = v[j] * rs * gff[j];
                        o8[64 * j] = pk4_fp8(hv.x, hv.y, hv.z, hv.w);
                        *(LAS f32x4*)(hs + rl * HP + 4 * F.lane + 256 * j) = hv; }
                }
                __syncthreads();
                {
                    const LAS float* ha = hs + (F.lane & 15) * HP + F.wave * 128 + 8 * (F.lane >> 4);
                    f32x4 c0 = {0.f, 0.f, 0.f, 0.f}, c1 = {0.f, 0.f, 0.f, 0.f};
#pragma unroll
                    for (int s_ = 0; s_ < 4; ++s_) { const f32x4 x0 = *(const LAS f32x4*)(ha + 32 * s_), x1 = *(const LAS f32x4*)(ha + 32 * s_ + 4);
                        u32x4 ah, al; SPLIT2(x0[0], x0[1], ah.x, al.x); SPLIT2(x0[2], x0[3], ah.y, al.y); SPLIT2(x1[0], x1[1], ah.z, al.z); SPLIT2(x1[2], x1[3], ah.w, al.w);
                        const bf16x8 ah8 = __builtin_bit_cast(bf16x8, ah), al8 = __builtin_bit_cast(bf16x8, al);
                        c0 = __builtin_amdgcn_mfma_f32_16x16x32_bf16(al8, __builtin_bit_cast(bf16x8, whi[s_][0]), c0, 0, 0, 0);
                        c1 = __builtin_amdgcn_mfma_f32_16x16x32_bf16(al8, __builtin_bit_cast(bf16x8, whi[s_][1]), c1, 0, 0, 0);
                        c0 = __builtin_amdgcn_mfma_f32_16x16x32_bf16(ah8, __builtin_bit_cast(bf16x8, wlo[s_][0]), c0, 0, 0, 0);
                        c1 = __builtin_amdgcn_mfma_f32_16x16x32_bf16(ah8, __builtin_bit_cast(bf16x8, wlo[s_][1]), c1, 0, 0, 0);
                        c0 = __builtin_amdgcn_mfma_f32_16x16x32_bf16(ah8, __builtin_bit_cast(bf16x8, whi[s_][0]), c0, 0, 0, 0);
                        c1 = __builtin_amdgcn_mfma_f32_16x16x32_bf16(ah8, __builtin_bit_cast(bf16x8, whi[s_][1]), c1, 0, 0, 0); }
                    LAS float* pw_ = part + (F.wave * 16 + 4 * (F.lane >> 4)) * 32 + (F.lane & 15);
#pragma unroll
                    for (int r = 0; r < 4; ++r) { pw_[r * 32] = c0[r]; pw_[r * 32 + 16] = c1[r]; }
                }
                __syncthreads();
                {
                    const int rl = F.wave * 2 + kh;
                    float cur = be;
#pragma unroll
                    for (int w = 0; w < 8; ++w) cur += part[(w * 16 + rl) * 32 + e];
                    float tv[4]; int ti[4];
#pragma unroll
                    for (int kk = 0; kk < 4; ++kk) {
                        const float bv = swap16_max(row_max16(cur));
                        const unsigned long long bm = __ballot(cur == bv);
                        const int bi = __builtin_ctz(kh ? (unsigned)(bm >> 32) : (unsigned)bm);
                        tv[kk] = bv; ti[kk] = bi; if (e == bi) cur = -INFINITY;
                    }
                    const float e1 = __expf(tv[1] - tv[0]), e2 = __expf(tv[2] - tv[0]), e3 = __expf(tv[3] - tv[0]);
                    const float inv = 1.0f / (1.0f + e1 + e2 + e3);
                    if (e < 4) {
                        const int kk = e; const int ex = kk == 0 ? ti[0] : kk == 1 ? ti[1] : kk == 2 ? ti[2] : ti[3];
                        const float gx = (kk == 0 ? 1.0f : kk == 1 ? e1 : kk == 2 ? e2 : e3) * inv;
                        const int a = (step * 16 + rl) * 4 + kk;
                        const int rank = __hip_atomic_fetch_add((LAS int*)&lcnt[ex], 1, __ATOMIC_RELAXED, __HIP_MEMORY_SCOPE_WORKGROUP);
                        sele[a] = ex; selr[a] = rank; selg[a] = gx;
                    }
                }
            }
            __syncthreads();
            if (F.tid < 32) lbase[F.tid] = (int)xb_add(ctl + CW_ECNT + F.tid, (unsigned)lcnt[F.tid]);
            __syncthreads();
            if (F.tid < 256) { const int a = F.tid; const int ex = sele[a]; const int pos = lbase[ex] + selr[a]; const int slot = (row0 + (a >> 2)) * 4 + (a & 3);
                u32x2 pr; pr.x = (unsigned)slot; pr.y = __float_as_uint(selg[a]); LIST2[ex * MTOK + pos] = pr; }
            __syncthreads();
        }
        if (BOTH(5)) GRID_BAR();
    }

    if (IN(6) || IN(7)) {
        REFRESH_ID();
        if (F.wave == 0) {
            const int e_ = F.lane & 31; const int c = (int)xb_ld(ctl + CW_ECNT + e_); const int tiles_ = (c + 255) >> 8;
            LAS int* tl = (LAS int*)(F.lds + LDSCTL_OFF) + L_LCNT;
            if (F.lane < 32) { LCTL[L_CNT + e_] = (unsigned)c; tl[e_] = tiles_; }
            asm volatile("s_waitcnt lgkmcnt(0)" ::: "memory");
            int pre_ = 0;
#pragma unroll
            for (int i = 0; i < NEXP; ++i) { const int t_ = tl[i]; pre_ += (i < e_) ? t_ : 0; }
            if (F.lane < 32) LCTL[L_PRE + e_] = (unsigned)pre_;
            if (F.lane == 31) LCTL[L_PRE + NEXP] = (unsigned)(pre_ + tiles_);
        }
        __syncthreads();
    }
    const LAS int* Lpre = (const LAS int*)(F.lds + LDSCTL_OFF) + L_PRE; const LAS int* Lcnt = (const LAS int*)(F.lds + LDSCTL_OFF) + L_CNT;

    if (IN(6)) {
        pg8::MoeOrder S; S.init(Lpre, Lcnt, LIST2, 2 * DFF / 256, F.G, F.vcu);
        EpiSwiglu E{b_gate_up, ACT};
        for (int rep_ = 0; rep_ < NREP(6); ++rep_)
        pg8::gemm_phase<EpiSwiglu, pg8::MoeOrder, true, true, true, true>(F.lds + RING_OFF, H2, WGU, DM, 2 * DFF / 256, S, E, F.wave);
        if (BOTH(6)) GRID_BAR();
    }

    if (IN(7)) {
        pg8::MoeOrder S; S.init(Lpre, Lcnt, LIST2, DM / 256, F.G, F.vcu);
        EpiDown E{b_down, LIST2, Lcnt, YB};
        for (int rep_ = 0; rep_ < NREP(7); ++rep_)
        pg8::gemm_phase<EpiDown, pg8::MoeOrder, true, true, false, true>(F.lds + RING_OFF, ACT, WD, DFF, DM / 256, S, E, F.wave);
        if (BOTH(7)) GRID_BAR();
    }

    if (IN(8)) {
        const int lane8 = (int)__builtin_amdgcn_mbcnt_hi(~0u, __builtin_amdgcn_mbcnt_lo(~0u, 0u));
        for (int rep_ = 0; rep_ < NREP(8); ++rep_)
        for (int m = gw; m < MTOK; m += NGW) {
            const u32x2* xin = (const u32x2*)(X1 + (size_t)m * DM) + lane8;
            f32x4* xr = (f32x4*)(out + (size_t)m * DM) + lane8;
            f32x4 v[4];
#pragma unroll
            for (int j = 0; j < 4; ++j) { const u32x2 w_ = xin[64 * j]; v[j] = (f32x4){bflo(w_.x), bfhi(w_.x), bflo(w_.y), bfhi(w_.y)}; }
#pragma unroll
            for (int k = 0; k < 4; ++k) { const unsigned* yr = (const unsigned*)(YB + ((size_t)m * 4 + k) * DM) + lane8;
#pragma unroll
                for (int j = 0; j < 4; ++j) { const int w = (int)yr[64 * j]; const f32x2 lo_ = __builtin_amdgcn_cvt_pk_f32_fp8(w, false), hi_ = __builtin_amdgcn_cvt_pk_f32_fp8(w, true);
                    v[j].x += 0.25f * lo_.x; v[j].y += 0.25f * lo_.y; v[j].z += 0.25f * hi_.x; v[j].w += 0.25f * hi_.y; } }
            float s = 0.f;
#pragma unroll
            for (int j = 0; j < 4; ++j) s += (v[j].x * v[j].x + v[j].y * v[j].y) + (v[j].z * v[j].z + v[j].w * v[j].w);
            s = wave_sum(s); const float rs = rsqrtf(s * (1.0f / DM) + EPS);
#pragma unroll
            for (int j = 0; j < 4; ++j) { const f32x4 gg = *((const f32x4*)g_final + lane8 + 64 * j); xr[64 * j] = v[j] * rs * gg; }
        }
    }
#undef IN
#undef BOTH
#undef GRID_BAR
#undef x_in
#undef g_mix
#undef w_in
#undef qa_norm
#undef ka_norm
#undef sink_b
#undef w_br_a
#undef w_br_b
#undef w_out
#undef g_ffn
#undef w_router
#undef b_router
#undef w_gate_up
#undef b_gate_up
#undef w_down
#undef b_down
#undef g_final
}

extern "C" void kernel_launch(void* const* d_in, const int* in_sizes, int n_in, void* d_out, int out_size, void* d_ws, size_t ws_size, hipStream_t stream) {
    static int grid = 0;
    if (grid == 0) {
        if (n_in != 17 || out_size != MTOK * DM || ws_size < WS_END) { fprintf(stderr, "kernel_launch: unexpected problem shape (n_in %d out %d ws %zu)\n", n_in, out_size, ws_size); grid = -1; return; }
        int dev = 0, cus = 0;
        if (hipGetDevice(&dev) != hipSuccess || hipDeviceGetAttribute(&cus, hipDeviceAttributeMultiprocessorCount, dev) != hipSuccess) { grid = -1; return; }
        if (hipFuncSetAttribute((const void*)fwd_kernel, hipFuncAttributeMaxDynamicSharedMemorySize, LDS_BYTES) != hipSuccess) { fprintf(stderr, "kernel_launch: hipFuncSetAttribute failed\n"); grid = -1; return; }
        int per_cu = 0;
        if (hipOccupancyMaxActiveBlocksPerMultiprocessor(&per_cu, (const void*)fwd_kernel, 512, LDS_BYTES) != hipSuccess || per_cu < 1) { fprintf(stderr, "kernel_launch: occupancy query says %d\n", per_cu); }
        (void)hipGetLastError();
        grid = cus;
    }
    if (grid < 0) return;
    (void)hipMemsetAsync((char*)d_ws + WS_CTL, 0, CTL_ZERO_BYTES, stream);
    Args a{};
    for (int i = 0; i < 17; ++i) a.in[i] = (const float*)d_in[i];
    a.out = (float*)d_out; a.ws = (unsigned char*)d_ws;
    if (N_LAUNCHES == 1) {
        a.ph_lo = 0; a.ph_hi = NPHASE; a.li = 0;
        hipLaunchKernelGGL(fwd_kernel, dim3(grid), dim3(512), LDS_BYTES, stream, a);
#if defined(PROBE_PHASE)
        a.ph_lo = PROBE_PHASE; a.ph_hi = PROBE_PHASE + 1; a.li = 1;
        hipLaunchKernelGGL(fwd_kernel, dim3(grid), dim3(512), LDS_BYTES, stream, a);
#endif
    } else {
        for (int li = 0; li < NPHASE; ++li) { a.ph_lo = li; a.ph_hi = li + 1; a.li = li; hipLaunchKernelGGL(fwd_kernel, dim3(grid), dim3(512), LDS_BYTES, stream, a); }
    }
}
```

```cpp
#include <hip/hip_runtime.h>
#include <hip/hip_bf16.h>
#include <cstdio>
#include <cstdint>
#include <cmath>

#ifndef MK_N_LAUNCHES
#define MK_N_LAUNCHES 1
#endif

constexpr int BATCH = 2, SEQ = 8192, DM = 1024, MTOK = BATCH * SEQ;
constexpr int HD = 64, NQH = 8, NKVH = 2, QW = NQH * HD  , KVW = NKVH * HD  ;
constexpr int IN_COLS = 3584, NEXP = 32, TOPK = 4, DFF = 1024;
constexpr int NSLOT_ASSIGN = MTOK * TOPK;
constexpr int ACT_ROWS = NSLOT_ASSIGN + NEXP * 256;
constexpr float EPS = 1e-6f;
constexpr float C2 = 0.125f * 1.4426950408889634f;

#define LAS __attribute__((address_space(3)))
#define GAS __attribute__((address_space(1)))
typedef unsigned short bf16_t;
typedef short bf16x8 __attribute__((ext_vector_type(8)));
typedef float f32x4 __attribute__((ext_vector_type(4)));
typedef float f32x2 __attribute__((ext_vector_type(2)));
typedef unsigned u32x4 __attribute__((ext_vector_type(4)));
typedef unsigned u32x2 __attribute__((ext_vector_type(2)));
typedef int i32x8 __attribute__((ext_vector_type(8)));
typedef int i32x4 __attribute__((ext_vector_type(4)));
typedef i32x8 i32x8_a16 __attribute__((aligned(16)));
__device__ __forceinline__ unsigned pk4_fp8(float a, float b, float c, float d) { int w = 0; w = __builtin_amdgcn_cvt_pk_fp8_f32(a, b, w, false); w = __builtin_amdgcn_cvt_pk_fp8_f32(c, d, w, true); return (unsigned)w; }

__device__ __forceinline__ unsigned f2bf(float f) { unsigned u = __builtin_bit_cast(unsigned, f); return (u + 0x7fffu + ((u >> 16) & 1u)) >> 16; }
typedef __bf16 bf16x2_hw __attribute__((ext_vector_type(2)));
__device__ __forceinline__ unsigned pk2(float lo, float hi) { f32x2 v = {lo, hi}; bf16x2_hw b = __builtin_convertvector(v, bf16x2_hw); return __builtin_bit_cast(unsigned, b); }
__device__ __forceinline__ float bf2f(unsigned short b) { return __builtin_bit_cast(float, (unsigned)b << 16); }
__device__ __forceinline__ float bflo(unsigned w) { return __builtin_bit_cast(float, w << 16); }
__device__ __forceinline__ float bfhi(unsigned w) { return __builtin_bit_cast(float, w & 0xffff0000u); }
constexpr float SWI_C = -1.702f * 1.4426950408889634f;
__device__ __forceinline__ float sigmoidf_(float v) { return __builtin_amdgcn_rcpf(1.0f + __builtin_amdgcn_exp2f(v * -1.4426950408889634f)); }
__device__ __forceinline__ int lane_fresh() { int l; asm volatile("v_mbcnt_lo_u32_b32 %0, -1, 0\n\tv_mbcnt_hi_u32_b32 %0, -1, %0" : "=v"(l)); return l; }
template <int CTRL> __device__ __forceinline__ float dpp_f(float v) { return __builtin_bit_cast(float, __builtin_amdgcn_update_dpp(0, __builtin_bit_cast(int, v), CTRL, 0xf, 0xf, true)); }
__device__ __forceinline__ float row_sum16(float v) { v += dpp_f<0xB1>(v); v += dpp_f<0x4E>(v); v += dpp_f<0x141>(v); v += dpp_f<0x140>(v); return v; }
__device__ __forceinline__ float row_max16(float v) { v = fmaxf(v, dpp_f<0xB1>(v)); v = fmaxf(v, dpp_f<0x4E>(v)); v = fmaxf(v, dpp_f<0x141>(v)); v = fmaxf(v, dpp_f<0x140>(v)); return v; }
__device__ __forceinline__ float swap16_sum(float v) { const auto r = __builtin_amdgcn_permlane16_swap(__float_as_uint(v), __float_as_uint(v), false, false); return __uint_as_float(r[0]) + __uint_as_float(r[1]); }
__device__ __forceinline__ float swap32_sum(float v) { const auto r = __builtin_amdgcn_permlane32_swap(__float_as_uint(v), __float_as_uint(v), false, false); return __uint_as_float(r[0]) + __uint_as_float(r[1]); }
__device__ __forceinline__ float swap16_max(float v) { const auto r = __builtin_amdgcn_permlane16_swap(__float_as_uint(v), __float_as_uint(v), false, false); return fmaxf(__uint_as_float(r[0]), __uint_as_float(r[1])); }
__device__ __forceinline__ float swap32_max(float v) { const auto r = __builtin_amdgcn_permlane32_swap(__float_as_uint(v), __float_as_uint(v), false, false); return fmaxf(__uint_as_float(r[0]), __uint_as_float(r[1])); }
__device__ __forceinline__ float wave_sum(float v) { return swap32_sum(swap16_sum(row_sum16(v))); }
__device__ __forceinline__ float wave_max(float v) { return swap32_max(swap16_max(row_max16(v))); }

namespace pg8 {
constexpr int BM = 256, BK = 64, HALF = 128, HTB = HALF * BK * 2, STAGE_BYTES = 8 * HTB, NXCD = 8, WGM = 8;
__host__ __device__ __forceinline__ int lds_byte(int r, int c) { const int st = (r >> 4) * 2 + (c >> 5), rr = r & 15, cc = c & 31, ob = rr * 64 + cc * 2; return st * 1024 + (ob ^ (((ob >> 9) & 1) << 5)); }
__host__ __device__ __forceinline__ void stage_rc(int b, int& R, int& C) { const int st = b / 1024, sb = b % 1024, swz = sb ^ (((sb >> 9) & 1) << 5); R = (st >> 1) * 16 + swz / 64; C = (st & 1) * 32 + (swz % 64) / 2; }
__host__ __device__ __forceinline__ int perm32(int rho) { const int n = rho >> 4, i = rho & 15; return 8 * (i >> 2) + 4 * n + (i & 3); }

struct Unit { int pm, pn, e, pml; };

struct StaticOrder {
    int nM, nN, nwg, G, c;
    __device__ void init(int M, int N, int G_, int c_) { nM = M / BM; nN = N / BM; nwg = nM * nN; G = G_; c = c_; }
    __device__ bool next(int i, Unit& u) const {
        const long L = (long)i * G + c; if (L >= nwg) return false;
        int wgid = (int)L; { const int q = nwg / NXCD, r = nwg % NXCD, xcd = wgid % NXCD, off = wgid / NXCD; wgid = (xcd < r ? xcd * (q + 1) : r * (q + 1) + (xcd - r) * q) + off; }
        const int nig = WGM * nN, gid = wgid / nig, fm = gid * WGM, gsz = (nM - fm) < WGM ? (nM - fm) : WGM;
        u.pm = fm + ((wgid % nig) % gsz); u.pn = (wgid % nig) / gsz; u.e = 0; u.pml = u.pm; return true;
    }
    __device__ __forceinline__ unsigned a_rowoff(const Unit&, int) const { return 0u; }
    static constexpr bool LAZY = false;
    __device__ __forceinline__ void prefetch(int) const {}
};

struct PairOrder {
    StaticOrder so; int nM;
    static constexpr bool LAZY = false;
    __device__ void init(int M, int N, int G, int c) { so.init(M, N, G, c); nM = M / BM; }
    __device__ bool next(int i, Unit& u) const { if (i >= 2 || !so.next(0, u)) return false; u.e = i; u.pml = u.pm; u.pm = u.pm + i * nM; return true; }
    __device__ __forceinline__ void prefetch(int) const {}
    __device__ __forceinline__ unsigned a_rowoff(const Unit&, int) const { return 0u; }
};

struct TicketOrder {
    StaticOrder so; unsigned* ctr; volatile LAS int* slot; int x, cpx, wave;
    static constexpr bool LAZY = true;
    __device__ void init(int M, int N, int G, int vcu, unsigned* ctr_base, volatile LAS int* slot_, int wave_) { wave = wave_; so.init(M, N, G, 0); cpx = (G % 8 == 0) ? G / 8 : G; x = vcu / cpx; ctr = ctr_base + 64 * x; slot = slot_; }
    __device__ __forceinline__ void prefetch(int i) const { if (wave == 0 && lane_fresh() == 0) { const int t = (int)__hip_atomic_fetch_add(ctr, 1u, __ATOMIC_RELAXED, __HIP_MEMORY_SCOPE_AGENT); slot[i & 1] = t; } }
    __device__ bool next(int i, Unit& u) const {
        const int t = slot[i & 1]; StaticOrder s2 = so; s2.c = 8 * (t % cpx) + x; if (so.G % 8 != 0) s2.c = t % cpx;
        return s2.next(t / cpx, u);
    }
    __device__ __forceinline__ unsigned a_rowoff(const Unit&, int) const { return 0u; }
};

struct MoeOrder {
    const LAS int* pre; const LAS int* cnt; const u32x2* list; int npn, lo, hi, j, cpx; unsigned rowbytes;
    __device__ void init(const LAS int* pre_, const LAS int* cnt_, const u32x2* list_, int npn_, int G, int vcu) {
        pre = pre_; cnt = cnt_; list = list_; npn = npn_; rowbytes = (unsigned)DM;
        const int U = pre[NEXP] * npn; cpx = (G % 8 == 0) ? G / 8 : G; const int nx = G / cpx, x = vcu / cpx; j = vcu % cpx;
        lo = (int)((long)U * x / nx); hi = (int)((long)U * (x + 1) / nx);
    }
    __device__ bool next(int i, Unit& u) const {
        const int L = lo + j + cpx * i; if (L >= hi) return false;
        const int tr = L / npn; u.pn = L % npn; int e = 0;
#pragma unroll
        for (int st = NEXP / 2; st > 0; st >>= 1) { if (pre[e + st] <= tr) e += st; }
        u.e = e; u.pm = tr; u.pml = tr - pre[e]; return true;
    }
    static constexpr bool LAZY = false;
    __device__ __forceinline__ void prefetch(int) const {}
    __device__ __forceinline__ unsigned a_rowoff(const Unit& u, int R) const {
        const int idx = u.pml * BM + R; const int ic = idx < cnt[u.e] ? idx : 0;
        const int slot = (int)list[u.e * MTOK + ic].x;
        return (unsigned)(slot >> 2) * rowbytes;
    }
};

template <class Epi, class Sched, bool ALIGN_EPI, bool SP2, bool GATHER, bool F8 = false>
__device__ __forceinline__ void gemm_phase(LAS unsigned char* lds, const void* Aptr, const void* Btptr, const int K, const int NBT, const Sched& S, const Epi& E, const int wave_, const int scla_ = 0x7f7f7f7f) {
    const int wid = wave_, lane = lane_fresh(), tid = wid * 64 + lane, wr = wid >> 2, wc = wid & 3, fr = lane & 15, fq = lane >> 4;
    constexpr int EB = F8 ? 1 : 2; const int nt = K * EB / (BK * 2);
    unsigned voffA[2], voffB[2]; int R0, C0;
#pragma unroll
    for (int i = 0; i < 2; ++i) { const int R = 8 * wid + 64 * i + (lane >> 3), cl = (lane & 7) ^ ((R >> 1) & 7); const int Rb = Epi::PERM ? ((R & ~31) + perm32(R & 31)) : R;
        voffA[i] = (unsigned)(R * K * EB + cl * 16); voffB[i] = (unsigned)(Rb * K * EB + cl * 16); if (i == 0) { R0 = R; C0 = cl * 8; } }
    const size_t kstep = (size_t)(BK * 2);
    const size_t hstep = (size_t)HALF * K * EB;
    const size_t tstep = 2 * hstep;
    const unsigned ldsw = (unsigned)wid * 1024u;
    const int sw_ = (fr >> 1) & 7; int aoffk[2], boffk[2];
#pragma unroll
    for (int k = 0; k < 2; ++k) { aoffk[k] = (wr * 64 + fr) * 128 + (((fq + 4 * k) ^ sw_) << 4); boffk[k] = (wc * 32 + fr) * 128 + (((fq + 4 * k) ^ sw_) << 4); }
    unsigned gc[2][2], gn[2][2];
#define PG8_SA(b, h) (((b) * 2 + (h)) * HTB)
#define PG8_SB(b, h) ((4 + (b) * 2 + (h)) * HTB)
#define PG8_GLDS(src, dstoff) __builtin_amdgcn_global_load_lds((const unsigned*)(src), (LAS unsigned*)(lds + (dstoff)), 16, 0, 0)
#define PG8_STAGE(bufoff, gbase, voff) do { _Pragma("unroll") for (int _i = 0; _i < 2; ++_i) PG8_GLDS((const char*)(gbase) + (voff)[_i], (bufoff) + ldsw + _i * 8192); } while (0)
#define PG8_STAGE_A(bufoff, kbase, h, usen) do { if constexpr (GATHER) { _Pragma("unroll") for (int _i = 0; _i < 2; ++_i) { const unsigned _o = (usen) ? gn[h][_i] : gc[h][_i]; PG8_GLDS((const char*)(kbase) + _o, (bufoff) + ldsw + _i * 8192); } } \
        else { PG8_STAGE(bufoff, (const char*)(kbase) + (h) * hstep, voffA); } } while (0)
#define PG8_GOFFS(g, u) do { _Pragma("unroll") for (int _h = 0; _h < 2; ++_h) _Pragma("unroll") for (int _i = 0; _i < 2; ++_i) g[_h][_i] = S.a_rowoff(u, _h * HALF + R0 + 64 * _i) + (unsigned)(C0 * 2); } while (0)
#define PG8_LDA8(dst, b, h) do { _Pragma("unroll") for (int m = 0; m < 4; ++m) { const i32x4 _lo = *(const LAS i32x4*)(lds + PG8_SA(b, h) + aoffk[0] + m * 2048), _hi = *(const LAS i32x4*)(lds + PG8_SA(b, h) + aoffk[1] + m * 2048); dst[m] = (i32x8){_lo.x, _lo.y, _lo.z, _lo.w, _hi.x, _hi.y, _hi.z, _hi.w}; } } while (0)
#define PG8_LDB8(dst, b, h) do { _Pragma("unroll") for (int n = 0; n < 2; ++n) { const i32x4 _lo = *(const LAS i32x4*)(lds + PG8_SB(b, h) + boffk[0] + n * 2048), _hi = *(const LAS i32x4*)(lds + PG8_SB(b, h) + boffk[1] + n * 2048); dst[n] = (i32x8){_lo.x, _lo.y, _lo.z, _lo.w, _hi.x, _hi.y, _hi.z, _hi.w}; } } while (0)
#define PG8_MMA8(ai, bj, At, Bt) do { __builtin_amdgcn_s_setprio(1); _Pragma("unroll") for (int m = 0; m < 4; ++m) _Pragma("unroll") for (int n = 0; n < 2; ++n) \
        asm volatile("v_mfma_scale_f32_16x16x128_f8f6f4 %0, %1, %2, %0, %3, %4 op_sel_hi:[0,0,0]" : "+v"(acc[ai][bj][m][n]) : "v"(Bt[n]), "v"(At[m]), "v"(sclw), "v"(scla)); __builtin_amdgcn_s_setprio(0); } while (0)
#define PG8_LDA(dst, b, h) do { _Pragma("unroll") for (int m = 0; m < 4; ++m) _Pragma("unroll") for (int k = 0; k < 2; ++k) dst[m][k] = *(const LAS bf16x8*)(lds + PG8_SA(b, h) + aoffk[k] + m * 2048); } while (0)
#define PG8_LDB(dst, b, h) do { _Pragma("unroll") for (int n = 0; n < 2; ++n) _Pragma("unroll") for (int k = 0; k < 2; ++k) dst[n][k] = *(const LAS bf16x8*)(lds + PG8_SB(b, h) + boffk[k] + n * 2048); } while (0)
#define PG8_MMA(ai, bj, At, Bt) do { __builtin_amdgcn_s_setprio(1); _Pragma("unroll") for (int m = 0; m < 4; ++m) _Pragma("unroll") for (int n = 0; n < 2; ++n) _Pragma("unroll") for (int k = 0; k < 2; ++k) \
        acc[ai][bj][m][n] = __builtin_amdgcn_mfma_f32_16x16x32_bf16(Bt[n][k], At[m][k], acc[ai][bj][m][n], 0, 0, 0); __builtin_amdgcn_s_setprio(0); } while (0)
#define PG8_WAIT_V(n) asm volatile("s_waitcnt vmcnt(" #n ")" ::: "memory")
#define PG8_WAIT_L(n) asm volatile("s_waitcnt lgkmcnt(" #n ")" ::: "memory")
#define PG8_BAR __builtin_amdgcn_s_barrier()
#define PG8_SCHED __builtin_amdgcn_sched_barrier(0)
    constexpr int ROWS_OFF = STAGE_BYTES + 6144;
    constexpr int PRE_OFF = STAGE_BYTES + 4096;
    Unit cur, nxt; int ui = 0;
    if constexpr (Sched::LAZY) { S.prefetch(0); asm volatile("s_waitcnt vmcnt(0) lgkmcnt(0)" ::: "memory"); __builtin_amdgcn_s_barrier(); asm volatile("" ::: "memory"); }
    if (!S.next(0, cur)) return;
    f32x4 acc[2][2][4][2];
#pragma unroll
    for (int a = 0; a < 2; ++a)
#pragma unroll
        for (int b = 0; b < 2; ++b)
#pragma unroll
            for (int m = 0; m < 4; ++m)
#pragma unroll
                for (int n = 0; n < 2; ++n) acc[a][b][m][n] = (f32x4){0.f, 0.f, 0.f, 0.f};
    bf16x8 At[4][2], B0[2][2], B1[2][2]; i32x8 At8[4], B08[2], B18[2];
    int sclw = 0x7a7a7a7a, scla = scla_; asm volatile("" : "+v"(sclw), "+v"(scla));
    const char* cA = GATHER ? (const char*)Aptr : (const char*)Aptr + (size_t)cur.pm * tstep;
    const char* cB = (const char*)Btptr + ((size_t)cur.e * NBT + cur.pn) * tstep;
    if constexpr (GATHER) { PG8_GOFFS(gc, cur); PG8_GOFFS(gn, cur); }
    if constexpr (Epi::HAS_PRE) { if (wid == 0) E.pre(cur, lds + PRE_OFF, lane); }
    static_assert(SP2, "only the SP2 loop is kept here");
    PG8_STAGE(PG8_SB(0, 0), cB, voffB); PG8_STAGE(PG8_SB(0, 1), cB + hstep, voffB); PG8_STAGE_A(PG8_SA(0, 0), cA, 0, false); PG8_STAGE_A(PG8_SA(0, 1), cA, 1, false);
    if (wr == 1) PG8_BAR;
    PG8_WAIT_V(2); PG8_BAR;
    PG8_STAGE(PG8_SB(1, 0), cB + kstep, voffB); PG8_STAGE_A(PG8_SA(1, 0), cA + kstep, 0, false); PG8_STAGE(PG8_SB(1, 1), cB + hstep + kstep, voffB);
    PG8_WAIT_V(6); PG8_BAR;
    if constexpr (Epi::HAS_PRE) E.init(acc, (const LAS float*)(lds + PRE_OFF), wc, fq);
    for (;;) {
        bool has_next = false; const char* nA = cA; const char* nB = cB;
        if constexpr (Epi::HAS_ROWS) E.rows(cur, lds + ROWS_OFF + (ui & 1) * 2048, wid, lane);
        if constexpr (Sched::LAZY) { S.prefetch(ui + 1); }
        else { has_next = S.next(ui + 1, nxt);
            nA = GATHER ? (const char*)Aptr : (has_next ? (const char*)Aptr + (size_t)nxt.pm * tstep : cA);
            nB = has_next ? (const char*)Btptr + ((size_t)nxt.e * NBT + nxt.pn) * tstep : cB;
            if constexpr (GATHER) { if (has_next) { PG8_GOFFS(gn, nxt); } }
            if constexpr (Epi::HAS_PRE) { if (has_next && wid == 0) E.pre(nxt, lds + PRE_OFF + ((ui + 1) & 1) * 1024, lane); } }
        for (int t = 0; t < nt; t += 2) {
            const bool last = (t == nt - 2);
            if constexpr (Sched::LAZY) { if (last) { has_next = S.next(ui + 1, nxt);
                nA = has_next ? (const char*)Aptr + (size_t)nxt.pm * tstep : cA; nB = has_next ? (const char*)Btptr + ((size_t)nxt.e * NBT + nxt.pn) * tstep : cB; } }
            const char* a1 = cA + (size_t)(t + 1) * kstep;
            const char* a2 = last ? nA : cA + (size_t)(t + 2) * kstep; const char* b2 = last ? nB : cB + (size_t)(t + 2) * kstep;
            const char* a3 = a2 + kstep; const char* b3 = b2 + kstep;
            const bool usen = last && has_next;
#define XLDB0(b, h) do { if constexpr (F8) { PG8_LDB8(B08, b, h); } else { PG8_LDB(B0, b, h); } } while (0)
#define XLDB1(b, h) do { if constexpr (F8) { PG8_LDB8(B18, b, h); } else { PG8_LDB(B1, b, h); } } while (0)
#define XLDA(b, h) do { if constexpr (F8) { PG8_LDA8(At8, b, h); } else { PG8_LDA(At, b, h); } } while (0)
#define XMMA0(ai) do { if constexpr (F8) { PG8_MMA8(ai, 0, At8, B08); } else { PG8_MMA(ai, 0, At, B0); } } while (0)
#define XMMA1(ai) do { if constexpr (F8) { PG8_MMA8(ai, 1, At8, B18); } else { PG8_MMA(ai, 1, At, B1); } } while (0)
            XLDB0(0, 0); XLDB1(0, 1); PG8_SCHED; XLDA(0, 0); PG8_STAGE_A(PG8_SA(1, 1), a1, 1, false);
            PG8_WAIT_V(8); PG8_WAIT_L(0); PG8_BAR; XMMA0(0); XMMA1(0); PG8_BAR; PG8_SCHED;
            XLDA(0, 1); PG8_STAGE(PG8_SB(0, 0), b2, voffB); PG8_STAGE(PG8_SB(0, 1), b2 + hstep, voffB); PG8_STAGE_A(PG8_SA(0, 0), a2, 0, usen);
            PG8_WAIT_V(8); PG8_WAIT_L(0); PG8_BAR; XMMA0(1); XMMA1(1); PG8_BAR; PG8_SCHED;
            XLDB0(1, 0); XLDB1(1, 1); PG8_SCHED; XLDA(1, 0); PG8_STAGE_A(PG8_SA(0, 1), a2, 1, usen);
            PG8_WAIT_V(8); PG8_WAIT_L(0); PG8_BAR; XMMA0(0); XMMA1(0); PG8_BAR; PG8_SCHED;
            XLDA(1, 1); PG8_STAGE(PG8_SB(1, 0), b3, voffB); PG8_STAGE(PG8_SB(1, 1), b3 + hstep, voffB); PG8_STAGE_A(PG8_SA(1, 0), a3, 0, usen);
            PG8_WAIT_V(8); PG8_WAIT_L(0); PG8_BAR; XMMA0(1); XMMA1(1); PG8_BAR; PG8_SCHED;
#undef XLDB0
#undef XLDB1
#undef XLDA
#undef XMMA0
#undef XMMA1
        }
        if constexpr (ALIGN_EPI) { if (wr == 0) PG8_BAR; }
        if constexpr (F8) asm volatile("s_nop 15\n\ts_nop 7" ::: "memory");
        if constexpr (Epi::HAS_ROWS) E(acc, cur, wr, wc, fr, fq, lds + ROWS_OFF + (ui & 1) * 2048); else E(acc, cur, wr, wc, fr, fq);
        if (!has_next) break;
        if constexpr (Epi::HAS_PRE) E.init(acc, (const LAS float*)(lds + PRE_OFF + ((ui + 1) & 1) * 1024), wc, fq);
        else if (!Epi::keeps(cur)) {
#pragma unroll
        for (int a = 0; a < 2; ++a)
#pragma unroll
            for (int b = 0; b < 2; ++b)
#pragma unroll
                for (int m = 0; m < 4; ++m)
#pragma unroll
                    for (int n = 0; n < 2; ++n) acc[a][b][m][n] = (f32x4){0.f, 0.f, 0.f, 0.f};
        }
        cur = nxt; cA = nA; cB = nB; ++ui;
        if constexpr (GATHER) {
#pragma unroll
            for (int h = 0; h < 2; ++h)
#pragma unroll
                for (int i = 0; i < 2; ++i) gc[h][i] = gn[h][i];
        }
        if constexpr (ALIGN_EPI) { if (wr == 1) PG8_BAR; }
    }
    PG8_WAIT_V(0);
    if constexpr (!ALIGN_EPI) { if (wr == 0) PG8_BAR; }
    PG8_BAR;
#undef PG8_SA
#undef PG8_SB
#undef PG8_GLDS
#undef PG8_STAGE
#undef PG8_STAGE_A
#undef PG8_GOFFS
#undef PG8_LDA
#undef PG8_LDA8
#undef PG8_LDB8
#undef PG8_MMA8
#undef PG8_LDB
#undef PG8_MMA
#undef PG8_WAIT_V
#undef PG8_WAIT_L
#undef PG8_BAR
#undef PG8_SCHED
}
}

__device__ __forceinline__ u32x4 swap16_pair(u32x2 x, u32x2 y) {
    const auto lo = __builtin_amdgcn_permlane16_swap(x.x, y.x, false, false);
    const auto hi = __builtin_amdgcn_permlane16_swap(x.y, y.y, false, false);
    u32x4 r; r.x = lo[0]; r.y = hi[0]; r.z = lo[1]; r.w = hi[1]; return r;
}

typedef f32x4 AccT[2][2][4][2];

struct EpiInProj {
    static constexpr bool PERM = true, HAS_PRE = false, HAS_ROWS = true;
    __device__ __forceinline__ static bool keeps(const pg8::Unit&) { return false; }
    const float* rstd; const float* qa_g; const float* ka_g; const unsigned* csA; const unsigned* csB;
    unsigned char *QA; bf16_t *KA, *VA; unsigned char *QB; bf16_t *KB, *VB; unsigned char *GA, *GB;
    __device__ __forceinline__ static void store16(bf16_t* rp, const f32x4 (&v)[2][2]) {
#pragma unroll
        for (int bj = 0; bj < 2; ++bj) { u32x4 w; w.x = pk2(v[bj][0][0], v[bj][0][1]); w.y = pk2(v[bj][0][2], v[bj][0][3]); w.z = pk2(v[bj][1][0], v[bj][1][1]); w.w = pk2(v[bj][1][2], v[bj][1][3]);
            *(u32x4*)(rp + 32 * bj) = w; }
    }
    __device__ __forceinline__ static void store_tile(bf16_t* buf, int tmode, int kvh, int row, int fq, const f32x4 (&v)[2][2]) {
        const int t = row & (SEQ - 1), bb = row >> 13, r = t & 63; char* tb = (char*)buf + ((size_t)((bb * NKVH + kvh) * (SEQ / 64) + (t >> 6))) * 8192;
#pragma unroll
        for (int bj = 0; bj < 2; ++bj) { u32x4 w; w.x = pk2(v[bj][0][0], v[bj][0][1]); w.y = pk2(v[bj][0][2], v[bj][0][3]); w.z = pk2(v[bj][1][0], v[bj][1][1]); w.w = pk2(v[bj][1][2], v[bj][1][3]);
            const int off = (tmode == 1) ? ((4 * bj + fq) * 1024 + r * 16) : ((bj * 4 + (r >> 4)) * 1024 + (r & 15) * 64 + 16 * fq);
            *(u32x4*)(tb + off) = w; }
    }
    __device__ __forceinline__ void rows(const pg8::Unit& u, LAS unsigned char* dst, int wid, int lane) const {
        if (wid == 0) __builtin_amdgcn_global_load_lds((const unsigned*)(rstd + u.pm * 256 + lane * 4), (LAS unsigned*)dst, 16, 0, 0);
    }
    __device__ __forceinline__ void operator()(const AccT& acc, const pg8::Unit& u, int wr, int wc, int fr, int fq, const LAS unsigned char* rl) const {
        const LAS float* rsl = (const LAS float*)rl + wr * 64 + fr;
        const int s = 4 * u.pn + wc;
        int kind; bf16_t* dst; int pitch; const float* gain = nullptr; const unsigned* ct = nullptr; float qs = 1.f; int tmode = 0, kvh_ = 0;
        unsigned char* qdst = nullptr;
        if (s < 8) { kind = 0; dst = nullptr; qdst = QA + s * 64; pitch = QW; gain = qa_g; ct = csA; qs = C2 * 8.0f; }
        else if (s < 10) { kind = 0; dst = KA; pitch = KVW; gain = ka_g; ct = csA; tmode = 1; kvh_ = s - 8; }
        else if (s < 12) { kind = 2; dst = VA; pitch = KVW; tmode = 2; kvh_ = s - 10; }
        else if (s < 20) { kind = 1; dst = nullptr; qdst = QB + (s - 12) * 64; pitch = QW; ct = csB; qs = C2 * 8.0f; }
        else if (s < 22) { kind = 1; dst = KB; pitch = KVW; ct = csB; tmode = 1; kvh_ = s - 20; }
        else if (s < 24) { kind = 2; dst = VB; pitch = KVW; tmode = 2; kvh_ = s - 22; }
        else { kind = 3; dst = nullptr; pitch = DM; }
        unsigned char* gdst = (s < 40) ? GA + (s - 24) * 64 : GB + (s - 40) * 64;
        const int row0 = u.pm * 256 + wr * 64 + fr;
        if (kind >= 2) {
#pragma unroll
            for (int ai = 0; ai < 2; ++ai) {
                float rs[2][4];
#pragma unroll
                for (int m = 0; m < 4; ++m) rs[ai][m] = rsl[ai * 128 + m * 16];
#pragma unroll
                for (int m = 0; m < 4; ++m) {
                    const int row = row0 + ai * 128 + m * 16; f32x4 v[2][2];
#pragma unroll
                    for (int bj = 0; bj < 2; ++bj)
#pragma unroll
                        for (int n = 0; n < 2; ++n) {
                            if (kind == 3) { const float rsn = rs[ai][m] * -1.4426950408889634f;
#pragma unroll
                                for (int j = 0; j < 4; ++j) v[bj][n][j] = __builtin_amdgcn_rcpf(1.0f + __builtin_amdgcn_exp2f(acc[ai][bj][m][n][j] * rsn)); }
                            else v[bj][n] = acc[ai][bj][m][n] * rs[ai][m]; }
                    if (kind == 3) {
                        u32x2 w[2];
#pragma unroll
                        for (int bj = 0; bj < 2; ++bj) { w[bj].x = pk4_fp8(v[bj][0][0], v[bj][0][1], v[bj][0][2], v[bj][0][3]); w[bj].y = pk4_fp8(v[bj][1][0], v[bj][1][1], v[bj][1][2], v[bj][1][3]); }
                        const u32x4 q = swap16_pair(w[0], w[1]);
                        *(u32x4*)(gdst + (size_t)row * DM + (fq & 1) * 32 + 16 * (fq >> 1)) = q;
                    }
                    else if (tmode) store_tile(dst, tmode, kvh_, row, fq, v); else store16(dst + (size_t)row * pitch + 8 * fq, v);
                }
            }
            return;
        }
        f32x4 gv[2][2];
        if (kind == 0) {
#pragma unroll
            for (int bj = 0; bj < 2; ++bj)
#pragma unroll
                for (int n = 0; n < 2; ++n) gv[bj][n] = *(const f32x4*)(gain + 32 * bj + 8 * fq + 4 * n);
        }
#pragma unroll
        for (int hm = 0; hm < 4; ++hm) {
            const int ai = hm >> 1, m0 = (hm & 1) * 2;
            float rs[2][4]; rs[ai][m0] = rsl[ai * 128 + m0 * 16]; rs[ai][m0 + 1] = rsl[ai * 128 + (m0 + 1) * 16];
            u32x4 tb[2][2];
#pragma unroll
            for (int mm = 0; mm < 2; ++mm) { const int t = (row0 + ai * 128 + (m0 + mm) * 16) & (SEQ - 1);
#pragma unroll
                for (int n = 0; n < 2; ++n) tb[mm][n] = *(const u32x4*)(ct + t * 32 + 8 * fq + 4 * n); }
#pragma unroll
            for (int mm = 0; mm < 2; ++mm) {
                const int m = m0 + mm; const int row = row0 + ai * 128 + m * 16; f32x4 v[2][2];
#pragma unroll
                for (int bj = 0; bj < 2; ++bj)
#pragma unroll
                    for (int n = 0; n < 2; ++n) v[bj][n] = acc[ai][bj][m][n] * rs[ai][m];
                if (kind == 0) {
                    float ss = 0.f;
#pragma unroll
                    for (int bj = 0; bj < 2; ++bj)
#pragma unroll
                        for (int n = 0; n < 2; ++n) { const f32x4 x = v[bj][n]; ss += (x[0] * x[0] + x[1] * x[1]) + (x[2] * x[2] + x[3] * x[3]); }
                    ss = swap32_sum(swap16_sum(ss));
                    const float r = rsqrtf(ss * (1.0f / 64.0f) + EPS);
#pragma unroll
                    for (int bj = 0; bj < 2; ++bj)
#pragma unroll
                        for (int n = 0; n < 2; ++n) v[bj][n] = v[bj][n] * r * gv[bj][n];
                }
#pragma unroll
                for (int n = 0; n < 2; ++n) { const f32x4 x1 = v[0][n], x2 = v[1][n]; const u32x4 w = tb[mm][n];
                    const f32x4 c_ = {bflo(w.x), bflo(w.y), bflo(w.z), bflo(w.w)}, s_ = {bfhi(w.x), bfhi(w.y), bfhi(w.z), bfhi(w.w)};
                    v[0][n] = (x1 * c_ - x2 * s_) * qs; v[1][n] = (x2 * c_ + x1 * s_) * qs; }
                if (tmode) store_tile(dst, tmode, kvh_, row, fq, v);
                else {
                    u32x2 w[2];
#pragma unroll
                    for (int bj = 0; bj < 2; ++bj) { w[bj].x = pk4_fp8(v[bj][0][0], v[bj][0][1], v[bj][0][2], v[bj][0][3]); w[bj].y = pk4_fp8(v[bj][1][0], v[bj][1][1], v[bj][1][2], v[bj][1][3]); }
                    const u32x4 q = swap16_pair(w[0], w[1]);
                    *(u32x4*)(qdst + (size_t)row * QW + (fq & 1) * 32 + 16 * (fq >> 1)) = q;
                }
            }
        }
    }
};

template <bool FIRST> struct EpiGate {
    static constexpr bool PERM = true, HAS_PRE = false, HAS_ROWS = false;
    __device__ __forceinline__ static bool keeps(const pg8::Unit&) { return false; }
    const bf16_t* G; bf16_t* O;
    __device__ __forceinline__ void operator()(const AccT& acc, const pg8::Unit& u, int wr, int wc, int fr, int fq) const {
#pragma unroll
        for (int ai = 0; ai < 2; ++ai)
#pragma unroll
            for (int m = 0; m < 4; ++m) {
                const size_t row = (size_t)(u.pm * 256 + ai * 128 + wr * 64 + m * 16 + fr);
#pragma unroll
                for (int bj = 0; bj < 2; ++bj) {
                    const size_t off = row * DM + u.pn * 256 + bj * 128 + wc * 32 + 8 * fq;
                    const u32x4 g = *(const u32x4*)(G + off);
                    f32x4 v0 = acc[ai][bj][m][0], v1 = acc[ai][bj][m][1];
                    v0[0] *= bflo(g.x); v0[1] *= bfhi(g.x); v0[2] *= bflo(g.y); v0[3] *= bfhi(g.y);
                    v1[0] *= bflo(g.z); v1[1] *= bfhi(g.z); v1[2] *= bflo(g.w); v1[3] *= bfhi(g.w);
                    if (!FIRST) { const u32x4 p = *(const u32x4*)(O + off);
                        v0[0] += bflo(p.x); v0[1] += bfhi(p.x); v0[2] += bflo(p.y); v0[3] += bfhi(p.y);
                        v1[0] += bflo(p.z); v1[1] += bfhi(p.z); v1[2] += bflo(p.w); v1[3] += bfhi(p.w); }
                    u32x4 w; w.x = pk2(v0[0], v0[1]); w.y = pk2(v0[2], v0[3]); w.z = pk2(v1[0], v1[1]); w.w = pk2(v1[2], v1[3]);
                    *(u32x4*)(O + off) = w;
                }
            }
    }
};

struct EpiGateFused {
    static constexpr bool PERM = true, HAS_PRE = false, HAS_ROWS = false;
    const unsigned char* GA; const unsigned char* GB; unsigned char* O;
    __device__ __forceinline__ static bool keeps(const pg8::Unit& u) { return u.e == 0; }
    __device__ __forceinline__ void operator()(AccT& acc, const pg8::Unit& u, int wr, int wc, int fr, int fq) const {
        const size_t base = (size_t)(u.pml * 256 + wr * 64 + fr) * DM + u.pn * 256 + wc * 32 + 8 * fq;
        if (u.e == 0) {
#pragma unroll
            for (int ai = 0; ai < 2; ++ai)
#pragma unroll
                for (int m = 0; m < 4; ++m)
#pragma unroll
                    for (int bj = 0; bj < 2; ++bj) {
                        const size_t off = base + (size_t)(ai * 128 + m * 16) * DM + bj * 128;
                        const u32x2 a = *(const u32x2*)(GA + off), b = *(const u32x2*)(GB + off);
                        const f32x2 a0 = __builtin_amdgcn_cvt_pk_f32_fp8((int)a.x, false), a1 = __builtin_amdgcn_cvt_pk_f32_fp8((int)a.x, true), a2 = __builtin_amdgcn_cvt_pk_f32_fp8((int)a.y, false), a3 = __builtin_amdgcn_cvt_pk_f32_fp8((int)a.y, true);
                        const f32x2 b0 = __builtin_amdgcn_cvt_pk_f32_fp8((int)b.x, false), b1 = __builtin_amdgcn_cvt_pk_f32_fp8((int)b.x, true), b2 = __builtin_amdgcn_cvt_pk_f32_fp8((int)b.y, false), b3 = __builtin_amdgcn_cvt_pk_f32_fp8((int)b.y, true);
                        f32x4& v0 = acc[ai][bj][m][0]; f32x4& v1 = acc[ai][bj][m][1];
                        v0[0] *= b0.x * __builtin_amdgcn_rcpf(fmaxf(a0.x, 1e-30f)); v0[1] *= b0.y * __builtin_amdgcn_rcpf(fmaxf(a0.y, 1e-30f)); v0[2] *= b1.x * __builtin_amdgcn_rcpf(fmaxf(a1.x, 1e-30f)); v0[3] *= b1.y * __builtin_amdgcn_rcpf(fmaxf(a1.y, 1e-30f));
                        v1[0] *= b2.x * __builtin_amdgcn_rcpf(fmaxf(a2.x, 1e-30f)); v1[1] *= b2.y * __builtin_amdgcn_rcpf(fmaxf(a2.y, 1e-30f)); v1[2] *= b3.x * __builtin_amdgcn_rcpf(fmaxf(a3.x, 1e-30f)); v1[3] *= b3.y * __builtin_amdgcn_rcpf(fmaxf(a3.y, 1e-30f));
                    }
        } else {
#pragma unroll
            for (int ai = 0; ai < 2; ++ai)
#pragma unroll
                for (int m = 0; m < 4; ++m)
                {
                    u32x2 w[2];
#pragma unroll
                    for (int bj = 0; bj < 2; ++bj) {
                        const size_t off = base + (size_t)(ai * 128 + m * 16) * DM + bj * 128;
                        const u32x2 a = *(const u32x2*)(GA + off);
                        const f32x2 a0 = __builtin_amdgcn_cvt_pk_f32_fp8((int)a.x, false), a1 = __builtin_amdgcn_cvt_pk_f32_fp8((int)a.x, true), a2 = __builtin_amdgcn_cvt_pk_f32_fp8((int)a.y, false), a3 = __builtin_amdgcn_cvt_pk_f32_fp8((int)a.y, true);
                        const f32x4 v0 = acc[ai][bj][m][0] * 32.0f, v1 = acc[ai][bj][m][1] * 32.0f;
                        w[bj].x = pk4_fp8(v0[0] * a0.x, v0[1] * a0.y, v0[2] * a1.x, v0[3] * a1.y); w[bj].y = pk4_fp8(v1[0] * a2.x, v1[1] * a2.y, v1[2] * a3.x, v1[3] * a3.y);
                    }
                    const u32x4 q = swap16_pair(w[0], w[1]);
                    *(u32x4*)(O + (size_t)(u.pml * 256 + wr * 64 + fr + ai * 128 + m * 16) * DM + u.pn * 256 + (fq & 1) * 128 + wc * 32 + 16 * (fq >> 1)) = q;
                }
        }
    }
};

struct EpiResid {
    static constexpr bool PERM = true, HAS_PRE = false, HAS_ROWS = false;
    __device__ __forceinline__ static bool keeps(const pg8::Unit&) { return false; }
    const float* X; bf16_t* O;
    __device__ __forceinline__ void operator()(const AccT& acc, const pg8::Unit& u, int wr, int wc, int fr, int fq) const {
#pragma unroll
        for (int ai = 0; ai < 2; ++ai)
#pragma unroll
            for (int m = 0; m < 4; ++m) {
                const size_t row = (size_t)(u.pm * 256 + ai * 128 + wr * 64 + m * 16 + fr);
#pragma unroll
                for (int bj = 0; bj < 2; ++bj) {
                    const size_t off = row * DM + u.pn * 256 + bj * 128 + wc * 32 + 8 * fq;
                    const f32x4 v0 = *(const f32x4*)(X + off) + acc[ai][bj][m][0], v1 = *(const f32x4*)(X + off + 4) + acc[ai][bj][m][1];
                    u32x4 w; w.x = pk2(v0[0], v0[1]); w.y = pk2(v0[2], v0[3]); w.z = pk2(v1[0], v1[1]); w.w = pk2(v1[2], v1[3]);
                    *(u32x4*)(O + off) = w;
                }
            }
    }
};

struct EpiSwiglu {
    static constexpr bool PERM = true, HAS_PRE = true, HAS_ROWS = false;
    __device__ __forceinline__ static bool keeps(const pg8::Unit&) { return false; }
    const float* bgu; unsigned char* ACT;
    __device__ __forceinline__ void pre(const pg8::Unit& u, LAS unsigned char* dst, int lane) const {
        const float* src = bgu + (size_t)u.e * 2048 + (lane >> 5) * 1024 + u.pn * 128 + 4 * (lane & 31);
        __builtin_amdgcn_global_load_lds((const unsigned*)src, (LAS unsigned*)dst, 16, 0, 0);
    }
    __device__ __forceinline__ void init(AccT& acc, const LAS float* pb, int wc, int fq) const {
        const int cl = wc * 32 + 8 * fq;
#pragma unroll
        for (int n = 0; n < 2; ++n) { const f32x4 bg = *(const LAS f32x4*)(pb + cl + 4 * n) * SWI_C, bu = (*(const LAS f32x4*)(pb + 128 + cl + 4 * n) + 1.0f) * (1.0f / SWI_C);
#pragma unroll
            for (int ai = 0; ai < 2; ++ai)
#pragma unroll
                for (int m = 0; m < 4; ++m) { acc[ai][0][m][n] = bg; acc[ai][1][m][n] = bu; } }
    }
    __device__ __forceinline__ void operator()(const AccT& acc, const pg8::Unit& u, int wr, int wc, int fr, int fq) const {
#pragma unroll
        for (int ai = 0; ai < 2; ++ai)
#pragma unroll
            for (int mp = 0; mp < 2; ++mp) {
                u32x2 w[2];
#pragma unroll
                for (int mm = 0; mm < 2; ++mm) { const int m = 2 * mp + mm; float a[8];
#pragma unroll
                    for (int n = 0; n < 2; ++n)
#pragma unroll
                        for (int j = 0; j < 4; ++j) {
                            const float g = fmaxf(acc[ai][0][m][n][j], 7.0f * SWI_C), up1 = __builtin_amdgcn_fmed3f(acc[ai][1][m][n][j], 8.0f / SWI_C, -6.0f / SWI_C);
                            a[4 * n + j] = up1 * (g * __builtin_amdgcn_rcpf(1.0f + __builtin_amdgcn_exp2f(g)));
                        }
                    w[mm].x = pk4_fp8(a[0], a[1], a[2], a[3]); w[mm].y = pk4_fp8(a[4], a[5], a[6], a[7]); }
                const u32x4 q = swap16_pair(w[0], w[1]);
                const size_t row = (size_t)(u.pm * 256 + ai * 128 + wr * 64 + (2 * mp + (fq & 1)) * 16 + fr);
                *(u32x4*)(ACT + row * DFF + u.pn * 128 + wc * 32 + 16 * (fq >> 1)) = q;
            }
    }
};

struct EpiDown {
    static constexpr bool PERM = true, HAS_PRE = true, HAS_ROWS = true;
    __device__ __forceinline__ static bool keeps(const pg8::Unit&) { return false; }
    const float* bd; const u32x2* list2; const LAS int* cnt; unsigned char* Y;
    __device__ __forceinline__ void pre(const pg8::Unit& u, LAS unsigned char* dst, int lane) const {
        const float* src = bd + (size_t)u.e * DM + u.pn * 256 + 4 * lane;
        __builtin_amdgcn_global_load_lds((const unsigned*)src, (LAS unsigned*)dst, 16, 0, 0);
    }
    __device__ __forceinline__ void init(AccT& acc, const LAS float* pb, int wc, int fq) const {
        const int cl = wc * 32 + 8 * fq;
#pragma unroll
        for (int bj = 0; bj < 2; ++bj)
#pragma unroll
            for (int n = 0; n < 2; ++n) { const f32x4 bv = *(const LAS f32x4*)(pb + bj * 128 + cl + 4 * n);
#pragma unroll
                for (int ai = 0; ai < 2; ++ai)
#pragma unroll
                    for (int m = 0; m < 4; ++m) acc[ai][bj][m][n] = bv; }
    }
    __device__ __forceinline__ void rows(const pg8::Unit& u, LAS unsigned char* dst, int wid, int lane) const {
        if (wid < 2) __builtin_amdgcn_global_load_lds((const unsigned*)(list2 + (size_t)u.e * MTOK + u.pml * 256 + wid * 128 + lane * 2), (LAS unsigned*)(dst + wid * 1024), 16, 0, 0);
    }
    __device__ __forceinline__ void operator()(const AccT& acc, const pg8::Unit& u, int wr, int wc, int fr, int fq, const LAS unsigned char* rl) const {
        const int ne = cnt[u.e];
        u32x2 sg[2][4];
#pragma unroll
        for (int ai = 0; ai < 2; ++ai)
#pragma unroll
            for (int m = 0; m < 4; ++m) { const int rloc = ai * 128 + wr * 64 + m * 16 + fr;
                sg[ai][m] = *(const LAS u32x2*)(rl + rloc * 8); if (u.pml * 256 + rloc >= ne) sg[ai][m].x = 0xffffffffu; }
#pragma unroll
        for (int ai = 0; ai < 2; ++ai)
#pragma unroll
            for (int m = 0; m < 4; ++m) {
                const float gg = __uint_as_float(sg[ai][m].y) * 4.0f;
                u32x2 w[2];
#pragma unroll
                for (int bj = 0; bj < 2; ++bj) {
                    const f32x4 v0 = acc[ai][bj][m][0] * gg, v1 = acc[ai][bj][m][1] * gg;
                    w[bj].x = pk4_fp8(v0[0], v0[1], v0[2], v0[3]); w[bj].y = pk4_fp8(v1[0], v1[1], v1[2], v1[3]); }
                const u32x4 q = swap16_pair(w[0], w[1]);
                if (sg[ai][m].x != 0xffffffffu)
                    *(u32x4*)(Y + (size_t)sg[ai][m].x * DM + u.pn * 256 + (fq & 1) * 128 + wc * 32 + 16 * (fq >> 1)) = q;
            }
    }
};

namespace attn_body {
using bf16 = __hip_bfloat16;
using s16x4 = __attribute__((ext_vector_type(4))) short;
using f32x16 = __attribute__((ext_vector_type(16))) float;
constexpr int D = 64, QP = QW, KP = KVW;
constexpr int NW = 8, QBLK = 32, QB = QBLK * NW, KVBLK = 64;
__device__ __forceinline__ int crow(int r, int hi) { return (r & 3) + 8 * (r >> 2) + 4 * hi; }
#define SBAR() __builtin_amdgcn_sched_barrier(0)
constexpr int NSLOT = 3, SLOTB = 8192;
constexpr int LDS_K = 0, LDS_V = NSLOT * SLOTB, LDS_WS = 2 * NSLOT * SLOTB, LDS_OST = LDS_WS + NW * 64 * 4, LDS_BYTES = LDS_OST + NW * 4096;
__device__ __forceinline__ void glds16(const void* gsrc, unsigned lds_dst) { unsigned keep;
    asm volatile("s_mov_b32 %0, m0\n\ts_mov_b32 m0, %2\n\ts_nop 0\n\tglobal_load_lds_dwordx4 %1, off\n\ts_mov_b32 m0, %0" : "=&s"(keep) : "v"(gsrc), "s"(lds_dst) : "memory"); }
__device__ __forceinline__ float max3f(float a, float b, float c) { float r; asm("v_max3_f32 %0, %1, %2, %3" : "=v"(r) : "v"(a), "v"(b), "v"(c)); return r; }
__device__ __forceinline__ float max2f(float a, float b) { float r; asm("v_max_f32_e32 %0, %1, %2" : "=v"(r) : "v"(a), "v"(b)); return r; }
__device__ __forceinline__ float fadd_s(float a, float b) { float r; asm("v_add_f32_e32 %0, %1, %2" : "=v"(r) : "v"(a), "v"(b)); return r; }
__device__ __forceinline__ float fsub_s(float a, float b) { float r; asm("v_sub_f32_e32 %0, %1, %2" : "=v"(r) : "v"(a), "v"(b)); return r; }
typedef float f32x2_t __attribute__((ext_vector_type(2))); typedef __bf16 bf16x2_t __attribute__((ext_vector_type(2)));
__device__ __forceinline__ unsigned cvtpk_s(float lo, float hi) { f32x2_t v = {lo, hi}; bf16x2_t b = __builtin_convertvector(v, bf16x2_t); return __builtin_bit_cast(unsigned, b); }
#define WAIT_BAR(N) asm volatile("s_waitcnt vmcnt(" #N ") lgkmcnt(0)\n\ts_barrier" ::: "memory")

__device__ __forceinline__ void qkt(f32x16& p0, f32x16& p1, const char* Kslot, const bf16x8* qr, const f32x16& negm, int r32, int hi) {
    const char* kb = Kslot + hi * 1024 + r32 * 16;
#pragma unroll
    for (int d0 = 0; d0 < 4; ++d0) {
        const bf16x8 b0 = *reinterpret_cast<const bf16x8*>(kb + d0 * 2048);
        const bf16x8 b1 = *reinterpret_cast<const bf16x8*>(kb + d0 * 2048 + 512);
        if (d0 == 0) { p0 = __builtin_amdgcn_mfma_f32_32x32x16_bf16(b0, qr[0], negm, 0, 0, 0); p1 = __builtin_amdgcn_mfma_f32_32x32x16_bf16(b1, qr[0], negm, 0, 0, 0); }
        else { p0 = __builtin_amdgcn_mfma_f32_32x32x16_bf16(b0, qr[d0], p0, 0, 0, 0); p1 = __builtin_amdgcn_mfma_f32_32x32x16_bf16(b1, qr[d0], p1, 0, 0, 0); } }
}
typedef __attribute__((address_space(3))) const char* lds_cptr;
typedef short v4i16_t __attribute__((ext_vector_type(4)));
__device__ __forceinline__ void kload8(bf16x8* kf, lds_cptr kp) {
    kf[0] = *(const LAS bf16x8*)(kp);        kf[1] = *(const LAS bf16x8*)(kp + 512);
    kf[2] = *(const LAS bf16x8*)(kp + 2048); kf[3] = *(const LAS bf16x8*)(kp + 2560);
    kf[4] = *(const LAS bf16x8*)(kp + 4096); kf[5] = *(const LAS bf16x8*)(kp + 4608);
    kf[6] = *(const LAS bf16x8*)(kp + 6144); kf[7] = *(const LAS bf16x8*)(kp + 6656);
}
__device__ __forceinline__ void kload2(bf16x8* kf, lds_cptr kp, int j) { kf[2 * j] = *(const LAS bf16x8*)(kp + j * 2048); kf[2 * j + 1] = *(const LAS bf16x8*)(kp + j * 2048 + 512); }
__device__ __forceinline__ s16x4 vtr(lds_cptr p) { return __builtin_bit_cast(s16x4, __builtin_amdgcn_ds_read_tr16_b64_v4i16((LAS v4i16_t*)p)); }
__device__ __forceinline__ float rowmax(const f32x16& p0, const f32x16& p1) {
    float a = max3f(p0[0], p0[1], p1[0]), b = max3f(p0[2], p0[3], p1[1]); a = max3f(a, p1[2], p1[3]);
#pragma unroll
    for (int r = 4; r < 16; r += 4) { a = max3f(a, p0[r], p0[r + 1]); b = max3f(b, p0[r + 2], p0[r + 3]); a = max3f(a, p1[r], p1[r + 1]); b = max3f(b, p1[r + 2], p1[r + 3]); }
    const float m = max2f(a, b);
    auto rr = __builtin_amdgcn_permlane32_swap(__float_as_uint(m), __float_as_uint(m), false, false);
    return max2f(__uint_as_float(rr[0]), __uint_as_float(rr[1]));
}
__device__ __forceinline__ void pv(f32x16* o, int vb, bf16x8 pa0, bf16x8 pa1, bf16x8 pa2, bf16x8 pa3) {
#pragma unroll
    for (int d0 = 0; d0 < 2; ++d0) { s16x4 lo[4], hi[4];
#pragma unroll
        for (int ks = 0; ks < 4; ++ks) {
            asm volatile("ds_read_b64_tr_b16 %0,%1 offset:%c2" : "=&v"(lo[ks]) : "v"(vb), "i"(d0 * 4096 + ks * 1024) : "memory");
            asm volatile("ds_read_b64_tr_b16 %0,%1 offset:%c2" : "=&v"(hi[ks]) : "v"(vb), "i"(d0 * 4096 + ks * 1024 + 512) : "memory"); }
        asm volatile("s_waitcnt lgkmcnt(0)" ::: "memory"); SBAR();
#define PK(k) (bf16x8){lo[k][0], lo[k][1], lo[k][2], lo[k][3], hi[k][0], hi[k][1], hi[k][2], hi[k][3]}
        o[d0] = __builtin_amdgcn_mfma_f32_32x32x16_bf16(pa0, PK(0), o[d0], 0, 0, 0);
        o[d0] = __builtin_amdgcn_mfma_f32_32x32x16_bf16(pa1, PK(1), o[d0], 0, 0, 0);
        o[d0] = __builtin_amdgcn_mfma_f32_32x32x16_bf16(pa2, PK(2), o[d0], 0, 0, 0);
        o[d0] = __builtin_amdgcn_mfma_f32_32x32x16_bf16(pa3, PK(3), o[d0], 0, 0, 0);
#undef PK
    }
}
__device__ __forceinline__ void wmask(f32x16& p0, f32x16& p1, int base) {
    const float NEG = -INFINITY;
#pragma unroll
    for (int r = 0; r < 16; ++r) { const int d0 = base + (r & 3) + 8 * (r >> 2), d1 = d0 + 32;
        if (d0 > 128 || d0 < -128) p0[r] = NEG; if (d1 > 128 || d1 < -128) p1[r] = NEG; }
}

template <int MODE, int THRL, bool NOMAX = false> __device__ __forceinline__ void attn_unit(int b, int h, int qb, const unsigned char* Q, const bf16* __restrict__ K, const bf16* __restrict__ V, unsigned char* O, char* shm, int wave_, float sink2, float mref = 0.f) {
    const int wid = wave_, lane = lane_fresh(), tid = wid * 64 + lane, r32 = lane & 31, hi = lane >> 5;
    const long rowbase = (long)b * SEQ; const int q0 = qb * QB; const int kvh = h >> 2;
    int kt0 = 0, NT = SEQ / KVBLK;
    if (MODE == 1) { kt0 = 4 * qb - 2; int kt1 = 4 * qb + 6; if (kt0 < 0) kt0 = 0; if (kt1 > SEQ / KVBLK) kt1 = SEQ / KVBLK; NT = kt1 - kt0; }
    const unsigned char* Qw = Q + (rowbase + q0 + wid * QBLK) * QP + h * D;
    const unsigned lds0 = (unsigned)(uintptr_t)shm;
    float* wsf = (float*)(shm + LDS_WS) + wid * 64;
    const char* ksrc = (const char*)K + ((size_t)((b * NKVH + kvh) * (SEQ / KVBLK) + kt0)) * 8192 + wid * 1024 + lane * 16;
    const char* vsrc = (const char*)V + ((size_t)((b * NKVH + kvh) * (SEQ / KVBLK) + kt0)) * 8192 + wid * 1024 + lane * 16;
    const unsigned kdst = lds0 + LDS_K + wid * 1024, vdst = lds0 + LDS_V + wid * 1024;
#define DMA_K(t, slot) glds16(ksrc + (size_t)(t) * 8192, (unsigned)__builtin_amdgcn_readfirstlane(kdst + (slot)))
#define DMA_V(t, slot) glds16(vsrc + (size_t)(t) * 8192, (unsigned)__builtin_amdgcn_readfirstlane(vdst + (slot)))
    const int vb0 = (int)(lds0 + LDS_V) + ((lane >> 4) & 1) * 32 + (lane & 3) * 8 + (4 * hi + ((lane & 15) >> 2)) * 64;
    const char* Kbase = shm + LDS_K; bf16x8 kf[8];
    const lds_cptr shm3 = (lds_cptr)shm; const lds_cptr kp0 = shm3 + LDS_K + hi * 1024 + r32 * 16; const lds_cptr vp0 = shm3 + LDS_V + ((lane >> 4) & 1) * 32 + (lane & 3) * 8 + (4 * hi + ((lane & 15) >> 2)) * 64;
    DMA_K(0, 0); DMA_V(0, 0); DMA_K(1, SLOTB);
    bf16x8 qr[4];
#pragma unroll
    for (int d0 = 0; d0 < 4; ++d0) { const u32x2 w8 = *reinterpret_cast<const u32x2*>(&Qw[(long)r32 * QP + d0 * 16 + hi * 8]);
        const f32x2_t a0 = __builtin_amdgcn_cvt_pk_f32_fp8((int)w8.x, false), a1 = __builtin_amdgcn_cvt_pk_f32_fp8((int)w8.x, true), a2 = __builtin_amdgcn_cvt_pk_f32_fp8((int)w8.y, false), a3 = __builtin_amdgcn_cvt_pk_f32_fp8((int)w8.y, true);
        const u32x4 qw = {cvtpk_s(a0.x * 0.125f, a0.y * 0.125f), cvtpk_s(a1.x * 0.125f, a1.y * 0.125f), cvtpk_s(a2.x * 0.125f, a2.y * 0.125f), cvtpk_s(a3.x * 0.125f, a3.y * 0.125f)};
        qr[d0] = __builtin_bit_cast(bf16x8, qw); }
    float mhat = 0.f, l_reg = 0.f; f32x16 o[2]; o[0] = f32x16{}; o[1] = f32x16{}; f32x16 negm = f32x16{}; asm volatile("" : "+v"(negm));
    const int mbase = kt0 * KVBLK + 4 * hi - (q0 + wid * QBLK + r32);
#define CMASK(P0, P1, t) do { if (MODE == 1) wmask(P0, P1, mbase + (t) * KVBLK); } while (0)
    bool resc = false;
#define START(P0, P1) do { const float rm = NOMAX ? mref : rowmax(P0, P1); resc = false; \
    { const float dl = (MODE == 1) ? __builtin_fmaxf(rm, -500.f) : rm; mhat = fadd_s(mhat, dl); \
      _Pragma("unroll") for (int r = 0; r < 16; ++r) { P0[r] = fsub_s(P0[r], dl); P1[r] = fsub_s(P1[r], dl); } \
      _Pragma("unroll") for (int r = 0; r < 16; ++r) negm[r] = -mhat; asm volatile("" : "+v"(negm)); } \
    _Pragma("unroll") for (int r = 0; r < 16; ++r) P0[r] = __builtin_amdgcn_exp2f(P0[r]); } while (0)
#define RESC() do { if (resc) { asm volatile("s_waitcnt lgkmcnt(0)" ::: "memory"); \
      _Pragma("unroll") for (int d_ = 0; d_ < 2; ++d_) _Pragma("unroll") for (int r = 0; r < 16; ++r) o[d_][r] *= wsf[crow(r, hi)]; } } while (0)
    f32x16 pA0, pA1, pB0, pB1;
    int sl_prev = 0, sl_cur = 0, sl_next = SLOTB;
#define ROT() do { sl_prev = sl_cur; sl_cur = sl_next; sl_next = (sl_next == (NSLOT - 1) * SLOTB) ? 0 : sl_next + SLOTB; } while (0)
    DMA_K(2, 2 * SLOTB);
    WAIT_BAR(3);
    qkt(pA0, pA1, Kbase, qr, negm, r32, hi); asm volatile("s_nop 15\n\ts_nop 7" : "+v"(pA0), "+v"(pA1)); CMASK(pA0, pA1, 0);
    START(pA0, pA1);
    _Pragma("unroll") for (int r = 0; r < 16; ++r) pA1[r] = __builtin_amdgcn_exp2f(pA1[r]);
    WAIT_BAR(0);
    DMA_K(3, 0); DMA_V(1, SLOTB);
    ROT();
    kload8(kf, kp0 + sl_cur);
    WAIT_BAR(2);
    s16x4 vlo[8], vhi[8]; u32x4 pw0, pw1, pw2, pw3;
#define PKW(P, B) cvtpk_s(P[B], P[B + 1])
#define PAF(k) __builtin_bit_cast(bf16x8, pw##k)
#define VFR(i) (bf16x8){vlo[i][0], vlo[i][1], vlo[i][2], vlo[i][3], vhi[i][0], vhi[i][1], vhi[i][2], vhi[i][3]}
#define PIN(x) asm volatile("" : "+v"(x))
#define MX3(a, b, c) __builtin_fmaxf(__builtin_fmaxf((a), (b)), (c))
#define GAPA(MF, A0, A1, A2, A3, W0, W1, PW) do { MF; sacc += A0; sacc += A1; sacc += A2; sacc += A3; PIN(sacc); W0; W1; PIN(PW); SBAR(); } while (0)
#define EX(v) __builtin_amdgcn_exp2f(v)
#define GAPB(MF, X, B) do { MF; X[B] = EX(X[B]); X[B + 1] = EX(X[B + 1]); X[B + 2] = EX(X[B + 2]); X[B + 3] = EX(X[B + 3]); PIN(X); SBAR(); } while (0)
#define VRD(i) do { vlo[i] = vtr(vp_ + (((i) >> 2) * 4096 + ((i) & 3) * 1024)); vhi[i] = vtr(vp_ + (((i) >> 2) * 4096 + ((i) & 3) * 1024 + 512)); } while (0)
#define KRD(G, j) do { if (G) { kload2(kf, kp0 + sl_next, j); SBAR(); } } while (0)
#define STEP(C0, C1, P0, P1, t, GK, GV, GL) do { SBAR(); \
    const lds_cptr vp_ = vp0 + sl_prev; \
    VRD(0); SBAR(); float sacc = (P0[0] + P0[1]); \
    GAPA(C0 = __builtin_amdgcn_mfma_f32_32x32x16_bf16(kf[0], qr[0], negm, 0, 0, 0), P0[2], P0[3], P0[4], P0[5],     pw0[0] = PKW(P0, 0), pw0[1] = PKW(P0, 2), pw0); \
    VRD(4); SBAR(); GAPA(C1 = __builtin_amdgcn_mfma_f32_32x32x16_bf16(kf[1], qr[0], negm, 0, 0, 0), P0[6], P0[7], P0[8], P0[9],     pw0[2] = PKW(P0, 4), pw0[3] = PKW(P0, 6), pw0); \
    VRD(1); SBAR(); GAPA(C0 = __builtin_amdgcn_mfma_f32_32x32x16_bf16(kf[2], qr[1], C0, 0, 0, 0),   P0[10], P0[11], P0[12], P0[13], pw1[0] = PKW(P0, 8), pw1[1] = PKW(P0, 10), pw1); \
    VRD(5); SBAR(); GAPA(C1 = __builtin_amdgcn_mfma_f32_32x32x16_bf16(kf[3], qr[1], C1, 0, 0, 0),   P0[14], P0[15], P1[0], P1[1],   pw1[2] = PKW(P0, 12), pw1[3] = PKW(P0, 14), pw1); \
    VRD(2); SBAR(); GAPA(C0 = __builtin_amdgcn_mfma_f32_32x32x16_bf16(kf[4], qr[2], C0, 0, 0, 0),   P1[2], P1[3], P1[4], P1[5],     pw2[0] = PKW(P1, 0), pw2[1] = PKW(P1, 2), pw2); \
    VRD(6); SBAR(); GAPA(C1 = __builtin_amdgcn_mfma_f32_32x32x16_bf16(kf[5], qr[2], C1, 0, 0, 0),   P1[6], P1[7], P1[8], P1[9],     pw2[2] = PKW(P1, 4), pw2[3] = PKW(P1, 6), pw2); \
    VRD(3); SBAR(); GAPA(C0 = __builtin_amdgcn_mfma_f32_32x32x16_bf16(kf[6], qr[3], C0, 0, 0, 0),   P1[10], P1[11], P1[12], P1[13], pw3[0] = PKW(P1, 8), pw3[1] = PKW(P1, 10), pw3); \
    VRD(7); SBAR(); GAPA(C1 = __builtin_amdgcn_mfma_f32_32x32x16_bf16(kf[7], qr[3], C1, 0, 0, 0),   P1[14], P1[15], 0.f, 0.f,       pw3[2] = PKW(P1, 12), pw3[3] = PKW(P1, 14), pw3); \
    l_reg += sacc; \
    if (GK) { DMA_K((t) + 3, sl_cur); } if (GV) { DMA_V((t) + 1, sl_next); } \
    CMASK(C0, C1, t); \
    if (!NOMAX) { float a = MX3(C0[0], C0[1], C1[0]), b = MX3(C0[2], C0[3], C1[1]); a = MX3(a, C1[2], C1[3]); \
      _Pragma("unroll") for (int r = 4; r < 16; r += 4) { a = MX3(a, C0[r], C0[r + 1]); b = MX3(b, C0[r + 2], C0[r + 3]); a = MX3(a, C1[r], C1[r + 1]); b = MX3(b, C1[r + 2], C1[r + 3]); } \
      float rm = __builtin_fmaxf(a, b); { auto rr = __builtin_amdgcn_permlane32_swap(__float_as_uint(rm), __float_as_uint(rm), false, false); rm = __builtin_fmaxf(__uint_as_float(rr[0]), __uint_as_float(rr[1])); } \
      resc = false; \
      if (__builtin_expect(__any(rm > (float)THRL), 0)) { const float dl = __builtin_fmaxf(rm, 0.f); mhat += dl; \
        _Pragma("unroll") for (int r = 0; r < 16; ++r) { C0[r] -= dl; C1[r] -= dl; } \
        _Pragma("unroll") for (int r = 0; r < 16; ++r) negm[r] = -mhat; asm volatile("" : "+v"(negm)); \
        const float f = __builtin_amdgcn_exp2f(-dl); l_reg *= f; if (hi == 0) wsf[r32] = f; resc = true; } } \
    SBAR(); \
    GAPB(o[0] = __builtin_amdgcn_mfma_f32_32x32x16_bf16(PAF(0), VFR(0), o[0], 0, 0, 0), C0, 0); \
    GAPB(o[1] = __builtin_amdgcn_mfma_f32_32x32x16_bf16(PAF(0), VFR(4), o[1], 0, 0, 0), C0, 4); \
    KRD(GL, 0); GAPB(o[0] = __builtin_amdgcn_mfma_f32_32x32x16_bf16(PAF(1), VFR(1), o[0], 0, 0, 0), C0, 8); \
    KRD(GL, 1); GAPB(o[1] = __builtin_amdgcn_mfma_f32_32x32x16_bf16(PAF(1), VFR(5), o[1], 0, 0, 0), C0, 12); \
    KRD(GL, 2); GAPB(o[0] = __builtin_amdgcn_mfma_f32_32x32x16_bf16(PAF(2), VFR(2), o[0], 0, 0, 0), C1, 0); \
    KRD(GL, 3); GAPB(o[1] = __builtin_amdgcn_mfma_f32_32x32x16_bf16(PAF(2), VFR(6), o[1], 0, 0, 0), C1, 4); \
    GAPB(o[0] = __builtin_amdgcn_mfma_f32_32x32x16_bf16(PAF(3), VFR(3), o[0], 0, 0, 0), C1, 8); \
    GAPB(o[1] = __builtin_amdgcn_mfma_f32_32x32x16_bf16(PAF(3), VFR(7), o[1], 0, 0, 0), C1, 12); \
    } while (0)
    int t = 1;
    for (; t + 5 < NT; t += 2) {
        STEP(pB0, pB1, pA0, pA1, t, true, true, true);     WAIT_BAR(2); RESC(); ROT();
        STEP(pA0, pA1, pB0, pB1, t + 1, true, true, true); WAIT_BAR(2); RESC(); ROT();
    }
#define ENDW(tt) do { if ((tt) + 3 < NT) { WAIT_BAR(2); } else if ((tt) + 2 < NT) { WAIT_BAR(1); } else { WAIT_BAR(0); } } while (0)
    for (; t + 1 < NT; t += 2) {
        STEP(pB0, pB1, pA0, pA1, t, (t + 3 < NT), (t + 1 < NT), (t + 1 < NT));         ENDW(t);     RESC(); ROT();
        STEP(pA0, pA1, pB0, pB1, t + 1, (t + 4 < NT), (t + 2 < NT), (t + 2 < NT));     ENDW(t + 1); RESC(); ROT();
    }
    STEP(pB0, pB1, pA0, pA1, NT - 1, false, false, false); RESC();
    { float sacc = pB0[0] + pB0[1]; _Pragma("unroll") for (int r = 2; r < 16; ++r) sacc += pB0[r]; _Pragma("unroll") for (int r = 0; r < 16; ++r) sacc += pB1[r]; l_reg += sacc;
      pw0 = (u32x4){PKW(pB0, 0), PKW(pB0, 2), PKW(pB0, 4), PKW(pB0, 6)}; pw1 = (u32x4){PKW(pB0, 8), PKW(pB0, 10), PKW(pB0, 12), PKW(pB0, 14)}; pw2 = (u32x4){PKW(pB1, 0), PKW(pB1, 2), PKW(pB1, 4), PKW(pB1, 6)}; pw3 = (u32x4){PKW(pB1, 8), PKW(pB1, 10), PKW(pB1, 12), PKW(pB1, 14)};
      SBAR(); pv(o, vb0 + sl_cur, PAF(0), PAF(1), PAF(2), PAF(3)); }
#undef PKW
#undef PAF
#undef VFR
#undef PIN
#undef MX3
#undef GAPA
#undef GAPB
#undef EX
#undef VRD
#undef KRD
#undef STEP
#undef ENDW
    { auto rr = __builtin_amdgcn_permlane32_swap(__float_as_uint(l_reg), __float_as_uint(l_reg), false, false); l_reg = __uint_as_float(rr[0]) + __uint_as_float(rr[1]); }
    if (MODE == 1) l_reg += __builtin_amdgcn_exp2f(sink2 - mhat);
    if (hi == 0) wsf[32 + r32] = l_reg; asm volatile("s_waitcnt lgkmcnt(0)" ::: "memory");
    float rli[16];
#pragma unroll
    for (int r = 0; r < 16; ++r) rli[r] = __builtin_amdgcn_rcpf(wsf[32 + crow(r, hi)]);
    unsigned char* Ow = O + (rowbase + q0 + wid * QBLK) * QP + h * D;
    { unsigned char* stg = (unsigned char*)(shm + LDS_OST) + wid * 2048;
#pragma unroll
      for (int r = 0; r < 16; ++r) { const int orow = crow(r, hi); const float sc = rli[r] * 32.0f;
        const unsigned pk = (unsigned)__builtin_amdgcn_cvt_pk_fp8_f32(o[0][r] * sc, o[1][r] * sc, 0, false);
        stg[orow * 64 + r32] = (unsigned char)(pk & 0xffu); stg[orow * 64 + 32 + r32] = (unsigned char)((pk >> 8) & 0xffu); }
      asm volatile("s_waitcnt lgkmcnt(0)" ::: "memory");
#pragma unroll
      for (int i = 0; i < 2; ++i) { const int row = i * 16 + (lane >> 2), ch = lane & 3; const u32x4 v = *(const u32x4*)(stg + row * 64 + ch * 16); *(u32x4*)(Ow + (long)row * QP + ch * 16) = v; } }
    asm volatile("s_waitcnt lgkmcnt(0)\n\ts_barrier" ::: "memory");
#undef DMA_K
#undef DMA_V
#undef CMASK
#undef START
#undef RESC
#undef ROT
}
#undef SBAR
#undef WAIT_BAR
}

constexpr size_t MiB = 1u << 20;
constexpr size_t WS_CTL = 0, CTL_ZERO_BYTES = 1 * MiB;
constexpr size_t WS_RSTD = 1 * MiB;
constexpr size_t WS_ROPE = 2 * MiB;
constexpr size_t WS_GATEW = 6 * MiB;
constexpr size_t WS_LIST = 7 * MiB;
constexpr size_t WS_WIN = 10 * MiB;
constexpr size_t WS_WA = 18 * MiB, WS_WB = WS_WA + MiB / 2, WS_WOUT = 20 * MiB;
constexpr size_t WS_XB = 24 * MiB;
constexpr size_t WS_QA = 56 * MiB, WS_QB = 72 * MiB;
constexpr size_t WS_KA = 88 * MiB, WS_VA = 92 * MiB, WS_KB = 96 * MiB, WS_VB = 100 * MiB;
constexpr size_t WS_GA = 104 * MiB, WS_GB = 136 * MiB;
constexpr size_t WS_MERGED = 168 * MiB;
constexpr size_t WS_H2 = 200 * MiB;
constexpr size_t WS_WGU = 232 * MiB;
constexpr size_t WS_WD = 360 * MiB;
constexpr size_t WS_ACT = 424 * MiB;
constexpr size_t WS_Y = 568 * MiB;
constexpr size_t WS_OA = 696 * MiB, WS_OB = 704 * MiB;
constexpr size_t WS_X1 = 728 * MiB;
constexpr size_t WS_LIST2 = 792 * MiB;
constexpr size_t WS_END = 796 * MiB;
static_assert((size_t)ACT_ROWS * DFF * 2 <= WS_Y - WS_ACT, "ACT fits");
constexpr int CW_ECNT = 64;
constexpr int CW_TKT = 512;
constexpr int CW_BAR = 4096;

constexpr int RING_OFF = 0, RING_BYTES = 131072;
constexpr int LDSCTL_OFF = RING_BYTES;
constexpr int L_BARST = 0;
constexpr int L_TKT = 8;
constexpr int L_PRE = 16;
constexpr int L_CNT = 64;
constexpr int L_LCNT = 96;
constexpr int L_LBASE = 128;
constexpr int L_SELE = 256, L_SELR = 512, L_SELG = 768;
constexpr int LDS_BYTES = 147456;
static_assert(LDSCTL_OFF + 1024 * 4 <= LDS_BYTES, "LDS map");

#define XB_TMO      128
#define XB_XCNT(j)  (256  + 64 * (j))
#define XB_XSUB(j)  (1280 + 64 * (j))
#define XB_XGEN(j)  (2304 + 64 * (j))
#define XB_TOP      3328
#define XB_TOPGEN   3392
#define XCD_BAR_WORDS 3456
#define XB_SPIN_CAP (1u << 22)
__device__ __forceinline__ unsigned xb_ld(unsigned* p)              { return __hip_atomic_load(p, __ATOMIC_RELAXED, __HIP_MEMORY_SCOPE_AGENT); }
__device__ __forceinline__ unsigned xb_add(unsigned* p, unsigned v) { return __hip_atomic_fetch_add(p, v, __ATOMIC_RELAXED, __HIP_MEMORY_SCOPE_AGENT); }
__device__ __forceinline__ unsigned xb_xcc_id() { return (unsigned)__builtin_amdgcn_s_getreg((3 << 11) | 20) & 0xFu; }
#define XB_SPIN(cond, bar) do { unsigned _sp = 0; while (cond) { __builtin_amdgcn_s_sleep(1); \
    if ((++_sp & 255u) == 0u) { if (xb_ld(&(bar)[XB_TMO])) break; if (_sp > XB_SPIN_CAP) { atomicAdd(&(bar)[XB_TMO], 1u); break; } } } } while (0)
struct XcdBarrier { unsigned* bar; unsigned x; volatile LAS unsigned* st; };
__device__ __forceinline__ XcdBarrier xcd_barrier_post(unsigned* bar, volatile LAS unsigned* st, int wave) {
    XcdBarrier b; b.bar = bar; b.x = xb_xcc_id(); b.st = st;
    if (wave == 0 && lane_fresh() == 0) st[2] = xb_add(&bar[XB_XCNT(b.x)], 1u);
    return b;
}
__device__ __forceinline__ void xcd_barrier_complete(unsigned* bar, unsigned x, unsigned& nloc, unsigned& nx) {
    const unsigned G = gridDim.x * gridDim.y * gridDim.z;
    unsigned sum, cnt, mine, sp = 0u;
    for (;;) {
        sum = 0u; cnt = 0u; mine = 0u;
#pragma unroll
        for (unsigned j = 0; j < 16; ++j) { const unsigned c = xb_ld(&bar[XB_XCNT(j)]); sum += c; cnt += (c > 0u) ? 1u : 0u; mine = (j == x) ? c : mine; }
        if (sum == G) break;
        __builtin_amdgcn_s_sleep(1);
        if ((++sp & 255u) == 0u) { if (xb_ld(&bar[XB_TMO])) break; if (sp > XB_SPIN_CAP) { atomicAdd(&bar[XB_TMO], 1u); break; } }
    }
    nloc = mine > 0u ? mine : 1u; nx = cnt > 0u ? cnt : 1u;
}
__device__ __forceinline__ void xcd_barrier(const XcdBarrier& b, int wave) {
    asm volatile("s_waitcnt vmcnt(0)" ::: "memory");
    __syncthreads();
    if (wave == 0 && lane_fresh() == 0) {
        unsigned* bar = b.bar;
        __builtin_amdgcn_s_waitcnt(0);
        unsigned nloc = b.st[0], nx = b.st[1];
        if (nloc == 0u) { xcd_barrier_complete(bar, b.x, nloc, nx); b.st[0] = nloc; b.st[1] = nx; }
        const unsigned old = xb_add(&bar[XB_XSUB(b.x)], 1u);
        const unsigned gen = old / nloc;
        if (old + 1u == (gen + 1u) * nloc) {
            __builtin_amdgcn_fence(__ATOMIC_RELEASE, "agent");
            asm volatile("s_waitcnt vmcnt(0)" ::: "memory");
            const unsigned og = xb_add(&bar[XB_TOP], 1u);
            const unsigned tg = og / nx;
            if (og + 1u == (tg + 1u) * nx) xb_add(&bar[XB_TOPGEN], 1u);
            else XB_SPIN(xb_ld(&bar[XB_TOPGEN]) == tg, bar);
            __builtin_amdgcn_fence(__ATOMIC_ACQUIRE, "agent");
            xb_add(&bar[XB_XGEN(b.x)], 1u);
            asm volatile("s_waitcnt vmcnt(0)" ::: "memory");
        } else {
            XB_SPIN(xb_ld(&bar[XB_XGEN(b.x)]) == gen, bar);
            __builtin_amdgcn_fence(__ATOMIC_ACQUIRE, "agent");
            asm volatile("s_waitcnt vmcnt(0)" ::: "memory");
        }
    }
    __syncthreads();
}

struct Args { const float* in[17]; float* out; unsigned char* ws; int ph_lo, ph_hi, li, pad; };
struct Frame {
    LAS unsigned char* lds; int tid, lane, wave, vcu, G;
};

__device__ __forceinline__ void p0_item(const float* W, int ldw, int k0, int nsrc0, bf16_t* WT, int K, int ndst0, const float* gk, LAS float* scr, int lane) {
    f32x4 v[8];
#pragma unroll
    for (int i = 0; i < 8; ++i) v[i] = *(const f32x4*)(W + (size_t)(k0 + 8 * i + (lane >> 3)) * ldw + nsrc0 + 4 * (lane & 7));
    if (gk) {
#pragma unroll
        for (int i = 0; i < 8; ++i) v[i] = v[i] * gk[k0 + 8 * i + (lane >> 3)];
    }
#pragma unroll
    for (int i = 0; i < 8; ++i) { LAS float* s = scr + (8 * i + (lane >> 3)) * 33 + 4 * (lane & 7); s[0] = v[i][0]; s[1] = v[i][1]; s[2] = v[i][2]; s[3] = v[i][3]; }
    asm volatile("s_waitcnt lgkmcnt(0)" ::: "memory");
    const int c = lane & 7;
#pragma unroll
    for (int j = 0; j < 4; ++j) { const int n = (lane >> 3) + 8 * j; const LAS float* s = scr + (8 * c) * 33 + n;
        u32x4 o; o.x = pk2(s[0 * 33], s[1 * 33]); o.y = pk2(s[2 * 33], s[3 * 33]); o.z = pk2(s[4 * 33], s[5 * 33]); o.w = pk2(s[6 * 33], s[7 * 33]);
        *(u32x4*)(WT + (size_t)(ndst0 + n) * K + k0 + 8 * c) = o; }
    asm volatile("s_waitcnt lgkmcnt(0)" ::: "memory");
}
__device__ __forceinline__ void p0_item8(const float* W, int ldw, int k0, int nsrc0, unsigned char* WT, int K, int ndst0, float scale, const float* gk, LAS float* scr, int lane) {
    f32x4 v[8];
#pragma unroll
    for (int i = 0; i < 8; ++i) v[i] = *(const f32x4*)(W + (size_t)(k0 + 8 * i + (lane >> 3)) * ldw + nsrc0 + 4 * (lane & 7));
    if (gk) {
#pragma unroll
        for (int i = 0; i < 8; ++i) v[i] = v[i] * gk[k0 + 8 * i + (lane >> 3)];
    }
#pragma unroll
    for (int i = 0; i < 8; ++i) { LAS float* s = scr + (8 * i + (lane >> 3)) * 33 + 4 * (lane & 7); s[0] = v[i][0] * scale; s[1] = v[i][1] * scale; s[2] = v[i][2] * scale; s[3] = v[i][3] * scale; }
    asm volatile("s_waitcnt lgkmcnt(0)" ::: "memory");
    const int c = lane & 7;
#pragma unroll
    for (int j = 0; j < 4; ++j) { const int n = (lane >> 3) + 8 * j; const LAS float* s = scr + (8 * c) * 33 + n;
        u32x2 o; o.x = pk4_fp8(s[0 * 33], s[1 * 33], s[2 * 33], s[3 * 33]); o.y = pk4_fp8(s[4 * 33], s[5 * 33], s[6 * 33], s[7 * 33]);
        *(u32x2*)(WT + (size_t)(ndst0 + n) * K + k0 + 8 * c) = o; }
    asm volatile("s_waitcnt lgkmcnt(0)" ::: "memory");
}
template <class SrcMap> __device__ __forceinline__ void p0_weight8(const Frame& F, const float* W, int K, int N, unsigned char* WT, float scale, const float* gk, LAS float* scr, SrcMap srcmap) {
    const int gw = F.vcu * 8 + F.wave, NGW = F.G * 8; const int nkb = K / 64, nnb = N / 32, nitems = nkb * nnb;
    for (int it = gw; it < nitems; it += NGW) { const int kb = it / nnb, nb = it % nnb; p0_item8(W, N, kb * 64, srcmap(nb * 32), WT, K, nb * 32, scale, gk, scr, F.lane); }
}
struct W8Task { const float* W; unsigned char* WT; int K, N, ngroups; float scale; const float* gk; int gu, nt; };
template <bool HAS_GK, class SrcMap> __device__ __forceinline__ void p0_w8_load(const W8Task& T, int it, f32x4 (&v)[8], float (&gv)[8], int lane, SrcMap srcmap) {
    const int nnb = T.N / 32, per = (T.K / 64) * nnb; const int g = it / per, r = it - g * per, kb = r / nnb, nb = r - kb * nnb;
    const float* W = T.W + (size_t)g * T.K * T.N; const int nsrc0 = srcmap(nb * 32), k0 = kb * 64;
#pragma unroll
    for (int i = 0; i < 8; ++i) { v[i] = __builtin_nontemporal_load((const f32x4*)(W + (size_t)(k0 + 8 * i + (lane >> 3)) * T.N + nsrc0 + 4 * (lane & 7))); if (HAS_GK) gv[i] = T.gk[k0 + 8 * i + (lane >> 3)]; }
}
template <bool HAS_GK> __device__ __forceinline__ void p0_w8_store(const W8Task& T, int it, const f32x4 (&v)[8], const float (&gv)[8], LAS float* scr, int lane) {
    const int nnb = T.N / 32, per = (T.K / 64) * nnb; const int g = it / per, r = it - g * per, kb = r / nnb, nb = r - kb * nnb;
    unsigned char* WT = T.WT + (size_t)g * T.K * T.N; const int k0 = kb * 64, ndst0 = nb * 32;
    const float gus = T.gu ? (((ndst0 >> 7) & 1) ? 1.0f / SWI_C : SWI_C) : 1.0f;
#pragma unroll
    for (int i = 0; i < 8; ++i) { float sc = T.scale * gus; if (HAS_GK) sc *= gv[i];
        LAS float* s = scr + (8 * i + (lane >> 3)) * 33 + 4 * (lane & 7); s[0] = v[i][0] * sc; s[1] = v[i][1] * sc; s[2] = v[i][2] * sc; s[3] = v[i][3] * sc; }
    asm volatile("s_waitcnt lgkmcnt(0)" ::: "memory");
    const int c = lane & 7;
#pragma unroll
    for (int j = 0; j < 4; ++j) { const int n = (lane >> 3) + 8 * j; const LAS float* s = scr + (8 * c) * 33 + n;
        u32x2 o; o.x = pk4_fp8(s[0 * 33], s[1 * 33], s[2 * 33], s[3 * 33]); o.y = pk4_fp8(s[4 * 33], s[5 * 33], s[6 * 33], s[7 * 33]);
        if (T.nt) __builtin_nontemporal_store(o, (u32x2*)(WT + (size_t)(ndst0 + n) * T.K + k0 + 8 * c)); else *(u32x2*)(WT + (size_t)(ndst0 + n) * T.K + k0 + 8 * c) = o; }
    asm volatile("s_waitcnt lgkmcnt(0)" ::: "memory");
}
template <bool HAS_GK, class SrcMap> __device__ __forceinline__ void p0_w8_run(const Frame& F, const W8Task& T, LAS float* scr, SrcMap srcmap, int gw = -1, int NGW = 0) {
    if (gw < 0) { gw = F.vcu * 8 + F.wave; NGW = F.G * 8; } const int total = T.ngroups * (T.K / 64) * (T.N / 32);
    f32x4 va[8], vb_[8]; float ga[8], gb[8]; int it = gw;
    if (it < total) p0_w8_load<HAS_GK>(T, it, va, ga, F.lane, srcmap);
    while (it < total) {
        const int i1 = it + NGW; if (i1 < total) p0_w8_load<HAS_GK>(T, i1, vb_, gb, F.lane, srcmap);
        p0_w8_store<HAS_GK>(T, it, va, ga, scr, F.lane);
        if (i1 >= total) break;
        const int i2 = i1 + NGW; if (i2 < total) p0_w8_load<HAS_GK>(T, i2, va, ga, F.lane, srcmap);
        p0_w8_store<HAS_GK>(T, i1, vb_, gb, scr, F.lane);
        it = i2;
    }
}
template <class SrcMap> __device__ __forceinline__ void p0_weight(const Frame& F, const float* W, int K, int N, bf16_t* WT, const float* gk, LAS float* scr, SrcMap srcmap) {
    const int gw = F.vcu * 8 + F.wave, NGW = F.G * 8; const int nkb = K / 64, nnb = N / 32, nitems = nkb * nnb;
    for (int it = gw; it < nitems; it += NGW) { const int kb = it / nnb, nb = it % nnb; p0_item(W, N, kb * 64, srcmap(nb * 32), WT, K, nb * 32, gk, scr, F.lane); }
}
struct MapId { __device__ __forceinline__ int operator()(int n) const { return n; } };
struct MapInProj { __device__ __forceinline__ int operator()(int n) const { const int pn = n >> 8, c = n & 255; return pn * 256 + 64 * ((c & 127) >> 5) + 32 * (c >> 7) + (c & 31); } };
struct MapGateUp { __device__ __forceinline__ int operator()(int n) const { const int pn = n >> 8, bj = (n >> 7) & 1, j = n & 127; return 1024 * bj + 128 * pn + j; } };

__device__ const double ROPE_INV[32] = {1.0, 0.7498942093324559, 0.5623413251903491, 0.4216965034285822, 0.31622776601683794, 0.23713737056616552, 0.1778279410038923, 0.1333521432163324, 0.1, 0.07498942093324558, 0.05623413251903491, 0.042169650342858224, 0.03162277660168379, 0.023713737056616554, 0.01778279410038923, 0.01333521432163324, 0.01, 0.007498942093324558, 0.005623413251903491, 0.004216965034285823, 0.0031622776601683794, 0.0023713737056616554, 0.0017782794100389228, 0.001333521432163324, 0.001, 0.0007498942093324559, 0.0005623413251903491, 0.00042169650342858224, 0.00031622776601683794, 0.00023713737056616554, 0.00017782794100389227, 0.0001333521432163324};

constexpr int NPHASE = 9;
#ifndef REP_PHASE
#define REP_PHASE -1
#endif
#define NREP(k) ((k) == REP_PHASE ? 2 : 1)
constexpr int N_LAUNCHES = MK_N_LAUNCHES;

__global__ void __launch_bounds__(512, 2) fwd_kernel(Args args) {
    extern __shared__ __attribute__((aligned(16))) unsigned char lds_raw[];
    Frame F;
    F.lds = (LAS unsigned char*)lds_raw;
    F.wave = __builtin_amdgcn_readfirstlane((int)threadIdx.x >> 6); F.lane = lane_fresh(); F.tid = F.wave * 64 + F.lane;
#define REFRESH_ID() do { F.lane = lane_fresh(); F.tid = F.wave * 64 + F.lane; } while (0)
    F.G = gridDim.x; { const int bx = blockIdx.x; F.vcu = (F.G % 8 == 0) ? (bx % 8) * (F.G / 8) + bx / 8 : bx; }
    unsigned char* ws = args.ws;
    unsigned* ctl = (unsigned*)(ws + WS_CTL);
    volatile LAS unsigned* LCTL = (volatile LAS unsigned*)(F.lds + LDSCTL_OFF);
    for (int u = F.tid; u < (LDS_BYTES - LDSCTL_OFF) / 4; u += 512) ((LAS unsigned*)(F.lds + LDSCTL_OFF))[u] = 0u;
    __syncthreads();
    XcdBarrier bar; bar.bar = ctl + CW_BAR; bar.x = 0; bar.st = nullptr;
    if (N_LAUNCHES == 1) bar = xcd_barrier_post(ctl + CW_BAR, LCTL + L_BARST, F.wave);
#define GRID_BAR() do { if (N_LAUNCHES == 1) xcd_barrier(bar, F.wave); } while (0)
    const int lo = args.ph_lo, hi = args.ph_hi;
#ifndef PHASE_MASK
#define PHASE_MASK 0x1ff
#endif
#define IN(k) (((PHASE_MASK >> (k)) & 1) && lo <= (k) && (k) < hi)
#define BOTH(k) (IN(k) && IN((k) + 1))

#define x_in ((const float*)args.in[0])
#define g_mix ((const float*)args.in[1])
#define w_in ((const float*)args.in[2])
#define qa_norm ((const float*)args.in[3])
#define ka_norm ((const float*)args.in[4])
#define sink_b ((const float*)args.in[5])
#define w_br_a ((const float*)args.in[6])
#define w_br_b ((const float*)args.in[7])
#define w_out ((const float*)args.in[8])
#define g_ffn ((const float*)args.in[9])
#define w_router ((const float*)args.in[10])
#define b_router ((const float*)args.in[11])
#define w_gate_up ((const float*)args.in[12])
#define b_gate_up ((const float*)args.in[13])
#define w_down ((const float*)args.in[14])
#define b_down ((const float*)args.in[15])
#define g_final ((const float*)args.in[16])
    float* out = args.out;
    float* RSTD = (float*)(ws + WS_RSTD); float* ROPE = (float*)(ws + WS_ROPE); u32x2* LIST2 = (u32x2*)(ws + WS_LIST2);
    unsigned char* WIN = (unsigned char*)(ws + WS_WIN); unsigned char* WA = (unsigned char*)(ws + WS_WA); unsigned char* WB = (unsigned char*)(ws + WS_WB); unsigned char* WOUT = (unsigned char*)(ws + WS_WOUT);
    unsigned char* XB = (unsigned char*)(ws + WS_XB); unsigned char* QA = (unsigned char*)(ws + WS_QA); unsigned char* QBb = (unsigned char*)(ws + WS_QB);
    bf16_t* KA = (bf16_t*)(ws + WS_KA); bf16_t* VA = (bf16_t*)(ws + WS_VA); bf16_t* KBb = (bf16_t*)(ws + WS_KB); bf16_t* VBb = (bf16_t*)(ws + WS_VB);
    unsigned char* GA = (unsigned char*)(ws + WS_GA); unsigned char* GB = (unsigned char*)(ws + WS_GB); unsigned char* MERGED = (unsigned char*)(ws + WS_MERGED); unsigned char* H2 = (unsigned char*)(ws + WS_H2);
    unsigned char* WGU = (unsigned char*)(ws + WS_WGU); unsigned char* WD = (unsigned char*)(ws + WS_WD); unsigned char* ACT = (unsigned char*)(ws + WS_ACT); unsigned char* YB = (unsigned char*)(ws + WS_Y);
    unsigned char* OA = (unsigned char*)(ws + WS_OA); unsigned char* OB = (unsigned char*)(ws + WS_OB); bf16_t* X1 = (bf16_t*)(ws + WS_X1);
    float* cosA = ROPE, *sinA = ROPE + SEQ * 32, *cosB = ROPE + 2 * SEQ * 32, *sinB = ROPE + 3 * SEQ * 32;
    const int gw = F.vcu * 8 + F.wave, NGW = F.G * 8;

    if (IN(0)) {
        REFRESH_ID();
        LAS float* scr = (LAS float*)(F.lds + RING_OFF + F.wave * 16384);
        for (int rep_ = 0; rep_ < NREP(0); ++rep_) {
        for (int m = gw; m < MTOK; m += 2 * NGW) {
            const int m1 = m + NGW; const bool has1 = m1 < MTOK;
            const f32x4* xr0 = (const f32x4*)(x_in + (size_t)m * DM) + F.lane; const f32x4* xr1 = (const f32x4*)(x_in + (size_t)(has1 ? m1 : m) * DM) + F.lane;
            f32x4 v0[4], v1[4]; float s0 = 0.f, s1 = 0.f;
#pragma unroll
            for (int j = 0; j < 4; ++j) { v0[j] = __builtin_nontemporal_load(xr0 + 64 * j); v1[j] = __builtin_nontemporal_load(xr1 + 64 * j); }
#pragma unroll
            for (int j = 0; j < 4; ++j) { s0 += (v0[j].x * v0[j].x + v0[j].y * v0[j].y) + (v0[j].z * v0[j].z + v0[j].w * v0[j].w); s1 += (v1[j].x * v1[j].x + v1[j].y * v1[j].y) + (v1[j].z * v1[j].z + v1[j].w * v1[j].w); }
            s0 = wave_sum(s0); s1 = wave_sum(s1);
            if (F.lane == 0) { RSTD[m] = rsqrtf(s0 * (1.0f / DM) + EPS); if (has1) RSTD[m1] = rsqrtf(s1 * (1.0f / DM) + EPS); }
            unsigned* o0 = (unsigned*)(XB + (size_t)m * DM) + F.lane; unsigned* o1 = (unsigned*)(XB + (size_t)m1 * DM) + F.lane;
#pragma unroll
            for (int j = 0; j < 4; ++j) { o0[64 * j] = pk4_fp8(v0[j].x, v0[j].y, v0[j].z, v0[j].w); if (has1) o1[64 * j] = pk4_fp8(v1[j].x, v1[j].y, v1[j].z, v1[j].w); }
        }
        { W8Task T{w_in, WIN, DM, IN_COLS, 1, 32.0f, g_mix}; p0_w8_run<true>(F, T, scr, MapInProj()); }
        { W8Task T{w_br_a, WA, QW, DM, 1, 32.0f, nullptr}; p0_w8_run<false>(F, T, scr, MapId()); }
        { W8Task T{w_br_b, WB, QW, DM, 1, 32.0f, nullptr}; p0_w8_run<false>(F, T, scr, MapId()); }
        { W8Task T{w_out, WOUT, DM, DM, 1, 32.0f, nullptr}; p0_w8_run<false>(F, T, scr, MapId()); }
        { W8Task T{w_down, WD, DFF, DM, NEXP, 32.0f, nullptr, 0, 1}; p0_w8_run<false>(F, T, scr, MapId()); }
        {
            for (int it = gw; it < SEQ * 32 / 64; it += NGW) {
                const int idx = it * 64 + F.lane, t = idx >> 5, i = idx & 31;
                const double i2pi = 0.15915494309189535;
                { const double ang = (i < 16) ? (double)(t >> 6) * ROPE_INV[2 * i] : (double)(t & 63) * ROPE_INV[2 * (i - 16)];
                  double rev = ang * i2pi; rev -= rint(rev); const float fr_ = (float)rev;
                  ((unsigned*)ROPE)[idx] = pk2(__builtin_amdgcn_cosf(fr_), __builtin_amdgcn_sinf(fr_)); }
                { const double ang = (double)t * ROPE_INV[i];
                  double rev = ang * i2pi; rev -= rint(rev); const float fr_ = (float)rev;
                  ((unsigned*)ROPE)[SEQ * 32 + idx] = pk2(__builtin_amdgcn_cosf(fr_), __builtin_amdgcn_sinf(fr_)); }
            }
        }
        }
        if (BOTH(0)) GRID_BAR();
    }
    int vb = (int)blockIdx.x;
    if (N_LAUNCHES == 1 && lo == 0 && hi > 1) {
        REFRESH_ID();
        if (F.tid == 0) { unsigned base = 0; for (unsigned j = 0; j < 16; ++j) { const unsigned c = xb_ld(&bar.bar[XB_XCNT(j)]); if (j < bar.x) base += c; } LCTL[L_BARST + 3] = base + LCTL[L_BARST + 2]; }
        __syncthreads();
        F.vcu = (int)LCTL[L_BARST + 3];
        if (F.G % 8 == 0) vb = (F.vcu % (F.G / 8)) * 8 + F.vcu / (F.G / 8); else vb = F.vcu;
    }

    if (IN(1)) {
        constexpr int NCONV = 14;
        { const int cpx_ = (F.G % 8 == 0) ? F.G / 8 : F.G, jj_ = F.vcu % cpx_, xg_ = F.vcu / cpx_, nconv_ = NCONV < cpx_ ? NCONV : cpx_;
          if (jj_ < nconv_) { LAS float* scr = (LAS float*)(F.lds + RING_OFF + F.wave * 16384); const int ngrp_ = F.G / cpx_;
              const int gwc = (xg_ * nconv_ + jj_) * 8 + F.wave, ngwc = ngrp_ * nconv_ * 8;
              { W8Task T{w_gate_up, WGU, DM, 2 * DFF, NEXP, 32.0f, nullptr, 1, 1}; p0_w8_run<false>(F, T, scr, MapGateUp(), gwc, ngwc); }
              asm volatile("s_waitcnt vmcnt(0) lgkmcnt(0)" ::: "memory"); __syncthreads(); } }
        pg8::TicketOrder S; S.init(MTOK, IN_COLS, F.G, F.vcu, ctl + CW_TKT, (volatile LAS int*)(LCTL + L_TKT), F.wave);
        EpiInProj E{RSTD, qa_norm, ka_norm, (const unsigned*)ROPE, (const unsigned*)ROPE + SEQ * 32, QA, KA, VA, QBb, KBb, VBb, GA, GB};
        for (int rep_ = 0; rep_ < NREP(1); ++rep_)
        pg8::gemm_phase<EpiInProj, pg8::TicketOrder, true, true, false, true>(F.lds + RING_OFF, XB, WIN, DM, IN_COLS / 256, S, E, F.wave);
        if (BOTH(1)) GRID_BAR();
    }

    if (IN(2)) {
        REFRESH_ID();
        char* shm = (char*)lds_raw + RING_OFF;
        float gq_ = fabsf(qa_norm[F.lane]), gk_ = fabsf(ka_norm[F.lane]);
        gq_ = wave_max(gq_); gk_ = wave_max(gk_);
        const float mrefA = 64.0f * gq_ * gk_ * C2 * 1.0001f;
        const bool nomax = mrefA < 64.0f;
        for (int rep_ = 0; rep_ < NREP(2); ++rep_) {
        for (int i = 0; i < 2; ++i) {
            const int uu = F.vcu + F.G * i; if (uu >= 512) break;
            const int ii = uu >> 8, v = uu & 255, combo = v >> 6, w = (v & 63) + 64 * ii, g = w >> 5, qb = w & 31;
            const int b = combo >> 1, h = (combo & 1) * 4 + g;
            if (nomax) attn_body::attn_unit<0, 8, true>(b, h, qb, QA, (const attn_body::bf16*)KA, (const attn_body::bf16*)VA, OA, shm, F.wave, 0.f, mrefA);
            else attn_body::attn_unit<0, 8>(b, h, qb, QA, (const attn_body::bf16*)KA, (const attn_body::bf16*)VA, OA, shm, F.wave, 0.f);
        }
        for (int i = 0; i < 2; ++i) {
            const int uu = F.vcu + F.G * i; if (uu >= 512) break;
            const int qb = uu & 31, h = (uu >> 5) & 7, b = uu >> 8;
            attn_body::attn_unit<1, 8>(b, h, qb, QBb, (const attn_body::bf16*)KBb, (const attn_body::bf16*)VBb, OB, shm, F.wave, sink_b[h] * 1.4426950408889634f);
        }
        }
        if (BOTH(2)) GRID_BAR();
    }

    if (IN(3)) {
        static_assert(WS_OB == WS_OA + (size_t)MTOK * QW && WS_WB == WS_WA + (size_t)DM * QW, "branch B operands follow branch A's");
        pg8::PairOrder S; S.init(MTOK, DM, F.G, vb);
        EpiGateFused E{GB, GA, MERGED};
        for (int rep_ = 0; rep_ < NREP(3); ++rep_)
        pg8::gemm_phase<EpiGateFused, pg8::PairOrder, true, true, false, true>(F.lds + RING_OFF, OA, WA, QW, DM / 256, S, E, F.wave, 0x7a7a7a7a);
        if (BOTH(3)) GRID_BAR();
    }

    u32x4 whi[4][2], wlo[4][2]; float be_r = 0.f;
#define SPLIT2(a_, b_, hi_, lo_) do { const float _a = (a_), _b = (b_); hi_ = pk2(_a, _b); lo_ = pk2(_a - bflo(hi_), _b - bfhi(hi_)); } while (0)
#define LOAD_WREG() do { const float* wp = w_router + (size_t)(F.wave * 128 + 8 * (F.lane >> 4)) * NEXP + (F.lane & 15); \
        _Pragma("unroll") for (int s_ = 0; s_ < 4; ++s_) _Pragma("unroll") for (int h_ = 0; h_ < 2; ++h_) { float w8[8]; \
            _Pragma("unroll") for (int i_ = 0; i_ < 8; ++i_) w8[i_] = wp[(size_t)(32 * s_ + i_) * NEXP + 16 * h_]; \
            SPLIT2(w8[0], w8[1], whi[s_][h_].x, wlo[s_][h_].x); SPLIT2(w8[2], w8[3], whi[s_][h_].y, wlo[s_][h_].y); SPLIT2(w8[4], w8[5], whi[s_][h_].z, wlo[s_][h_].z); SPLIT2(w8[6], w8[7], whi[s_][h_].w, wlo[s_][h_].w); } \
        be_r = b_router[F.lane & 31]; } while (0)
    if (IN(4)) {
        pg8::StaticOrder S; S.init(MTOK, DM, F.G, vb);
        EpiResid E{x_in, X1};
        for (int rep_ = 0; rep_ < NREP(4); ++rep_)
        pg8::gemm_phase<EpiResid, pg8::StaticOrder, true, true, false, true>(F.lds + RING_OFF, MERGED, WOUT, DM, DM / 256, S, E, F.wave, 0x7a7a7a7a);
        if (BOTH(4)) { REFRESH_ID(); LOAD_WREG(); GRID_BAR(); }
    }

    if (IN(5)) {
        REFRESH_ID();
        constexpr int HP = 1028;
        LAS float* hs = (LAS float*)(F.lds + RING_OFF);
        LAS float* part = (LAS float*)(F.lds + RING_OFF + 66560);
        volatile LAS int* lcnt = (volatile LAS int*)(LCTL + L_LCNT); volatile LAS int* lbase = (volatile LAS int*)(LCTL + L_LBASE);
        volatile LAS int* sele = (volatile LAS int*)(LCTL + L_SELE); volatile LAS int* selr = (volatile LAS int*)(LCTL + L_SELR); volatile LAS float* selg = (volatile LAS float*)(LCTL + L_SELG);
        const int e = F.lane & 31, kh = F.lane >> 5;
        if (!IN(4)) { LOAD_WREG(); }
        const float be = be_r;
        f32x4 gff[4];
#pragma unroll
        for (int j = 0; j < 4; ++j) gff[j] = *((const f32x4*)g_ffn + F.lane + 64 * j);
        for (int chunk = F.vcu; chunk < MTOK / 64; chunk += F.G) {
            if (F.tid < 32) lcnt[F.tid] = 0;
            const int row0 = chunk * 64;
            u32x2 xn[2][4];
#pragma unroll
            for (int rr = 0; rr < 2; ++rr)
#pragma unroll
                for (int j = 0; j < 4; ++j) xn[rr][j] = *((const u32x2*)(X1 + (size_t)(row0 + F.wave * 2 + rr) * DM) + F.lane + 64 * j);
            for (int step = 0; step < 4; ++step) {
                u32x2 xc[2][4];
#pragma unroll
                for (int rr = 0; rr < 2; ++rr)
#pragma unroll
                    for (int j = 0; j < 4; ++j) xc[rr][j] = xn[rr][j];
                if (step < 3) {
#pragma unroll
                    for (int rr = 0; rr < 2; ++rr)
#pragma unroll
                        for (int j = 0; j < 4; ++j) xn[rr][j] = *((const u32x2*)(X1 + (size_t)(row0 + (step + 1) * 16 + F.wave * 2 + rr) * DM) + F.lane + 64 * j);
                }
#pragma unroll
                for (int rr = 0; rr < 2; ++rr) {
                    const int rl = F.wave * 2 + rr, m = row0 + step * 16 + rl;
                    f32x4 v[4]; float ssum = 0.f;
#pragma unroll
                    for (int j = 0; j < 4; ++j) { const u32x2 w_ = xc[rr][j]; v[j] = (f32x4){bflo(w_.x), bfhi(w_.x), bflo(w_.y), bfhi(w_.y)}; ssum += (v[j].x * v[j].x + v[j].y * v[j].y) + (v[j].z * v[j].z + v[j].w * v[j].w); }
                    ssum = wave_sum(ssum); const float rs = rsqrtf(ssum * (1.0f / DM) + EPS);
                    unsigned* o8 = (unsigned*)(H2 + (size_t)m * DM) + F.lane;
#pragma unroll
                    for (int j = 0; j < 4; ++j) { const f32x4 hv = v[j] * rs * gff[j];
                        o8[64 * j] = pk4_fp8(hv.x, hv.y, hv.z, hv.w);
                        *(LAS f32x4*)(hs + rl * HP + 4 * F.lane + 256 * j) = hv; }
                }
                __syncthreads();
                {
                    const LAS float* ha = hs + (F.lane & 15) * HP + F.wave * 128 + 8 * (F.lane >> 4);
                    f32x4 c0 = {0.f, 0.f, 0.f, 0.f}, c1 = {0.f, 0.f, 0.f, 0.f};
#pragma unroll
                    for (int s_ = 0; s_ < 4; ++s_) { const f32x4 x0 = *(const LAS f32x4*)(ha + 32 * s_), x1 = *(const LAS f32x4*)(ha + 32 * s_ + 4);
                        u32x4 ah, al; SPLIT2(x0[0], x0[1], ah.x, al.x); SPLIT2(x0[2], x0[3], ah.y, al.y); SPLIT2(x1[0], x1[1], ah.z, al.z); SPLIT2(x1[2], x1[3], ah.w, al.w);
                        const bf16x8 ah8 = __builtin_bit_cast(bf16x8, ah), al8 = __builtin_bit_cast(bf16x8, al);
                        c0 = __builtin_amdgcn_mfma_f32_16x16x32_bf16(al8, __builtin_bit_cast(bf16x8, whi[s_][0]), c0, 0, 0, 0);
                        c1 = __builtin_amdgcn_mfma_f32_16x16x32_bf16(al8, __builtin_bit_cast(bf16x8, whi[s_][1]), c1, 0, 0, 0);
                        c0 = __builtin_amdgcn_mfma_f32_16x16x32_bf16(ah8, __builtin_bit_cast(bf16x8, wlo[s_][0]), c0, 0, 0, 0);
                        c1 = __builtin_amdgcn_mfma_f32_16x16x32_bf16(ah8, __builtin_bit_cast(bf16x8, wlo[s_][1]), c1, 0, 0, 0);
                        c0 = __builtin_amdgcn_mfma_f32_16x16x32_bf16(ah8, __builtin_bit_cast(bf16x8, whi[s_][0]), c0, 0, 0, 0);
                        c1 = __builtin_amdgcn_mfma_f32_16x16x32_bf16(ah8, __builtin_bit_cast(bf16x8, whi[s_][1]), c1, 0, 0, 0); }
                    LAS float* pw_ = part + (F.wave * 16 + 4 * (F.lane >> 4)) * 32 + (F.lane & 15);
#pragma unroll
                    for (int r = 0; r < 4; ++r) { pw_[r * 32] = c0[r]; pw_[r * 32 + 16] = c1[r]; }
                }
                __syncthreads();
                {
                    const int rl = F.wave * 2 + kh;
                    float cur = be;
#pragma unroll
                    for (int w = 0; w < 8; ++w) cur += part[(w * 16 + rl) * 32 + e];
                    float tv[4]; int ti[4];
#pragma unroll
                    for (int kk = 0; kk < 4; ++kk) {
                        const float bv = swap16_max(row_max16(cur));
                        const unsigned long long bm = __ballot(cur == bv);
                        const int bi = __builtin_ctz(kh ? (unsigned)(bm >> 32) : (unsigned)bm);
                        tv[kk] = bv; ti[kk] = bi; if (e == bi) cur = -INFINITY;
                    }
                    const float e1 = __expf(tv[1] - tv[0]), e2 = __expf(tv[2] - tv[0]), e3 = __expf(tv[3] - tv[0]);
                    const float inv = 1.0f / (1.0f + e1 + e2 + e3);
                    if (e < 4) {
                        const int kk = e; const int ex = kk == 0 ? ti[0] : kk == 1 ? ti[1] : kk == 2 ? ti[2] : ti[3];
                        const float gx = (kk == 0 ? 1.0f : kk == 1 ? e1 : kk == 2 ? e2 : e3) * inv;
                        const int a = (step * 16 + rl) * 4 + kk;
                        const int rank = __hip_atomic_fetch_add((LAS int*)&lcnt[ex], 1, __ATOMIC_RELAXED, __HIP_MEMORY_SCOPE_WORKGROUP);
                        sele[a] = ex; selr[a] = rank; selg[a] = gx;
                    }
                }
            }
            __syncthreads();
            if (F.tid < 32) lbase[F.tid] = (int)xb_add(ctl + CW_ECNT + F.tid, (unsigned)lcnt[F.tid]);
            __syncthreads();
            if (F.tid < 256) { const int a = F.tid; const int ex = sele[a]; const int pos = lbase[ex] + selr[a]; const int slot = (row0 + (a >> 2)) * 4 + (a & 3);
                u32x2 pr; pr.x = (unsigned)slot; pr.y = __float_as_uint(selg[a]); LIST2[ex * MTOK + pos] = pr; }
            __syncthreads();
        }
        if (BOTH(5)) GRID_BAR();
    }

    if (IN(6) || IN(7)) {
        REFRESH_ID();
        if (F.wave == 0) {
            const int e_ = F.lane & 31; const int c = (int)xb_ld(ctl + CW_ECNT + e_); const int tiles_ = (c + 255) >> 8;
            LAS int* tl = (LAS int*)(F.lds + LDSCTL_OFF) + L_LCNT;
            if (F.lane < 32) { LCTL[L_CNT + e_] = (unsigned)c; tl[e_] = tiles_; }
            asm volatile("s_waitcnt lgkmcnt(0)" ::: "memory");
            int pre_ = 0;
#pragma unroll
            for (int i = 0; i < NEXP; ++i) { const int t_ = tl[i]; pre_ += (i < e_) ? t_ : 0; }
            if (F.lane < 32) LCTL[L_PRE + e_] = (unsigned)pre_;
            if (F.lane == 31) LCTL[L_PRE + NEXP] = (unsigned)(pre_ + tiles_);
        }
        __syncthreads();
    }
    const LAS int* Lpre = (const LAS int*)(F.lds + LDSCTL_OFF) + L_PRE; const LAS int* Lcnt = (const LAS int*)(F.lds + LDSCTL_OFF) + L_CNT;

    if (IN(6)) {
        pg8::MoeOrder S; S.init(Lpre, Lcnt, LIST2, 2 * DFF / 256, F.G, F.vcu);
        EpiSwiglu E{b_gate_up, ACT};
        for (int rep_ = 0; rep_ < NREP(6); ++rep_)
        pg8::gemm_phase<EpiSwiglu, pg8::MoeOrder, true, true, true, true>(F.lds + RING_OFF, H2, WGU, DM, 2 * DFF / 256, S, E, F.wave);
        if (BOTH(6)) GRID_BAR();
    }

    if (IN(7)) {
        pg8::MoeOrder S; S.init(Lpre, Lcnt, LIST2, DM / 256, F.G, F.vcu);
        EpiDown E{b_down, LIST2, Lcnt, YB};
        for (int rep_ = 0; rep_ < NREP(7); ++rep_)
        pg8::gemm_phase<EpiDown, pg8::MoeOrder, true, true, false, true>(F.lds + RING_OFF, ACT, WD, DFF, DM / 256, S, E, F.wave);
        if (BOTH(7)) GRID_BAR();
    }

    if (IN(8)) {
        const int lane8 = (int)__builtin_amdgcn_mbcnt_hi(~0u, __builtin_amdgcn_mbcnt_lo(~0u, 0u));
        for (int rep_ = 0; rep_ < NREP(8); ++rep_)
        for (int m = gw; m < MTOK; m += NGW) {
            const u32x2* xin = (const u32x2*)(X1 + (size_t)m * DM) + lane8;
            f32x4* xr = (f32x4*)(out + (size_t)m * DM) + lane8;
            f32x4 v[4];
#pragma unroll
            for (int j = 0; j < 4; ++j) { const u32x2 w_ = xin[64 * j]; v[j] = (f32x4){bflo(w_.x), bfhi(w_.x), bflo(w_.y), bfhi(w_.y)}; }
#pragma unroll
            for (int k = 0; k < 4; ++k) { const unsigned* yr = (const unsigned*)(YB + ((size_t)m * 4 + k) * DM) + lane8;
#pragma unroll
                for (int j = 0; j < 4; ++j) { const int w = (int)yr[64 * j]; const f32x2 lo_ = __builtin_amdgcn_cvt_pk_f32_fp8(w, false), hi_ = __builtin_amdgcn_cvt_pk_f32_fp8(w, true);
                    v[j].x += 0.25f * lo_.x; v[j].y += 0.25f * lo_.y; v[j].z += 0.25f * hi_.x; v[j].w += 0.25f * hi_.y; } }
            float s = 0.f;
#pragma unroll
            for (int j = 0; j < 4; ++j) s += (v[j].x * v[j].x + v[j].y * v[j].y) + (v[j].z * v[j].z + v[j].w * v[j].w);
            s = wave_sum(s); const float rs = rsqrtf(s * (1.0f / DM) + EPS);
#pragma unroll
            for (int j = 0; j < 4; ++j) { const f32x4 gg = *((const f32x4*)g_final + lane8 + 64 * j); xr[64 * j] = v[j] * rs * gg; }
        }
    }
#undef IN
#undef BOTH
#undef GRID_BAR
#undef x_in
#undef g_mix
#undef w_in
#undef qa_norm
#undef ka_norm
#undef sink_b
#undef w_br_a
#undef w_br_b
#undef w_out
#undef g_ffn
#undef w_router
#undef b_router
#undef w_gate_up
#undef b_gate_up
#undef w_down
#undef b_down
#undef g_final
}

extern "C" void kernel_launch(void* const* d_in, const int* in_sizes, int n_in, void* d_out, int out_size, void* d_ws, size_t ws_size, hipStream_t stream) {
    static int grid = 0;
    if (grid == 0) {
        if (n_in != 17 || out_size != MTOK * DM || ws_size < WS_END) { fprintf(stderr, "kernel_launch: unexpected problem shape (n_in %d out %d ws %zu)\n", n_in, out_size, ws_size); grid = -1; return; }
        int dev = 0, cus = 0;
        if (hipGetDevice(&dev) != hipSuccess || hipDeviceGetAttribute(&cus, hipDeviceAttributeMultiprocessorCount, dev) != hipSuccess) { grid = -1; return; }
        if (hipFuncSetAttribute((const void*)fwd_kernel, hipFuncAttributeMaxDynamicSharedMemorySize, LDS_BYTES) != hipSuccess) { fprintf(stderr, "kernel_launch: hipFuncSetAttribute failed\n"); grid = -1; return; }
        int per_cu = 0;
        if (hipOccupancyMaxActiveBlocksPerMultiprocessor(&per_cu, (const void*)fwd_kernel, 512, LDS_BYTES) != hipSuccess || per_cu < 1) { fprintf(stderr, "kernel_launch: occupancy query says %d\n", per_cu); }
        (void)hipGetLastError();
        grid = cus;
    }
    if (grid < 0) return;
    (void)hipMemsetAsync((char*)d_ws + WS_CTL, 0, CTL_ZERO_BYTES, stream);
    Args a{};
    for (int i = 0; i < 17; ++i) a.in[i] = (const float*)d_in[i];
    a.out = (float*)d_out; a.ws = (unsigned char*)d_ws;
    if (N_LAUNCHES == 1) {
        a.ph_lo = 0; a.ph_hi = NPHASE; a.li = 0;
        hipLaunchKernelGGL(fwd_kernel, dim3(grid), dim3(512), LDS_BYTES, stream, a);
#if defined(PROBE_PHASE)
        a.ph_lo = PROBE_PHASE; a.ph_hi = PROBE_PHASE + 1; a.li = 1;
        hipLaunchKernelGGL(fwd_kernel, dim3(grid), dim3(512), LDS_BYTES, stream, a);
#endif
    } else {
        for (int li = 0; li < NPHASE; ++li) { a.ph_lo = li; a.ph_hi = li + 1; a.li = li; hipLaunchKernelGGL(fwd_kernel, dim3(grid), dim3(512), LDS_BYTES, stream, a); }
    }
}
```

```cpp
#include <hip/hip_runtime.h>
#include <hip/hip_bf16.h>
#include <cstdio>
#include <cstdint>
#include <cmath>

#ifndef MK_N_LAUNCHES
#define MK_N_LAUNCHES 1
#endif

constexpr int BATCH = 2, SEQ = 8192, DM = 1024, MTOK = BATCH * SEQ;
constexpr int HD = 64, NQH = 8, NKVH = 2, QW = NQH * HD  , KVW = NKVH * HD  ;
constexpr int IN_COLS = 3584, NEXP = 32, TOPK = 4, DFF = 1024;
constexpr int NSLOT_ASSIGN = MTOK * TOPK;
constexpr int ACT_ROWS = NSLOT_ASSIGN + NEXP * 256;
constexpr float EPS = 1e-6f;
constexpr float C2 = 0.125f * 1.4426950408889634f;

#define LAS __attribute__((address_space(3)))
#define GAS __attribute__((address_space(1)))
typedef unsigned short bf16_t;
typedef short bf16x8 __attribute__((ext_vector_type(8)));
typedef float f32x4 __attribute__((ext_vector_type(4)));
typedef float f32x2 __attribute__((ext_vector_type(2)));
typedef unsigned u32x4 __attribute__((ext_vector_type(4)));
typedef unsigned u32x2 __attribute__((ext_vector_type(2)));
typedef int i32x8 __attribute__((ext_vector_type(8)));
typedef int i32x4 __attribute__((ext_vector_type(4)));
typedef i32x8 i32x8_a16 __attribute__((aligned(16)));
__device__ __forceinline__ unsigned pk4_fp8(float a, float b, float c, float d) { int w = 0; w = __builtin_amdgcn_cvt_pk_fp8_f32(a, b, w, false); w = __builtin_amdgcn_cvt_pk_fp8_f32(c, d, w, true); return (unsigned)w; }

__device__ __forceinline__ unsigned f2bf(float f) { unsigned u = __builtin_bit_cast(unsigned, f); return (u + 0x7fffu + ((u >> 16) & 1u)) >> 16; }
typedef __bf16 bf16x2_hw __attribute__((ext_vector_type(2)));
__device__ __forceinline__ unsigned pk2(float lo, float hi) { f32x2 v = {lo, hi}; bf16x2_hw b = __builtin_convertvector(v, bf16x2_hw); return __builtin_bit_cast(unsigned, b); }
__device__ __forceinline__ float bf2f(unsigned short b) { return __builtin_bit_cast(float, (unsigned)b << 16); }
__device__ __forceinline__ float bflo(unsigned w) { return __builtin_bit_cast(float, w << 16); }
__device__ __forceinline__ float bfhi(unsigned w) { return __builtin_bit_cast(float, w & 0xffff0000u); }
constexpr float SWI_C = -1.702f * 1.4426950408889634f;
__device__ __forceinline__ float sigmoidf_(float v) { return __builtin_amdgcn_rcpf(1.0f + __builtin_amdgcn_exp2f(v * -1.4426950408889634f)); }
__device__ __forceinline__ int lane_fresh() { int l; asm volatile("v_mbcnt_lo_u32_b32 %0, -1, 0\n\tv_mbcnt_hi_u32_b32 %0, -1, %0" : "=v"(l)); return l; }
template <int CTRL> __device__ __forceinline__ float dpp_f(float v) { return __builtin_bit_cast(float, __builtin_amdgcn_update_dpp(0, __builtin_bit_cast(int, v), CTRL, 0xf, 0xf, true)); }
__device__ __forceinline__ float row_sum16(float v) { v += dpp_f<0xB1>(v); v += dpp_f<0x4E>(v); v += dpp_f<0x141>(v); v += dpp_f<0x140>(v); return v; }
__device__ __forceinline__ float row_max16(float v) { v = fmaxf(v, dpp_f<0xB1>(v)); v = fmaxf(v, dpp_f<0x4E>(v)); v = fmaxf(v, dpp_f<0x141>(v)); v = fmaxf(v, dpp_f<0x140>(v)); return v; }
__device__ __forceinline__ float swap16_sum(float v) { const auto r = __builtin_amdgcn_permlane16_swap(__float_as_uint(v), __float_as_uint(v), false, false); return __uint_as_float(r[0]) + __uint_as_float(r[1]); }
__device__ __forceinline__ float swap32_sum(float v) { const auto r = __builtin_amdgcn_permlane32_swap(__float_as_uint(v), __float_as_uint(v), false, false); return __uint_as_float(r[0]) + __uint_as_float(r[1]); }
__device__ __forceinline__ float swap16_max(float v) { const auto r = __builtin_amdgcn_permlane16_swap(__float_as_uint(v), __float_as_uint(v), false, false); return fmaxf(__uint_as_float(r[0]), __uint_as_float(r[1])); }
__device__ __forceinline__ float swap32_max(float v) { const auto r = __builtin_amdgcn_permlane32_swap(__float_as_uint(v), __float_as_uint(v), false, false); return fmaxf(__uint_as_float(r[0]), __uint_as_float(r[1])); }
__device__ __forceinline__ float wave_sum(float v) { return swap32_sum(swap16_sum(row_sum16(v))); }
__device__ __forceinline__ float wave_max(float v) { return swap32_max(swap16_max(row_max16(v))); }

namespace pg8 {
constexpr int BM = 256, BK = 64, HALF = 128, HTB = HALF * BK * 2, STAGE_BYTES = 8 * HTB, NXCD = 8, WGM = 8;
__host__ __device__ __forceinline__ int lds_byte(int r, int c) { const int st = (r >> 4) * 2 + (c >> 5), rr = r & 15, cc = c & 31, ob = rr * 64 + cc * 2; return st * 1024 + (ob ^ (((ob >> 9) & 1) << 5)); }
__host__ __device__ __forceinline__ void stage_rc(int b, int& R, int& C) { const int st = b / 1024, sb = b % 1024, swz = sb ^ (((sb >> 9) & 1) << 5); R = (st >> 1) * 16 + swz / 64; C = (st & 1) * 32 + (swz % 64) / 2; }
__host__ __device__ __forceinline__ int perm32(int rho) { const int n = rho >> 4, i = rho & 15; return 8 * (i >> 2) + 4 * n + (i & 3); }

struct Unit { int pm, pn, e, pml; };

struct StaticOrder {
    int nM, nN, nwg, G, c;
    __device__ void init(int M, int N, int G_, int c_) { nM = M / BM; nN = N / BM; nwg = nM * nN; G = G_; c = c_; }
    __device__ bool next(int i, Unit& u) const {
        const long L = (long)i * G + c; if (L >= nwg) return false;
        int wgid = (int)L; { const int q = nwg / NXCD, r = nwg % NXCD, xcd = wgid % NXCD, off = wgid / NXCD; wgid = (xcd < r ? xcd * (q + 1) : r * (q + 1) + (xcd - r) * q) + off; }
        const int nig = WGM * nN, gid = wgid / nig, fm = gid * WGM, gsz = (nM - fm) < WGM ? (nM - fm) : WGM;
        u.pm = fm + ((wgid % nig) % gsz); u.pn = (wgid % nig) / gsz; u.e = 0; u.pml = u.pm; return true;
    }
    __device__ __forceinline__ unsigned a_rowoff(const Unit&, int) const { return 0u; }
    static constexpr bool LAZY = false;
    __device__ __forceinline__ void prefetch(int) const {}
};

struct PairOrder {
    StaticOrder so; int nM;
    static constexpr bool LAZY = false;
    __device__ void init(int M, int N, int G, int c) { so.init(M, N, G, c); nM = M / BM; }
    __device__ bool next(int i, Unit& u) const { if (i >= 2 || !so.next(0, u)) return false; u.e = i; u.pml = u.pm; u.pm = u.pm + i * nM; return true; }
    __device__ __forceinline__ void prefetch(int) const {}
    __device__ __forceinline__ unsigned a_rowoff(const Unit&, int) const { return 0u; }
};

struct TicketOrder {
    StaticOrder so; unsigned* ctr; volatile LAS int* slot; int x, cpx, wave;
    static constexpr bool LAZY = true;
    __device__ void init(int M, int N, int G, int vcu, unsigned* ctr_base, volatile LAS int* slot_, int wave_) { wave = wave_; so.init(M, N, G, 0); cpx = (G % 8 == 0) ? G / 8 : G; x = vcu / cpx; ctr = ctr_base + 64 * x; slot = slot_; }
    __device__ __forceinline__ void prefetch(int i) const { if (wave == 0 && lane_fresh() == 0) { const int t = (int)__hip_atomic_fetch_add(ctr, 1u, __ATOMIC_RELAXED, __HIP_MEMORY_SCOPE_AGENT); slot[i & 1] = t; } }
    __device__ bool next(int i, Unit& u) const {
        const int t = slot[i & 1]; StaticOrder s2 = so; s2.c = 8 * (t % cpx) + x; if (so.G % 8 != 0) s2.c = t % cpx;
        return s2.next(t / cpx, u);
    }
    __device__ __forceinline__ unsigned a_rowoff(const Unit&, int) const { return 0u; }
};

struct MoeOrder {
    const LAS int* pre; const LAS int* cnt; const u32x2* list; int npn, lo, hi, j, cpx; unsigned rowbytes;
    __device__ void init(const LAS int* pre_, const LAS int* cnt_, const u32x2* list_, int npn_, int G, int vcu) {
        pre = pre_; cnt = cnt_; list = list_; npn = npn_; rowbytes = (unsigned)DM;
        const int U = pre[NEXP] * npn; cpx = (G % 8 == 0) ? G / 8 : G; const int nx = G / cpx, x = vcu / cpx; j = vcu % cpx;
        lo = (int)((long)U * x / nx); hi = (int)((long)U * (x + 1) / nx);
    }
    __device__ bool next(int i, Unit& u) const {
        const int L = lo + j + cpx * i; if (L >= hi) return false;
        const int tr = L / npn; u.pn = L % npn; int e = 0;
#pragma unroll
        for (int st = NEXP / 2; st > 0; st >>= 1) { if (pre[e + st] <= tr) e += st; }
        u.e = e; u.pm = tr; u.pml = tr - pre[e]; return true;
    }
    static constexpr bool LAZY = false;
    __device__ __forceinline__ void prefetch(int) const {}
    __device__ __forceinline__ unsigned a_rowoff(const Unit& u, int R) const {
        const int idx = u.pml * BM + R; const int ic = idx < cnt[u.e] ? idx : 0;
        const int slot = (int)list[u.e * MTOK + ic].x;
        return (unsigned)(slot >> 2) * rowbytes;
    }
};

template <class Epi, class Sched, bool ALIGN_EPI, bool SP2, bool GATHER, bool F8 = false>
__device__ __forceinline__ void gemm_phase(LAS unsigned char* lds, const void* Aptr, const void* Btptr, const int K, const int NBT, const Sched& S, const Epi& E, const int wave_, const int scla_ = 0x7f7f7f7f) {
    const int wid = wave_, lane = lane_fresh(), tid = wid * 64 + lane, wr = wid >> 2, wc = wid & 3, fr = lane & 15, fq = lane >> 4;
    constexpr int EB = F8 ? 1 : 2; const int nt = K * EB / (BK * 2);
    unsigned voffA[2], voffB[2]; int R0, C0;
#pragma unroll
    for (int i = 0; i < 2; ++i) { const int R = 8 * wid + 64 * i + (lane >> 3), cl = (lane & 7) ^ ((R >> 1) & 7); const int Rb = Epi::PERM ? ((R & ~31) + perm32(R & 31)) : R;
        voffA[i] = (unsigned)(R * K * EB + cl * 16); voffB[i] = (unsigned)(Rb * K * EB + cl * 16); if (i == 0) { R0 = R; C0 = cl * 8; } }
    const size_t kstep = (size_t)(BK * 2);
    const size_t hstep = (size_t)HALF * K * EB;
    const size_t tstep = 2 * hstep;
    const unsigned ldsw = (unsigned)wid * 1024u;
    const int sw_ = (fr >> 1) & 7; int aoffk[2], boffk[2];
#pragma unroll
    for (int k = 0; k < 2; ++k) { aoffk[k] = (wr * 64 + fr) * 128 + (((fq + 4 * k) ^ sw_) << 4); boffk[k] = (wc * 32 + fr) * 128 + (((fq + 4 * k) ^ sw_) << 4); }
    unsigned gc[2][2], gn[2][2];
#define PG8_SA(b, h) (((b) * 2 + (h)) * HTB)
#define PG8_SB(b, h) ((4 + (b) * 2 + (h)) * HTB)
#define PG8_GLDS(src, dstoff) __builtin_amdgcn_global_load_lds((const unsigned*)(src), (LAS unsigned*)(lds + (dstoff)), 16, 0, 0)
#define PG8_STAGE(bufoff, gbase, voff) do { _Pragma("unroll") for (int _i = 0; _i < 2; ++_i) PG8_GLDS((const char*)(gbase) + (voff)[_i], (bufoff) + ldsw + _i * 8192); } while (0)
#define PG8_STAGE_A(bufoff, kbase, h, usen) do { if constexpr (GATHER) { _Pragma("unroll") for (int _i = 0; _i < 2; ++_i) { const unsigned _o = (usen) ? gn[h][_i] : gc[h][_i]; PG8_GLDS((const char*)(kbase) + _o, (bufoff) + ldsw + _i * 8192); } } \
        else { PG8_STAGE(bufoff, (const char*)(kbase) + (h) * hstep, voffA); } } while (0)
#define PG8_GOFFS(g, u) do { _Pragma("unroll") for (int _h = 0; _h < 2; ++_h) _Pragma("unroll") for (int _i = 0; _i < 2; ++_i) g[_h][_i] = S.a_rowoff(u, _h * HALF + R0 + 64 * _i) + (unsigned)(C0 * 2); } while (0)
#define PG8_LDA8(dst, b, h) do { _Pragma("unroll") for (int m = 0; m < 4; ++m) { const i32x4 _lo = *(const LAS i32x4*)(lds + PG8_SA(b, h) + aoffk[0] + m * 2048), _hi = *(const LAS i32x4*)(lds + PG8_SA(b, h) + aoffk[1] + m * 2048); dst[m] = (i32x8){_lo.x, _lo.y, _lo.z, _lo.w, _hi.x, _hi.y, _hi.z, _hi.w}; } } while (0)
#define PG8_LDB8(dst, b, h) do { _Pragma("unroll") for (int n = 0; n < 2; ++n) { const i32x4 _lo = *(const LAS i32x4*)(lds + PG8_SB(b, h) + boffk[0] + n * 2048), _hi = *(const LAS i32x4*)(lds + PG8_SB(b, h) + boffk[1] + n * 2048); dst[n] = (i32x8){_lo.x, _lo.y, _lo.z, _lo.w, _hi.x, _hi.y, _hi.z, _hi.w}; } } while (0)
#define PG8_MMA8(ai, bj, At, Bt) do { __builtin_amdgcn_s_setprio(1); _Pragma("unroll") for (int m = 0; m < 4; ++m) _Pragma("unroll") for (int n = 0; n < 2; ++n) \
        asm volatile("v_mfma_scale_f32_16x16x128_f8f6f4 %0, %1, %2, %0, %3, %4 op_sel_hi:[0,0,0]" : "+v"(acc[ai][bj][m][n]) : "v"(Bt[n]), "v"(At[m]), "v"(sclw), "v"(scla)); __builtin_amdgcn_s_setprio(0); } while (0)
#define PG8_LDA(dst, b, h) do { _Pragma("unroll") for (int m = 0; m < 4; ++m) _Pragma("unroll") for (int k = 0; k < 2; ++k) dst[m][k] = *(const LAS bf16x8*)(lds + PG8_SA(b, h) + aoffk[k] + m * 2048); } while (0)
#define PG8_LDB(dst, b, h) do { _Pragma("unroll") for (int n = 0; n < 2; ++n) _Pragma("unroll") for (int k = 0; k < 2; ++k) dst[n][k] = *(const LAS bf16x8*)(lds + PG8_SB(b, h) + boffk[k] + n * 2048); } while (0)
#define PG8_MMA(ai, bj, At, Bt) do { __builtin_amdgcn_s_setprio(1); _Pragma("unroll") for (int m = 0; m < 4; ++m) _Pragma("unroll") for (int n = 0; n < 2; ++n) _Pragma("unroll") for (int k = 0; k < 2; ++k) \
        acc[ai][bj][m][n] = __builtin_amdgcn_mfma_f32_16x16x32_bf16(Bt[n][k], At[m][k], acc[ai][bj][m][n], 0, 0, 0); __builtin_amdgcn_s_setprio(0); } while (0)
#define PG8_WAIT_V(n) asm volatile("s_waitcnt vmcnt(" #n ")" ::: "memory")
#define PG8_WAIT_L(n) asm volatile("s_waitcnt lgkmcnt(" #n ")" ::: "memory")
#define PG8_BAR __builtin_amdgcn_s_barrier()
#define PG8_SCHED __builtin_amdgcn_sched_barrier(0)
    constexpr int ROWS_OFF = STAGE_BYTES + 6144;
    constexpr int PRE_OFF = STAGE_BYTES + 4096;
    Unit cur, nxt; int ui = 0;
    if constexpr (Sched::LAZY) { S.prefetch(0); asm volatile("s_waitcnt vmcnt(0) lgkmcnt(0)" ::: "memory"); __builtin_amdgcn_s_barrier(); asm volatile("" ::: "memory"); }
    if (!S.next(0, cur)) return;
    f32x4 acc[2][2][4][2];
#pragma unroll
    for (int a = 0; a < 2; ++a)
#pragma unroll
        for (int b = 0; b < 2; ++b)
#pragma unroll
            for (int m = 0; m < 4; ++m)
#pragma unroll
                for (int n = 0; n < 2; ++n) acc[a][b][m][n] = (f32x4){0.f, 0.f, 0.f, 0.f};
    bf16x8 At[4][2], B0[2][2], B1[2][2]; i32x8 At8[4], B08[2], B18[2];
    int sclw = 0x7a7a7a7a, scla = scla_; asm volatile("" : "+v"(sclw), "+v"(scla));
    const char* cA = GATHER ? (const char*)Aptr : (const char*)Aptr + (size_t)cur.pm * tstep;
    const char* cB = (const char*)Btptr + ((size_t)cur.e * NBT + cur.pn) * tstep;
    if constexpr (GATHER) { PG8_GOFFS(gc, cur); PG8_GOFFS(gn, cur); }
    if constexpr (Epi::HAS_PRE) { if (wid == 0) E.pre(cur, lds + PRE_OFF, lane); }
    static_assert(SP2, "only the SP2 loop is kept here");
    PG8_STAGE(PG8_SB(0, 0), cB, voffB); PG8_STAGE(PG8_SB(0, 1), cB + hstep, voffB); PG8_STAGE_A(PG8_SA(0, 0), cA, 0, false); PG8_STAGE_A(PG8_SA(0, 1), cA, 1, false);
    if (wr == 1) PG8_BAR;
    PG8_WAIT_V(2); PG8_BAR;
    PG8_STAGE(PG8_SB(1, 0), cB + kstep, voffB); PG8_STAGE_A(PG8_SA(1, 0), cA + kstep, 0, false); PG8_STAGE(PG8_SB(1, 1), cB + hstep + kstep, voffB);
    PG8_WAIT_V(6); PG8_BAR;
    if constexpr (Epi::HAS_PRE) E.init(acc, (const LAS float*)(lds + PRE_OFF), wc, fq);
    for (;;) {
        bool has_next = false; const char* nA = cA; const char* nB = cB;
        if constexpr (Epi::HAS_ROWS) E.rows(cur, lds + ROWS_OFF + (ui & 1) * 2048, wid, lane);
        if constexpr (Sched::LAZY) { S.prefetch(ui + 1); }
        else { has_next = S.next(ui + 1, nxt);
            nA = GATHER ? (const char*)Aptr : (has_next ? (const char*)Aptr + (size_t)nxt.pm * tstep : cA);
            nB = has_next ? (const char*)Btptr + ((size_t)nxt.e * NBT + nxt.pn) * tstep : cB;
            if constexpr (GATHER) { if (has_next) { PG8_GOFFS(gn, nxt); } }
            if constexpr (Epi::HAS_PRE) { if (has_next && wid == 0) E.pre(nxt, lds + PRE_OFF + ((ui + 1) & 1) * 1024, lane); } }
        for (int t = 0; t < nt; t += 2) {
            const bool last = (t == nt - 2);
            if constexpr (Sched::LAZY) { if (last) { has_next = S.next(ui + 1, nxt);
                nA = has_next ? (const char*)Aptr + (size_t)nxt.pm * tstep : cA; nB = has_next ? (const char*)Btptr + ((size_t)nxt.e * NBT + nxt.pn) * tstep : cB; } }
            const char* a1 = cA + (size_t)(t + 1) * kstep;
            const char* a2 = last ? nA : cA + (size_t)(t + 2) * kstep; const char* b2 = last ? nB : cB + (size_t)(t + 2) * kstep;
            const char* a3 = a2 + kstep; const char* b3 = b2 + kstep;
            const bool usen = last && has_next;
#define XLDB0(b, h) do { if constexpr (F8) { PG8_LDB8(B08, b, h); } else { PG8_LDB(B0, b, h); } } while (0)
#define XLDB1(b, h) do { if constexpr (F8) { PG8_LDB8(B18, b, h); } else { PG8_LDB(B1, b, h); } } while (0)
#define XLDA(b, h) do { if constexpr (F8) { PG8_LDA8(At8, b, h); } else { PG8_LDA(At, b, h); } } while (0)
#define XMMA0(ai) do { if constexpr (F8) { PG8_MMA8(ai, 0, At8, B08); } else { PG8_MMA(ai, 0, At, B0); } } while (0)
#define XMMA1(ai) do { if constexpr (F8) { PG8_MMA8(ai, 1, At8, B18); } else { PG8_MMA(ai, 1, At, B1); } } while (0)
            XLDB0(0, 0); XLDB1(0, 1); PG8_SCHED; XLDA(0, 0); PG8_STAGE_A(PG8_SA(1, 1), a1, 1, false);
            PG8_WAIT_V(8); PG8_WAIT_L(0); PG8_BAR; XMMA0(0); XMMA1(0); PG8_BAR; PG8_SCHED;
            XLDA(0, 1); PG8_STAGE(PG8_SB(0, 0), b2, voffB); PG8_STAGE(PG8_SB(0, 1), b2 + hstep, voffB); PG8_STAGE_A(PG8_SA(0, 0), a2, 0, usen);
            PG8_WAIT_V(8); PG8_WAIT_L(0); PG8_BAR; XMMA0(1); XMMA1(1); PG8_BAR; PG8_SCHED;
            XLDB0(1, 0); XLDB1(1, 1); PG8_SCHED; XLDA(1, 0); PG8_STAGE_A(PG8_SA(0, 1), a2, 1, usen);
            PG8_WAIT_V(8); PG8_WAIT_L(0); PG8_BAR; XMMA0(0); XMMA1(0); PG8_BAR; PG8_SCHED;
            XLDA(1, 1); PG8_STAGE(PG8_SB(1, 0), b3, voffB); PG8_STAGE(PG8_SB(1, 1), b3 + hstep, voffB); PG8_STAGE_A(PG8_SA(1, 0), a3, 0, usen);
            PG8_WAIT_V(8); PG8_WAIT_L(0); PG8_BAR; XMMA0(1); XMMA1(1); PG8_BAR; PG8_SCHED;
#undef XLDB0
#undef XLDB1
#undef XLDA
#undef XMMA0
#undef XMMA1
        }
        if constexpr (ALIGN_EPI) { if (wr == 0) PG8_BAR; }
        if constexpr (F8) asm volatile("s_nop 15\n\ts_nop 7" ::: "memory");
        if constexpr (Epi::HAS_ROWS) E(acc, cur, wr, wc, fr, fq, lds + ROWS_OFF + (ui & 1) * 2048); else E(acc, cur, wr, wc, fr, fq);
        if (!has_next) break;
        if constexpr (Epi::HAS_PRE) E.init(acc, (const LAS float*)(lds + PRE_OFF + ((ui + 1) & 1) * 1024), wc, fq);
        else if (!Epi::keeps(cur)) {
#pragma unroll
        for (int a = 0; a < 2; ++a)
#pragma unroll
            for (int b = 0; b < 2; ++b)
#pragma unroll
                for (int m = 0; m < 4; ++m)
#pragma unroll
                    for (int n = 0; n < 2; ++n) acc[a][b][m][n] = (f32x4){0.f, 0.f, 0.f, 0.f};
        }
        cur = nxt; cA = nA; cB = nB; ++ui;
        if constexpr (GATHER) {
#pragma unroll
            for (int h = 0; h < 2; ++h)
#pragma unroll
                for (int i = 0; i < 2; ++i) gc[h][i] = gn[h][i];
        }
        if constexpr (ALIGN_EPI) { if (wr == 1) PG8_BAR; }
    }
    PG8_WAIT_V(0);
    if constexpr (!ALIGN_EPI) { if (wr == 0) PG8_BAR; }
    PG8_BAR;
#undef PG8_SA
#undef PG8_SB
#undef PG8_GLDS
#undef PG8_STAGE
#undef PG8_STAGE_A
#undef PG8_GOFFS
#undef PG8_LDA
#undef PG8_LDA8
#undef PG8_LDB8
#undef PG8_MMA8
#undef PG8_LDB
#undef PG8_MMA
#undef PG8_WAIT_V
#undef PG8_WAIT_L
#undef PG8_BAR
#undef PG8_SCHED
}
}

__device__ __forceinline__ u32x4 swap16_pair(u32x2 x, u32x2 y) {
    const auto lo = __builtin_amdgcn_permlane16_swap(x.x, y.x, false, false);
    const auto hi = __builtin_amdgcn_permlane16_swap(x.y, y.y, false, false);
    u32x4 r; r.x = lo[0]; r.y = hi[0]; r.z = lo[1]; r.w = hi[1]; return r;
}

typedef f32x4 AccT[2][2][4][2];

struct EpiInProj {
    static constexpr bool PERM = true, HAS_PRE = false, HAS_ROWS = true;
    __device__ __forceinline__ static bool keeps(const pg8::Unit&) { return false; }
    const float* rstd; const float* qa_g; const float* ka_g; const unsigned* csA; const unsigned* csB;
    unsigned char *QA; bf16_t *KA, *VA; unsigned char *QB; bf16_t *KB, *VB; unsigned char *GA, *GB;
    __device__ __forceinline__ static void store16(bf16_t* rp, const f32x4 (&v)[2][2]) {
#pragma unroll
        for (int bj = 0; bj < 2; ++bj) { u32x4 w; w.x = pk2(v[bj][0][0], v[bj][0][1]); w.y = pk2(v[bj][0][2], v[bj][0][3]); w.z = pk2(v[bj][1][0], v[bj][1][1]); w.w = pk2(v[bj][1][2], v[bj][1][3]);
            *(u32x4*)(rp + 32 * bj) = w; }
    }
    __device__ __forceinline__ static void store_tile(bf16_t* buf, int tmode, int kvh, int row, int fq, const f32x4 (&v)[2][2]) {
        const int t = row & (SEQ - 1), bb = row >> 13, r = t & 63; char* tb = (char*)buf + ((size_t)((bb * NKVH + kvh) * (SEQ / 64) + (t >> 6))) * 8192;
#pragma unroll
        for (int bj = 0; bj < 2; ++bj) { u32x4 w; w.x = pk2(v[bj][0][0], v[bj][0][1]); w.y = pk2(v[bj][0][2], v[bj][0][3]); w.z = pk2(v[bj][1][0], v[bj][1][1]); w.w = pk2(v[bj][1][2], v[bj][1][3]);
            const int off = (tmode == 1) ? ((4 * bj + fq) * 1024 + r * 16) : ((bj * 4 + (r >> 4)) * 1024 + (r & 15) * 64 + 16 * fq);
            *(u32x4*)(tb + off) = w; }
    }
    __device__ __forceinline__ void rows(const pg8::Unit& u, LAS unsigned char* dst, int wid, int lane) const {
        if (wid == 0) __builtin_amdgcn_global_load_lds((const unsigned*)(rstd + u.pm * 256 + lane * 4), (LAS unsigned*)dst, 16, 0, 0);
    }
    __device__ __forceinline__ void operator()(const AccT& acc, const pg8::Unit& u, int wr, int wc, int fr, int fq, const LAS unsigned char* rl) const {
        const LAS float* rsl = (const LAS float*)rl + wr * 64 + fr;
        const int s = 4 * u.pn + wc;
        int kind; bf16_t* dst; int pitch; const float* gain = nullptr; const unsigned* ct = nullptr; float qs = 1.f; int tmode = 0, kvh_ = 0;
        unsigned char* qdst = nullptr;
        if (s < 8) { kind = 0; dst = nullptr; qdst = QA + s * 64; pitch = QW; gain = qa_g; ct = csA; qs = C2 * 8.0f; }
        else if (s < 10) { kind = 0; dst = KA; pitch = KVW; gain = ka_g; ct = csA; tmode = 1; kvh_ = s - 8; }
        else if (s < 12) { kind = 2; dst = VA; pitch = KVW; tmode = 2; kvh_ = s - 10; }
        else if (s < 20) { kind = 1; dst = nullptr; qdst = QB + (s - 12) * 64; pitch = QW; ct = csB; qs = C2 * 8.0f; }
        else if (s < 22) { kind = 1; dst = KB; pitch = KVW; ct = csB; tmode = 1; kvh_ = s - 20; }
        else if (s < 24) { kind = 2; dst = VB; pitch = KVW; tmode = 2; kvh_ = s - 22; }
        else { kind = 3; dst = nullptr; pitch = DM; }
        unsigned char* gdst = (s < 40) ? GA + (s - 24) * 64 : GB + (s - 40) * 64;
        const int row0 = u.pm * 256 + wr * 64 + fr;
        if (kind >= 2) {
#pragma unroll
            for (int ai = 0; ai < 2; ++ai) {
                float rs[2][4];
#pragma unroll
                for (int m = 0; m < 4; ++m) rs[ai][m] = rsl[ai * 128 + m * 16];
#pragma unroll
                for (int m = 0; m < 4; ++m) {
                    const int row = row0 + ai * 128 + m * 16; f32x4 v[2][2];
#pragma unroll
                    for (int bj = 0; bj < 2; ++bj)
#pragma unroll
                        for (int n = 0; n < 2; ++n) {
                            if (kind == 3) { const float rsn = rs[ai][m] * -1.4426950408889634f;
#pragma unroll
                                for (int j = 0; j < 4; ++j) v[bj][n][j] = __builtin_amdgcn_rcpf(1.0f + __builtin_amdgcn_exp2f(acc[ai][bj][m][n][j] * rsn)); }
                            else v[bj][n] = acc[ai][bj][m][n] * rs[ai][m]; }
                    if (kind == 3) {
                        u32x2 w[2];
#pragma unroll
                        for (int bj = 0; bj < 2; ++bj) { w[bj].x = pk4_fp8(v[bj][0][0], v[bj][0][1], v[bj][0][2], v[bj][0][3]); w[bj].y = pk4_fp8(v[bj][1][0], v[bj][1][1], v[bj][1][2], v[bj][1][3]); }
                        const u32x4 q = swap16_pair(w[0], w[1]);
                        *(u32x4*)(gdst + (size_t)row * DM + (fq & 1) * 32 + 16 * (fq >> 1)) = q;
                    }
                    else if (tmode) store_tile(dst, tmode, kvh_, row, fq, v); else store16(dst + (size_t)row * pitch + 8 * fq, v);
                }
            }
            return;
        }
        f32x4 gv[2][2];
        if (kind == 0) {
#pragma unroll
            for (int bj = 0; bj < 2; ++bj)
#pragma unroll
                for (int n = 0; n < 2; ++n) gv[bj][n] = *(const f32x4*)(gain + 32 * bj + 8 * fq + 4 * n);
        }
#pragma unroll
        for (int hm = 0; hm < 4; ++hm) {
            const int ai = hm >> 1, m0 = (hm & 1) * 2;
            float rs[2][4]; rs[ai][m0] = rsl[ai * 128 + m0 * 16]; rs[ai][m0 + 1] = rsl[ai * 128 + (m0 + 1) * 16];
            u32x4 tb[2][2];
#pragma unroll
            for (int mm = 0; mm < 2; ++mm) { const int t = (row0 + ai * 128 + (m0 + mm) * 16) & (SEQ - 1);
#pragma unroll
                for (int n = 0; n < 2; ++n) tb[mm][n] = *(const u32x4*)(ct + t * 32 + 8 * fq + 4 * n); }
#pragma unroll
            for (int mm = 0; mm < 2; ++mm) {
                const int m = m0 + mm; const int row = row0 + ai * 128 + m * 16; f32x4 v[2][2];
#pragma unroll
                for (int bj = 0; bj < 2; ++bj)
#pragma unroll
                    for (int n = 0; n < 2; ++n) v[bj][n] = acc[ai][bj][m][n] * rs[ai][m];
                if (kind == 0) {
                    float ss = 0.f;
#pragma unroll
                    for (int bj = 0; bj < 2; ++bj)
#pragma unroll
                        for (int n = 0; n < 2; ++n) { const f32x4 x = v[bj][n]; ss += (x[0] * x[0] + x[1] * x[1]) + (x[2] * x[2] + x[3] * x[3]); }
                    ss = swap32_sum(swap16_sum(ss));
                    const float r = rsqrtf(ss * (1.0f / 64.0f) + EPS);
#pragma unroll
                    for (int bj = 0; bj < 2; ++bj)
#pragma unroll
                        for (int n = 0; n < 2; ++n) v[bj][n] = v[bj][n] * r * gv[bj][n];
                }
#pragma unroll
                for (int n = 0; n < 2; ++n) { const f32x4 x1 = v[0][n], x2 = v[1][n]; const u32x4 w = tb[mm][n];
                    const f32x4 c_ = {bflo(w.x), bflo(w.y), bflo(w.z), bflo(w.w)}, s_ = {bfhi(w.x), bfhi(w.y), bfhi(w.z), bfhi(w.w)};
                    v[0][n] = (x1 * c_ - x2 * s_) * qs; v[1][n] = (x2 * c_ + x1 * s_) * qs; }
                if (tmode) store_tile(dst, tmode, kvh_, row, fq, v);
                else {
                    u32x2 w[2];
#pragma unroll
                    for (int bj = 0; bj < 2; ++bj) { w[bj].x = pk4_fp8(v[bj][0][0], v[bj][0][1], v[bj][0][2], v[bj][0][3]); w[bj].y = pk4_fp8(v[bj][1][0], v[bj][1][1], v[bj][1][2], v[bj][1][3]); }
                    const u32x4 q = swap16_pair(w[0], w[1]);
                    *(u32x4*)(qdst + (size_t)row * QW + (fq & 1) * 32 + 16 * (fq >> 1)) = q;
                }
            }
        }
    }
};

template <bool FIRST> struct EpiGate {
    static constexpr bool PERM = true, HAS_PRE = false, HAS_ROWS = false;
    __device__ __forceinline__ static bool keeps(const pg8::Unit&) { return false; }
    const bf16_t* G; bf16_t* O;
    __device__ __forceinline__ void operator()(const AccT& acc, const pg8::Unit& u, int wr, int wc, int fr, int fq) const {
#pragma unroll
        for (int ai = 0; ai < 2; ++ai)
#pragma unroll
            for (int m = 0; m < 4; ++m) {
                const size_t row = (size_t)(u.pm * 256 + ai * 128 + wr * 64 + m * 16 + fr);
#pragma unroll
                for (int bj = 0; bj < 2; ++bj) {
                    const size_t off = row * DM + u.pn * 256 + bj * 128 + wc * 32 + 8 * fq;
                    const u32x4 g = *(const u32x4*)(G + off);
                    f32x4 v0 = acc[ai][bj][m][0], v1 = acc[ai][bj][m][1];
                    v0[0] *= bflo(g.x); v0[1] *= bfhi(g.x); v0[2] *= bflo(g.y); v0[3] *= bfhi(g.y);
                    v1[0] *= bflo(g.z); v1[1] *= bfhi(g.z); v1[2] *= bflo(g.w); v1[3] *= bfhi(g.w);
                    if (!FIRST) { const u32x4 p = *(const u32x4*)(O + off);
                        v0[0] += bflo(p.x); v0[1] += bfhi(p.x); v0[2] += bflo(p.y); v0[3] += bfhi(p.y);
                        v1[0] += bflo(p.z); v1[1] += bfhi(p.z); v1[2] += bflo(p.w); v1[3] += bfhi(p.w); }
                    u32x4 w; w.x = pk2(v0[0], v0[1]); w.y = pk2(v0[2], v0[3]); w.z = pk2(v1[0], v1[1]); w.w = pk2(v1[2], v1[3]);
                    *(u32x4*)(O + off) = w;
                }
            }
    }
};

struct EpiGateFused {
    static constexpr bool PERM = true, HAS_PRE = false, HAS_ROWS = false;
    const unsigned char* GA; const unsigned char* GB; unsigned char* O;
    __device__ __forceinline__ static bool keeps(const pg8::Unit& u) { return u.e == 0; }
    __device__ __forceinline__ void operator()(AccT& acc, const pg8::Unit& u, int wr, int wc, int fr, int fq) const {
        const size_t base = (size_t)(u.pml * 256 + wr * 64 + fr) * DM + u.pn * 256 + wc * 32 + 8 * fq;
        if (u.e == 0) {
#pragma unroll
            for (int ai = 0; ai < 2; ++ai)
#pragma unroll
                for (int m = 0; m < 4; ++m)
#pragma unroll
                    for (int bj = 0; bj < 2; ++bj) {
                        const size_t off = base + (size_t)(ai * 128 + m * 16) * DM + bj * 128;
                        const u32x2 a = *(const u32x2*)(GA + off), b = *(const u32x2*)(GB + off);
                        const f32x2 a0 = __builtin_amdgcn_cvt_pk_f32_fp8((int)a.x, false), a1 = __builtin_amdgcn_cvt_pk_f32_fp8((int)a.x, true), a2 = __builtin_amdgcn_cvt_pk_f32_fp8((int)a.y, false), a3 = __builtin_amdgcn_cvt_pk_f32_fp8((int)a.y, true);
                        const f32x2 b0 = __builtin_amdgcn_cvt_pk_f32_fp8((int)b.x, false), b1 = __builtin_amdgcn_cvt_pk_f32_fp8((int)b.x, true), b2 = __builtin_amdgcn_cvt_pk_f32_fp8((int)b.y, false), b3 = __builtin_amdgcn_cvt_pk_f32_fp8((int)b.y, true);
                        f32x4& v0 = acc[ai][bj][m][0]; f32x4& v1 = acc[ai][bj][m][1];
                        v0[0] *= b0.x * __builtin_amdgcn_rcpf(fmaxf(a0.x, 1e-30f)); v0[1] *= b0.y * __builtin_amdgcn_rcpf(fmaxf(a0.y, 1e-30f)); v0[2] *= b1.x * __builtin_amdgcn_rcpf(fmaxf(a1.x, 1e-30f)); v0[3] *= b1.y * __builtin_amdgcn_rcpf(fmaxf(a1.y, 1e-30f));
                        v1[0] *= b2.x * __builtin_amdgcn_rcpf(fmaxf(a2.x, 1e-30f)); v1[1] *= b2.y * __builtin_amdgcn_rcpf(fmaxf(a2.y, 1e-30f)); v1[2] *= b3.x * __builtin_amdgcn_rcpf(fmaxf(a3.x, 1e-30f)); v1[3] *= b3.y * __builtin_amdgcn_rcpf(fmaxf(a3.y, 1e-30f));
                    }
        } else {
#pragma unroll
            for (int ai = 0; ai < 2; ++ai)
#pragma unroll
                for (int m = 0; m < 4; ++m)
                {
                    u32x2 w[2];
#pragma unroll
                    for (int bj = 0; bj < 2; ++bj) {
                        const size_t off = base + (size_t)(ai * 128 + m * 16) * DM + bj * 128;
                        const u32x2 a = *(const u32x2*)(GA + off);
                        const f32x2 a0 = __builtin_amdgcn_cvt_pk_f32_fp8((int)a.x, false), a1 = __builtin_amdgcn_cvt_pk_f32_fp8((int)a.x, true), a2 = __builtin_amdgcn_cvt_pk_f32_fp8((int)a.y, false), a3 = __builtin_amdgcn_cvt_pk_f32_fp8((int)a.y, true);
                        const f32x4 v0 = acc[ai][bj][m][0] * 32.0f, v1 = acc[ai][bj][m][1] * 32.0f;
                        w[bj].x = pk4_fp8(v0[0] * a0.x, v0[1] * a0.y, v0[2] * a1.x, v0[3] * a1.y); w[bj].y = pk4_fp8(v1[0] * a2.x, v1[1] * a2.y, v1[2] * a3.x, v1[3] * a3.y);
                    }
                    const u32x4 q = swap16_pair(w[0], w[1]);
                    *(u32x4*)(O + (size_t)(u.pml * 256 + wr * 64 + fr + ai * 128 + m * 16) * DM + u.pn * 256 + (fq & 1) * 128 + wc * 32 + 16 * (fq >> 1)) = q;
                }
        }
    }
};

struct EpiResid {
    static constexpr bool PERM = true, HAS_PRE = false, HAS_ROWS = false;
    __device__ __forceinline__ static bool keeps(const pg8::Unit&) { return false; }
    const float* X; bf16_t* O;
    __device__ __forceinline__ void operator()(const AccT& acc, const pg8::Unit& u, int wr, int wc, int fr, int fq) const {
#pragma unroll
        for (int ai = 0; ai < 2; ++ai)
#pragma unroll
            for (int m = 0; m < 4; ++m) {
                const size_t row = (size_t)(u.pm * 256 + ai * 128 + wr * 64 + m * 16 + fr);
#pragma unroll
                for (int bj = 0; bj < 2; ++bj) {
                    const size_t off = row * DM + u.pn * 256 + bj * 128 + wc * 32 + 8 * fq;
                    const f32x4 v0 = __builtin_nontemporal_load((const f32x4*)(X + off)) + acc[ai][bj][m][0], v1 = __builtin_nontemporal_load((const f32x4*)(X + off + 4)) + acc[ai][bj][m][1];
                    u32x4 w; w.x = pk2(v0[0], v0[1]); w.y = pk2(v0[2], v0[3]); w.z = pk2(v1[0], v1[1]); w.w = pk2(v1[2], v1[3]);
                    *(u32x4*)(O + off) = w;
                }
            }
    }
};

struct EpiSwiglu {
    static constexpr bool PERM = true, HAS_PRE = true, HAS_ROWS = false;
    __device__ __forceinline__ static bool keeps(const pg8::Unit&) { return false; }
    const float* bgu; unsigned char* ACT;
    __device__ __forceinline__ void pre(const pg8::Unit& u, LAS unsigned char* dst, int lane) const {
        const float* src = bgu + (size_t)u.e * 2048 + (lane >> 5) * 1024 + u.pn * 128 + 4 * (lane & 31);
        __builtin_amdgcn_global_load_lds((const unsigned*)src, (LAS unsigned*)dst, 16, 0, 0);
    }
    __device__ __forceinline__ void init(AccT& acc, const LAS float* pb, int wc, int fq) const {
        const int cl = wc * 32 + 8 * fq;
#pragma unroll
        for (int n = 0; n < 2; ++n) { const f32x4 bg = *(const LAS f32x4*)(pb + cl + 4 * n) * SWI_C, bu = (*(const LAS f32x4*)(pb + 128 + cl + 4 * n) + 1.0f) * (1.0f / SWI_C);
#pragma unroll
            for (int ai = 0; ai < 2; ++ai)
#pragma unroll
                for (int m = 0; m < 4; ++m) { acc[ai][0][m][n] = bg; acc[ai][1][m][n] = bu; } }
    }
    __device__ __forceinline__ void operator()(const AccT& acc, const pg8::Unit& u, int wr, int wc, int fr, int fq) const {
#pragma unroll
        for (int ai = 0; ai < 2; ++ai)
#pragma unroll
            for (int mp = 0; mp < 2; ++mp) {
                u32x2 w[2];
#pragma unroll
                for (int mm = 0; mm < 2; ++mm) { const int m = 2 * mp + mm; float a[8];
#pragma unroll
                    for (int n = 0; n < 2; ++n)
#pragma unroll
                        for (int j = 0; j < 4; ++j) {
                            const float g = fmaxf(acc[ai][0][m][n][j], 7.0f * SWI_C), up1 = __builtin_amdgcn_fmed3f(acc[ai][1][m][n][j], 8.0f / SWI_C, -6.0f / SWI_C);
                            a[4 * n + j] = up1 * (g * __builtin_amdgcn_rcpf(1.0f + __builtin_amdgcn_exp2f(g)));
                        }
                    w[mm].x = pk4_fp8(a[0], a[1], a[2], a[3]); w[mm].y = pk4_fp8(a[4], a[5], a[6], a[7]); }
                const u32x4 q = swap16_pair(w[0], w[1]);
                const size_t row = (size_t)(u.pm * 256 + ai * 128 + wr * 64 + (2 * mp + (fq & 1)) * 16 + fr);
                *(u32x4*)(ACT + row * DFF + u.pn * 128 + wc * 32 + 16 * (fq >> 1)) = q;
            }
    }
};

struct EpiDown {
    static constexpr bool PERM = true, HAS_PRE = true, HAS_ROWS = true;
    __device__ __forceinline__ static bool keeps(const pg8::Unit&) { return false; }
    const float* bd; const u32x2* list2; const LAS int* cnt; unsigned char* Y;
    __device__ __forceinline__ void pre(const pg8::Unit& u, LAS unsigned char* dst, int lane) const {
        const float* src = bd + (size_t)u.e * DM + u.pn * 256 + 4 * lane;
        __builtin_amdgcn_global_load_lds((const unsigned*)src, (LAS unsigned*)dst, 16, 0, 0);
    }
    __device__ __forceinline__ void init(AccT& acc, const LAS float* pb, int wc, int fq) const {
        const int cl = wc * 32 + 8 * fq;
#pragma unroll
        for (int bj = 0; bj < 2; ++bj)
#pragma unroll
            for (int n = 0; n < 2; ++n) { const f32x4 bv = *(const LAS f32x4*)(pb + bj * 128 + cl + 4 * n);
#pragma unroll
                for (int ai = 0; ai < 2; ++ai)
#pragma unroll
                    for (int m = 0; m < 4; ++m) acc[ai][bj][m][n] = bv; }
    }
    __device__ __forceinline__ void rows(const pg8::Unit& u, LAS unsigned char* dst, int wid, int lane) const {
        if (wid < 2) __builtin_amdgcn_global_load_lds((const unsigned*)(list2 + (size_t)u.e * MTOK + u.pml * 256 + wid * 128 + lane * 2), (LAS unsigned*)(dst + wid * 1024), 16, 0, 0);
    }
    __device__ __forceinline__ void operator()(const AccT& acc, const pg8::Unit& u, int wr, int wc, int fr, int fq, const LAS unsigned char* rl) const {
        const int ne = cnt[u.e];
        u32x2 sg[2][4];
#pragma unroll
        for (int ai = 0; ai < 2; ++ai)
#pragma unroll
            for (int m = 0; m < 4; ++m) { const int rloc = ai * 128 + wr * 64 + m * 16 + fr;
                sg[ai][m] = *(const LAS u32x2*)(rl + rloc * 8); if (u.pml * 256 + rloc >= ne) sg[ai][m].x = 0xffffffffu; }
#pragma unroll
        for (int ai = 0; ai < 2; ++ai)
#pragma unroll
            for (int m = 0; m < 4; ++m) {
                const float gg = __uint_as_float(sg[ai][m].y) * 4.0f;
                u32x2 w[2];
#pragma unroll
                for (int bj = 0; bj < 2; ++bj) {
                    const f32x4 v0 = acc[ai][bj][m][0] * gg, v1 = acc[ai][bj][m][1] * gg;
                    w[bj].x = pk4_fp8(v0[0], v0[1], v0[2], v0[3]); w[bj].y = pk4_fp8(v1[0], v1[1], v1[2], v1[3]); }
                const u32x4 q = swap16_pair(w[0], w[1]);
                if (sg[ai][m].x != 0xffffffffu)
                    *(u32x4*)(Y + (size_t)sg[ai][m].x * DM + u.pn * 256 + (fq & 1) * 128 + wc * 32 + 16 * (fq >> 1)) = q;
            }
    }
};

namespace attn_body {
using bf16 = __hip_bfloat16;
using s16x4 = __attribute__((ext_vector_type(4))) short;
using f32x16 = __attribute__((ext_vector_type(16))) float;
constexpr int D = 64, QP = QW, KP = KVW;
constexpr int NW = 8, QBLK = 32, QB = QBLK * NW, KVBLK = 64;
__device__ __forceinline__ int crow(int r, int hi) { return (r & 3) + 8 * (r >> 2) + 4 * hi; }
#define SBAR() __builtin_amdgcn_sched_barrier(0)
constexpr int NSLOT = 3, SLOTB = 8192;
constexpr int LDS_K = 0, LDS_V = NSLOT * SLOTB, LDS_WS = 2 * NSLOT * SLOTB, LDS_OST = LDS_WS + NW * 64 * 4, LDS_BYTES = LDS_OST + NW * 4096;
__device__ __forceinline__ void glds16(const void* gsrc, unsigned lds_dst) { unsigned keep;
    asm volatile("s_mov_b32 %0, m0\n\ts_mov_b32 m0, %2\n\ts_nop 0\n\tglobal_load_lds_dwordx4 %1, off\n\ts_mov_b32 m0, %0" : "=&s"(keep) : "v"(gsrc), "s"(lds_dst) : "memory"); }
__device__ __forceinline__ float max3f(float a, float b, float c) { float r; asm("v_max3_f32 %0, %1, %2, %3" : "=v"(r) : "v"(a), "v"(b), "v"(c)); return r; }
__device__ __forceinline__ float max2f(float a, float b) { float r; asm("v_max_f32_e32 %0, %1, %2" : "=v"(r) : "v"(a), "v"(b)); return r; }
__device__ __forceinline__ float fadd_s(float a, float b) { float r; asm("v_add_f32_e32 %0, %1, %2" : "=v"(r) : "v"(a), "v"(b)); return r; }
__device__ __forceinline__ float fsub_s(float a, float b) { float r; asm("v_sub_f32_e32 %0, %1, %2" : "=v"(r) : "v"(a), "v"(b)); return r; }
typedef float f32x2_t __attribute__((ext_vector_type(2))); typedef __bf16 bf16x2_t __attribute__((ext_vector_type(2)));
__device__ __forceinline__ unsigned cvtpk_s(float lo, float hi) { f32x2_t v = {lo, hi}; bf16x2_t b = __builtin_convertvector(v, bf16x2_t); return __builtin_bit_cast(unsigned, b); }
#define WAIT_BAR(N) asm volatile("s_waitcnt vmcnt(" #N ") lgkmcnt(0)\n\ts_barrier" ::: "memory")

__device__ __forceinline__ void qkt(f32x16& p0, f32x16& p1, const char* Kslot, const bf16x8* qr, const f32x16& negm, int r32, int hi) {
    const char* kb = Kslot + hi * 1024 + r32 * 16;
#pragma unroll
    for (int d0 = 0; d0 < 4; ++d0) {
        const bf16x8 b0 = *reinterpret_cast<const bf16x8*>(kb + d0 * 2048);
        const bf16x8 b1 = *reinterpret_cast<const bf16x8*>(kb + d0 * 2048 + 512);
        if (d0 == 0) { p0 = __builtin_amdgcn_mfma_f32_32x32x16_bf16(b0, qr[0], negm, 0, 0, 0); p1 = __builtin_amdgcn_mfma_f32_32x32x16_bf16(b1, qr[0], negm, 0, 0, 0); }
        else { p0 = __builtin_amdgcn_mfma_f32_32x32x16_bf16(b0, qr[d0], p0, 0, 0, 0); p1 = __builtin_amdgcn_mfma_f32_32x32x16_bf16(b1, qr[d0], p1, 0, 0, 0); } }
}
typedef __attribute__((address_space(3))) const char* lds_cptr;
typedef short v4i16_t __attribute__((ext_vector_type(4)));
__device__ __forceinline__ void kload8(bf16x8* kf, lds_cptr kp) {
    kf[0] = *(const LAS bf16x8*)(kp);        kf[1] = *(const LAS bf16x8*)(kp + 512);
    kf[2] = *(const LAS bf16x8*)(kp + 2048); kf[3] = *(const LAS bf16x8*)(kp + 2560);
    kf[4] = *(const LAS bf16x8*)(kp + 4096); kf[5] = *(const LAS bf16x8*)(kp + 4608);
    kf[6] = *(const LAS bf16x8*)(kp + 6144); kf[7] = *(const LAS bf16x8*)(kp + 6656);
}
__device__ __forceinline__ void kload2(bf16x8* kf, lds_cptr kp, int j) { kf[2 * j] = *(const LAS bf16x8*)(kp + j * 2048); kf[2 * j + 1] = *(const LAS bf16x8*)(kp + j * 2048 + 512); }
__device__ __forceinline__ s16x4 vtr(lds_cptr p) { return __builtin_bit_cast(s16x4, __builtin_amdgcn_ds_read_tr16_b64_v4i16((LAS v4i16_t*)p)); }
__device__ __forceinline__ float rowmax(const f32x16& p0, const f32x16& p1) {
    float a = max3f(p0[0], p0[1], p1[0]), b = max3f(p0[2], p0[3], p1[1]); a = max3f(a, p1[2], p1[3]);
#pragma unroll
    for (int r = 4; r < 16; r += 4) { a = max3f(a, p0[r], p0[r + 1]); b = max3f(b, p0[r + 2], p0[r + 3]); a = max3f(a, p1[r], p1[r + 1]); b = max3f(b, p1[r + 2], p1[r + 3]); }
    const float m = max2f(a, b);
    auto rr = __builtin_amdgcn_permlane32_swap(__float_as_uint(m), __float_as_uint(m), false, false);
    return max2f(__uint_as_float(rr[0]), __uint_as_float(rr[1]));
}
__device__ __forceinline__ void pv(f32x16* o, int vb, bf16x8 pa0, bf16x8 pa1, bf16x8 pa2, bf16x8 pa3) {
#pragma unroll
    for (int d0 = 0; d0 < 2; ++d0) { s16x4 lo[4], hi[4];
#pragma unroll
        for (int ks = 0; ks < 4; ++ks) {
            asm volatile("ds_read_b64_tr_b16 %0,%1 offset:%c2" : "=&v"(lo[ks]) : "v"(vb), "i"(d0 * 4096 + ks * 1024) : "memory");
            asm volatile("ds_read_b64_tr_b16 %0,%1 offset:%c2" : "=&v"(hi[ks]) : "v"(vb), "i"(d0 * 4096 + ks * 1024 + 512) : "memory"); }
        asm volatile("s_waitcnt lgkmcnt(0)" ::: "memory"); SBAR();
#define PK(k) (bf16x8){lo[k][0], lo[k][1], lo[k][2], lo[k][3], hi[k][0], hi[k][1], hi[k][2], hi[k][3]}
        o[d0] = __builtin_amdgcn_mfma_f32_32x32x16_bf16(pa0, PK(0), o[d0], 0, 0, 0);
        o[d0] = __builtin_amdgcn_mfma_f32_32x32x16_bf16(pa1, PK(1), o[d0], 0, 0, 0);
        o[d0] = __builtin_amdgcn_mfma_f32_32x32x16_bf16(pa2, PK(2), o[d0], 0, 0, 0);
        o[d0] = __builtin_amdgcn_mfma_f32_32x32x16_bf16(pa3, PK(3), o[d0], 0, 0, 0);
#undef PK
    }
}
__device__ __forceinline__ void wmask(f32x16& p0, f32x16& p1, int base) {
    const float NEG = -INFINITY;
#pragma unroll
    for (int r = 0; r < 16; ++r) { const int d0 = base + (r & 3) + 8 * (r >> 2), d1 = d0 + 32;
        if (d0 > 128 || d0 < -128) p0[r] = NEG; if (d1 > 128 || d1 < -128) p1[r] = NEG; }
}

template <int MODE, int THRL, bool NOMAX = false> __device__ __forceinline__ void attn_unit(int b, int h, int qb, const unsigned char* Q, const bf16* __restrict__ K, const bf16* __restrict__ V, unsigned char* O, char* shm, int wave_, float sink2, float mref = 0.f) {
    const int wid = wave_, lane = lane_fresh(), tid = wid * 64 + lane, r32 = lane & 31, hi = lane >> 5;
    const long rowbase = (long)b * SEQ; const int q0 = qb * QB; const int kvh = h >> 2;
    int kt0 = 0, NT = SEQ / KVBLK;
    if (MODE == 1) { kt0 = 4 * qb - 2; int kt1 = 4 * qb + 6; if (kt0 < 0) kt0 = 0; if (kt1 > SEQ / KVBLK) kt1 = SEQ / KVBLK; NT = kt1 - kt0; }
    const unsigned char* Qw = Q + (rowbase + q0 + wid * QBLK) * QP + h * D;
    const unsigned lds0 = (unsigned)(uintptr_t)shm;
    float* wsf = (float*)(shm + LDS_WS) + wid * 64;
    const char* ksrc = (const char*)K + ((size_t)((b * NKVH + kvh) * (SEQ / KVBLK) + kt0)) * 8192 + wid * 1024 + lane * 16;
    const char* vsrc = (const char*)V + ((size_t)((b * NKVH + kvh) * (SEQ / KVBLK) + kt0)) * 8192 + wid * 1024 + lane * 16;
    const unsigned kdst = lds0 + LDS_K + wid * 1024, vdst = lds0 + LDS_V + wid * 1024;
#define DMA_K(t, slot) glds16(ksrc + (size_t)(t) * 8192, (unsigned)__builtin_amdgcn_readfirstlane(kdst + (slot)))
#define DMA_V(t, slot) glds16(vsrc + (size_t)(t) * 8192, (unsigned)__builtin_amdgcn_readfirstlane(vdst + (slot)))
    const int vb0 = (int)(lds0 + LDS_V) + ((lane >> 4) & 1) * 32 + (lane & 3) * 8 + (4 * hi + ((lane & 15) >> 2)) * 64;
    const char* Kbase = shm + LDS_K; bf16x8 kf[8];
    const lds_cptr shm3 = (lds_cptr)shm; const lds_cptr kp0 = shm3 + LDS_K + hi * 1024 + r32 * 16; const lds_cptr vp0 = shm3 + LDS_V + ((lane >> 4) & 1) * 32 + (lane & 3) * 8 + (4 * hi + ((lane & 15) >> 2)) * 64;
    DMA_K(0, 0); DMA_V(0, 0); DMA_K(1, SLOTB);
    bf16x8 qr[4];
#pragma unroll
    for (int d0 = 0; d0 < 4; ++d0) { const u32x2 w8 = *reinterpret_cast<const u32x2*>(&Qw[(long)r32 * QP + d0 * 16 + hi * 8]);
        const f32x2_t a0 = __builtin_amdgcn_cvt_pk_f32_fp8((int)w8.x, false), a1 = __builtin_amdgcn_cvt_pk_f32_fp8((int)w8.x, true), a2 = __builtin_amdgcn_cvt_pk_f32_fp8((int)w8.y, false), a3 = __builtin_amdgcn_cvt_pk_f32_fp8((int)w8.y, true);
        const u32x4 qw = {cvtpk_s(a0.x * 0.125f, a0.y * 0.125f), cvtpk_s(a1.x * 0.125f, a1.y * 0.125f), cvtpk_s(a2.x * 0.125f, a2.y * 0.125f), cvtpk_s(a3.x * 0.125f, a3.y * 0.125f)};
        qr[d0] = __builtin_bit_cast(bf16x8, qw); }
    float mhat = 0.f, l_reg = 0.f; f32x16 o[2]; o[0] = f32x16{}; o[1] = f32x16{}; f32x16 negm = f32x16{}; asm volatile("" : "+v"(negm));
    const int mbase = kt0 * KVBLK + 4 * hi - (q0 + wid * QBLK + r32);
#define CMASK(P0, P1, t) do { if (MODE == 1) wmask(P0, P1, mbase + (t) * KVBLK); } while (0)
    bool resc = false;
#define START(P0, P1) do { const float rm = NOMAX ? mref : rowmax(P0, P1); resc = false; \
    { const float dl = (MODE == 1) ? __builtin_fmaxf(rm, -500.f) : rm; mhat = fadd_s(mhat, dl); \
      _Pragma("unroll") for (int r = 0; r < 16; ++r) { P0[r] = fsub_s(P0[r], dl); P1[r] = fsub_s(P1[r], dl); } \
      _Pragma("unroll") for (int r = 0; r < 16; ++r) negm[r] = -mhat; asm volatile("" : "+v"(negm)); } \
    _Pragma("unroll") for (int r = 0; r < 16; ++r) P0[r] = __builtin_amdgcn_exp2f(P0[r]); } while (0)
#define RESC() do { if (resc) { asm volatile("s_waitcnt lgkmcnt(0)" ::: "memory"); \
      _Pragma("unroll") for (int d_ = 0; d_ < 2; ++d_) _Pragma("unroll") for (int r = 0; r < 16; ++r) o[d_][r] *= wsf[crow(r, hi)]; } } while (0)
    f32x16 pA0, pA1, pB0, pB1;
    int sl_prev = 0, sl_cur = 0, sl_next = SLOTB;
#define ROT() do { sl_prev = sl_cur; sl_cur = sl_next; sl_next = (sl_next == (NSLOT - 1) * SLOTB) ? 0 : sl_next + SLOTB; } while (0)
    DMA_K(2, 2 * SLOTB);
    WAIT_BAR(3);
    qkt(pA0, pA1, Kbase, qr, negm, r32, hi); asm volatile("s_nop 15\n\ts_nop 7" : "+v"(pA0), "+v"(pA1)); CMASK(pA0, pA1, 0);
    START(pA0, pA1);
    _Pragma("unroll") for (int r = 0; r < 16; ++r) pA1[r] = __builtin_amdgcn_exp2f(pA1[r]);
    WAIT_BAR(0);
    DMA_K(3, 0); DMA_V(1, SLOTB);
    ROT();
    kload8(kf, kp0 + sl_cur);
    WAIT_BAR(2);
    s16x4 vlo[8], vhi[8]; u32x4 pw0, pw1, pw2, pw3;
#define PKW(P, B) cvtpk_s(P[B], P[B + 1])
#define PAF(k) __builtin_bit_cast(bf16x8, pw##k)
#define VFR(i) (bf16x8){vlo[i][0], vlo[i][1], vlo[i][2], vlo[i][3], vhi[i][0], vhi[i][1], vhi[i][2], vhi[i][3]}
#define PIN(x) asm volatile("" : "+v"(x))
#define MX3(a, b, c) __builtin_fmaxf(__builtin_fmaxf((a), (b)), (c))
#define GAPA(MF, A0, A1, A2, A3, W0, W1, PW) do { MF; sacc += A0; sacc += A1; sacc += A2; sacc += A3; PIN(sacc); W0; W1; PIN(PW); SBAR(); } while (0)
#define EX(v) __builtin_amdgcn_exp2f(v)
#define GAPB(MF, X, B) do { MF; X[B] = EX(X[B]); X[B + 1] = EX(X[B + 1]); X[B + 2] = EX(X[B + 2]); X[B + 3] = EX(X[B + 3]); PIN(X); SBAR(); } while (0)
#define VRD(i) do { vlo[i] = vtr(vp_ + (((i) >> 2) * 4096 + ((i) & 3) * 1024)); vhi[i] = vtr(vp_ + (((i) >> 2) * 4096 + ((i) & 3) * 1024 + 512)); } while (0)
#define KRD(G, j) do { if (G) { kload2(kf, kp0 + sl_next, j); SBAR(); } } while (0)
#define STEP(C0, C1, P0, P1, t, GK, GV, GL) do { SBAR(); \
    const lds_cptr vp_ = vp0 + sl_prev; \
    VRD(0); SBAR(); float sacc = (P0[0] + P0[1]); \
    GAPA(C0 = __builtin_amdgcn_mfma_f32_32x32x16_bf16(kf[0], qr[0], negm, 0, 0, 0), P0[2], P0[3], P0[4], P0[5],     pw0[0] = PKW(P0, 0), pw0[1] = PKW(P0, 2), pw0); \
    VRD(4); SBAR(); GAPA(C1 = __builtin_amdgcn_mfma_f32_32x32x16_bf16(kf[1], qr[0], negm, 0, 0, 0), P0[6], P0[7], P0[8], P0[9],     pw0[2] = PKW(P0, 4), pw0[3] = PKW(P0, 6), pw0); \
    VRD(1); SBAR(); GAPA(C0 = __builtin_amdgcn_mfma_f32_32x32x16_bf16(kf[2], qr[1], C0, 0, 0, 0),   P0[10], P0[11], P0[12], P0[13], pw1[0] = PKW(P0, 8), pw1[1] = PKW(P0, 10), pw1); \
    VRD(5); SBAR(); GAPA(C1 = __builtin_amdgcn_mfma_f32_32x32x16_bf16(kf[3], qr[1], C1, 0, 0, 0),   P0[14], P0[15], P1[0], P1[1],   pw1[2] = PKW(P0, 12), pw1[3] = PKW(P0, 14), pw1); \
    VRD(2); SBAR(); GAPA(C0 = __builtin_amdgcn_mfma_f32_32x32x16_bf16(kf[4], qr[2], C0, 0, 0, 0),   P1[2], P1[3], P1[4], P1[5],     pw2[0] = PKW(P1, 0), pw2[1] = PKW(P1, 2), pw2); \
    VRD(6); SBAR(); GAPA(C1 = __builtin_amdgcn_mfma_f32_32x32x16_bf16(kf[5], qr[2], C1, 0, 0, 0),   P1[6], P1[7], P1[8], P1[9],     pw2[2] = PKW(P1, 4), pw2[3] = PKW(P1, 6), pw2); \
    VRD(3); SBAR(); GAPA(C0 = __builtin_amdgcn_mfma_f32_32x32x16_bf16(kf[6], qr[3], C0, 0, 0, 0),   P1[10], P1[11], P1[12], P1[13], pw3[0] = PKW(P1, 8), pw3[1] = PKW(P1, 10), pw3); \
    VRD(7); SBAR(); GAPA(C1 = __builtin_amdgcn_mfma_f32_32x32x16_bf16(kf[7], qr[3], C1, 0, 0, 0),   P1[14], P1[15], 0.f, 0.f,       pw3[2] = PKW(P1, 12), pw3[3] = PKW(P1, 14), pw3); \
    l_reg += sacc; \
    if (GK) { DMA_K((t) + 3, sl_cur); } if (GV) { DMA_V((t) + 1, sl_next); } \
    CMASK(C0, C1, t); \
    if (!NOMAX) { float a = MX3(C0[0], C0[1], C1[0]), b = MX3(C0[2], C0[3], C1[1]); a = MX3(a, C1[2], C1[3]); \
      _Pragma("unroll") for (int r = 4; r < 16; r += 4) { a = MX3(a, C0[r], C0[r + 1]); b = MX3(b, C0[r + 2], C0[r + 3]); a = MX3(a, C1[r], C1[r + 1]); b = MX3(b, C1[r + 2], C1[r + 3]); } \
      float rm = __builtin_fmaxf(a, b); { auto rr = __builtin_amdgcn_permlane32_swap(__float_as_uint(rm), __float_as_uint(rm), false, false); rm = __builtin_fmaxf(__uint_as_float(rr[0]), __uint_as_float(rr[1])); } \
      resc = false; \
      if (__builtin_expect(__any(rm > (float)THRL), 0)) { const float dl = __builtin_fmaxf(rm, 0.f); mhat += dl; \
        _Pragma("unroll") for (int r = 0; r < 16; ++r) { C0[r] -= dl; C1[r] -= dl; } \
        _Pragma("unroll") for (int r = 0; r < 16; ++r) negm[r] = -mhat; asm volatile("" : "+v"(negm)); \
        const float f = __builtin_amdgcn_exp2f(-dl); l_reg *= f; if (hi == 0) wsf[r32] = f; resc = true; } } \
    SBAR(); \
    GAPB(o[0] = __builtin_amdgcn_mfma_f32_32x32x16_bf16(PAF(0), VFR(0), o[0], 0, 0, 0), C0, 0); \
    GAPB(o[1] = __builtin_amdgcn_mfma_f32_32x32x16_bf16(PAF(0), VFR(4), o[1], 0, 0, 0), C0, 4); \
    KRD(GL, 0); GAPB(o[0] = __builtin_amdgcn_mfma_f32_32x32x16_bf16(PAF(1), VFR(1), o[0], 0, 0, 0), C0, 8); \
    KRD(GL, 1); GAPB(o[1] = __builtin_amdgcn_mfma_f32_32x32x16_bf16(PAF(1), VFR(5), o[1], 0, 0, 0), C0, 12); \
    KRD(GL, 2); GAPB(o[0] = __builtin_amdgcn_mfma_f32_32x32x16_bf16(PAF(2), VFR(2), o[0], 0, 0, 0), C1, 0); \
    KRD(GL, 3); GAPB(o[1] = __builtin_amdgcn_mfma_f32_32x32x16_bf16(PAF(2), VFR(6), o[1], 0, 0, 0), C1, 4); \
    GAPB(o[0] = __builtin_amdgcn_mfma_f32_32x32x16_bf16(PAF(3), VFR(3), o[0], 0, 0, 0), C1, 8); \
    GAPB(o[1] = __builtin_amdgcn_mfma_f32_32x32x16_bf16(PAF(3), VFR(7), o[1], 0, 0, 0), C1, 12); \
    } while (0)
    int t = 1;
    for (; t + 5 < NT; t += 2) {
        STEP(pB0, pB1, pA0, pA1, t, true, true, true);     WAIT_BAR(2); RESC(); ROT();
        STEP(pA0, pA1, pB0, pB1, t + 1, true, true, true); WAIT_BAR(2); RESC(); ROT();
    }
#define ENDW(tt) do { if ((tt) + 3 < NT) { WAIT_BAR(2); } else if ((tt) + 2 < NT) { WAIT_BAR(1); } else { WAIT_BAR(0); } } while (0)
    for (; t + 1 < NT; t += 2) {
        STEP(pB0, pB1, pA0, pA1, t, (t + 3 < NT), (t + 1 < NT), (t + 1 < NT));         ENDW(t);     RESC(); ROT();
        STEP(pA0, pA1, pB0, pB1, t + 1, (t + 4 < NT), (t + 2 < NT), (t + 2 < NT));     ENDW(t + 1); RESC(); ROT();
    }
    STEP(pB0, pB1, pA0, pA1, NT - 1, false, false, false); RESC();
    { float sacc = pB0[0] + pB0[1]; _Pragma("unroll") for (int r = 2; r < 16; ++r) sacc += pB0[r]; _Pragma("unroll") for (int r = 0; r < 16; ++r) sacc += pB1[r]; l_reg += sacc;
      pw0 = (u32x4){PKW(pB0, 0), PKW(pB0, 2), PKW(pB0, 4), PKW(pB0, 6)}; pw1 = (u32x4){PKW(pB0, 8), PKW(pB0, 10), PKW(pB0, 12), PKW(pB0, 14)}; pw2 = (u32x4){PKW(pB1, 0), PKW(pB1, 2), PKW(pB1, 4), PKW(pB1, 6)}; pw3 = (u32x4){PKW(pB1, 8), PKW(pB1, 10), PKW(pB1, 12), PKW(pB1, 14)};
      SBAR(); pv(o, vb0 + sl_cur, PAF(0), PAF(1), PAF(2), PAF(3)); }
#undef PKW
#undef PAF
#undef VFR
#undef PIN
#undef MX3
#undef GAPA
#undef GAPB
#undef EX
#undef VRD
#undef KRD
#undef STEP
#undef ENDW
    { auto rr = __builtin_amdgcn_permlane32_swap(__float_as_uint(l_reg), __float_as_uint(l_reg), false, false); l_reg = __uint_as_float(rr[0]) + __uint_as_float(rr[1]); }
    if (MODE == 1) l_reg += __builtin_amdgcn_exp2f(sink2 - mhat);
    if (hi == 0) wsf[32 + r32] = l_reg; asm volatile("s_waitcnt lgkmcnt(0)" ::: "memory");
    float rli[16];
#pragma unroll
    for (int r = 0; r < 16; ++r) rli[r] = __builtin_amdgcn_rcpf(wsf[32 + crow(r, hi)]);
    unsigned char* Ow = O + (rowbase + q0 + wid * QBLK) * QP + h * D;
    { unsigned char* stg = (unsigned char*)(shm + LDS_OST) + wid * 2048;
#pragma unroll
      for (int r = 0; r < 16; ++r) { const int orow = crow(r, hi); const float sc = rli[r] * 32.0f;
        const unsigned pk = (unsigned)__builtin_amdgcn_cvt_pk_fp8_f32(o[0][r] * sc, o[1][r] * sc, 0, false);
        stg[orow * 64 + r32] = (unsigned char)(pk & 0xffu); stg[orow * 64 + 32 + r32] = (unsigned char)((pk >> 8) & 0xffu); }
      asm volatile("s_waitcnt lgkmcnt(0)" ::: "memory");
#pragma unroll
      for (int i = 0; i < 2; ++i) { const int row = i * 16 + (lane >> 2), ch = lane & 3; const u32x4 v = *(const u32x4*)(stg + row * 64 + ch * 16); *(u32x4*)(Ow + (long)row * QP + ch * 16) = v; } }
    asm volatile("s_waitcnt lgkmcnt(0)\n\ts_barrier" ::: "memory");
#undef DMA_K
#undef DMA_V
#undef CMASK
#undef START
#undef RESC
#undef ROT
}
#undef SBAR
#undef WAIT_BAR
}

constexpr size_t MiB = 1u << 20;
constexpr size_t WS_CTL = 0, CTL_ZERO_BYTES = 1 * MiB;
constexpr size_t WS_RSTD = 1 * MiB;
constexpr size_t WS_ROPE = 2 * MiB;
constexpr size_t WS_GATEW = 6 * MiB;
constexpr size_t WS_LIST = 7 * MiB;
constexpr size_t WS_WIN = 10 * MiB;
constexpr size_t WS_WA = 18 * MiB, WS_WB = WS_WA + MiB / 2, WS_WOUT = 20 * MiB;
constexpr size_t WS_XB = 24 * MiB;
constexpr size_t WS_QA = 56 * MiB, WS_QB = 72 * MiB;
constexpr size_t WS_KA = 88 * MiB, WS_VA = 92 * MiB, WS_KB = 96 * MiB, WS_VB = 100 * MiB;
constexpr size_t WS_GA = 104 * MiB, WS_GB = 136 * MiB;
constexpr size_t WS_MERGED = 168 * MiB;
constexpr size_t WS_H2 = 200 * MiB;
constexpr size_t WS_WGU = 232 * MiB;
constexpr size_t WS_WD = 360 * MiB;
constexpr size_t WS_ACT = 424 * MiB;
constexpr size_t WS_Y = 568 * MiB;
constexpr size_t WS_OA = 696 * MiB, WS_OB = 704 * MiB;
constexpr size_t WS_X1 = 728 * MiB;
constexpr size_t WS_LIST2 = 792 * MiB;
constexpr size_t WS_END = 796 * MiB;
static_assert((size_t)ACT_ROWS * DFF * 2 <= WS_Y - WS_ACT, "ACT fits");
constexpr int CW_ECNT = 64;
constexpr int CW_TKT = 512;
constexpr int CW_BAR = 4096;

constexpr int RING_OFF = 0, RING_BYTES = 131072;
constexpr int LDSCTL_OFF = RING_BYTES;
constexpr int L_BARST = 0;
constexpr int L_TKT = 8;
constexpr int L_PRE = 16;
constexpr int L_CNT = 64;
constexpr int L_LCNT = 96;
constexpr int L_LBASE = 128;
constexpr int L_SELE = 256, L_SELR = 512, L_SELG = 768;
constexpr int LDS_BYTES = 147456;
static_assert(LDSCTL_OFF + 1024 * 4 <= LDS_BYTES, "LDS map");

#define XB_TMO      128
#define XB_XCNT(j)  (256  + 64 * (j))
#define XB_XSUB(j)  (1280 + 64 * (j))
#define XB_XGEN(j)  (2304 + 64 * (j))
#define XB_TOP      3328
#define XB_TOPGEN   3392
#define XCD_BAR_WORDS 3456
#define XB_SPIN_CAP (1u << 22)
__device__ __forceinline__ unsigned xb_ld(unsigned* p)              { return __hip_atomic_load(p, __ATOMIC_RELAXED, __HIP_MEMORY_SCOPE_AGENT); }
__device__ __forceinline__ unsigned xb_add(unsigned* p, unsigned v) { return __hip_atomic_fetch_add(p, v, __ATOMIC_RELAXED, __HIP_MEMORY_SCOPE_AGENT); }
__device__ __forceinline__ unsigned xb_xcc_id() { return (unsigned)__builtin_amdgcn_s_getreg((3 << 11) | 20) & 0xFu; }
#define XB_SPIN(cond, bar) do { unsigned _sp = 0; while (cond) { __builtin_amdgcn_s_sleep(1); \
    if ((++_sp & 255u) == 0u) { if (xb_ld(&(bar)[XB_TMO])) break; if (_sp > XB_SPIN_CAP) { atomicAdd(&(bar)[XB_TMO], 1u); break; } } } } while (0)
struct XcdBarrier { unsigned* bar; unsigned x; volatile LAS unsigned* st; };
__device__ __forceinline__ XcdBarrier xcd_barrier_post(unsigned* bar, volatile LAS unsigned* st, int wave) {
    XcdBarrier b; b.bar = bar; b.x = xb_xcc_id(); b.st = st;
    if (wave == 0 && lane_fresh() == 0) st[2] = xb_add(&bar[XB_XCNT(b.x)], 1u);
    return b;
}
__device__ __forceinline__ void xcd_barrier_complete(unsigned* bar, unsigned x, unsigned& nloc, unsigned& nx) {
    const unsigned G = gridDim.x * gridDim.y * gridDim.z;
    unsigned sum, cnt, mine, sp = 0u;
    for (;;) {
        sum = 0u; cnt = 0u; mine = 0u;
#pragma unroll
        for (unsigned j = 0; j < 16; ++j) { const unsigned c = xb_ld(&bar[XB_XCNT(j)]); sum += c; cnt += (c > 0u) ? 1u : 0u; mine = (j == x) ? c : mine; }
        if (sum == G) break;
        __builtin_amdgcn_s_sleep(1);
        if ((++sp & 255u) == 0u) { if (xb_ld(&bar[XB_TMO])) break; if (sp > XB_SPIN_CAP) { atomicAdd(&bar[XB_TMO], 1u); break; } }
    }
    nloc = mine > 0u ? mine : 1u; nx = cnt > 0u ? cnt : 1u;
}
__device__ __forceinline__ void xcd_barrier(const XcdBarrier& b, int wave) {
    asm volatile("s_waitcnt vmcnt(0)" ::: "memory");
    __syncthreads();
    if (wave == 0 && lane_fresh() == 0) {
        unsigned* bar = b.bar;
        __builtin_amdgcn_s_waitcnt(0);
        unsigned nloc = b.st[0], nx = b.st[1];
        if (nloc == 0u) { xcd_barrier_complete(bar, b.x, nloc, nx); b.st[0] = nloc; b.st[1] = nx; }
        const unsigned old = xb_add(&bar[XB_XSUB(b.x)], 1u);
        const unsigned gen = old / nloc;
        if (old + 1u == (gen + 1u) * nloc) {
            __builtin_amdgcn_fence(__ATOMIC_RELEASE, "agent");
            asm volatile("s_waitcnt vmcnt(0)" ::: "memory");
            const unsigned og = xb_add(&bar[XB_TOP], 1u);
            const unsigned tg = og / nx;
            if (og + 1u == (tg + 1u) * nx) xb_add(&bar[XB_TOPGEN], 1u);
            else XB_SPIN(xb_ld(&bar[XB_TOPGEN]) == tg, bar);
            __builtin_amdgcn_fence(__ATOMIC_ACQUIRE, "agent");
            xb_add(&bar[XB_XGEN(b.x)], 1u);
            asm volatile("s_waitcnt vmcnt(0)" ::: "memory");
        } else {
            XB_SPIN(xb_ld(&bar[XB_XGEN(b.x)]) == gen, bar);
            __builtin_amdgcn_fence(__ATOMIC_ACQUIRE, "agent");
            asm volatile("s_waitcnt vmcnt(0)" ::: "memory");
        }
    }
    __syncthreads();
}

struct Args { const float* in[17]; float* out; unsigned char* ws; int ph_lo, ph_hi, li, pad; };
struct Frame {
    LAS unsigned char* lds; int tid, lane, wave, vcu, G;
};

__device__ __forceinline__ void p0_item(const float* W, int ldw, int k0, int nsrc0, bf16_t* WT, int K, int ndst0, const float* gk, LAS float* scr, int lane) {
    f32x4 v[8];
#pragma unroll
    for (int i = 0; i < 8; ++i) v[i] = *(const f32x4*)(W + (size_t)(k0 + 8 * i + (lane >> 3)) * ldw + nsrc0 + 4 * (lane & 7));
    if (gk) {
#pragma unroll
        for (int i = 0; i < 8; ++i) v[i] = v[i] * gk[k0 + 8 * i + (lane >> 3)];
    }
#pragma unroll
    for (int i = 0; i < 8; ++i) { LAS float* s = scr + (8 * i + (lane >> 3)) * 33 + 4 * (lane & 7); s[0] = v[i][0]; s[1] = v[i][1]; s[2] = v[i][2]; s[3] = v[i][3]; }
    asm volatile("s_waitcnt lgkmcnt(0)" ::: "memory");
    const int c = lane & 7;
#pragma unroll
    for (int j = 0; j < 4; ++j) { const int n = (lane >> 3) + 8 * j; const LAS float* s = scr + (8 * c) * 33 + n;
        u32x4 o; o.x = pk2(s[0 * 33], s[1 * 33]); o.y = pk2(s[2 * 33], s[3 * 33]); o.z = pk2(s[4 * 33], s[5 * 33]); o.w = pk2(s[6 * 33], s[7 * 33]);
        *(u32x4*)(WT + (size_t)(ndst0 + n) * K + k0 + 8 * c) = o; }
    asm volatile("s_waitcnt lgkmcnt(0)" ::: "memory");
}
__device__ __forceinline__ void p0_item8(const float* W, int ldw, int k0, int nsrc0, unsigned char* WT, int K, int ndst0, float scale, const float* gk, LAS float* scr, int lane) {
    f32x4 v[8];
#pragma unroll
    for (int i = 0; i < 8; ++i) v[i] = *(const f32x4*)(W + (size_t)(k0 + 8 * i + (lane >> 3)) * ldw + nsrc0 + 4 * (lane & 7));
    if (gk) {
#pragma unroll
        for (int i = 0; i < 8; ++i) v[i] = v[i] * gk[k0 + 8 * i + (lane >> 3)];
    }
#pragma unroll
    for (int i = 0; i < 8; ++i) { LAS float* s = scr + (8 * i + (lane >> 3)) * 33 + 4 * (lane & 7); s[0] = v[i][0] * scale; s[1] = v[i][1] * scale; s[2] = v[i][2] * scale; s[3] = v[i][3] * scale; }
    asm volatile("s_waitcnt lgkmcnt(0)" ::: "memory");
    const int c = lane & 7;
#pragma unroll
    for (int j = 0; j < 4; ++j) { const int n = (lane >> 3) + 8 * j; const LAS float* s = scr + (8 * c) * 33 + n;
        u32x2 o; o.x = pk4_fp8(s[0 * 33], s[1 * 33], s[2 * 33], s[3 * 33]); o.y = pk4_fp8(s[4 * 33], s[5 * 33], s[6 * 33], s[7 * 33]);
        *(u32x2*)(WT + (size_t)(ndst0 + n) * K + k0 + 8 * c) = o; }
    asm volatile("s_waitcnt lgkmcnt(0)" ::: "memory");
}
template <class SrcMap> __device__ __forceinline__ void p0_weight8(const Frame& F, const float* W, int K, int N, unsigned char* WT, float scale, const float* gk, LAS float* scr, SrcMap srcmap) {
    const int gw = F.vcu * 8 + F.wave, NGW = F.G * 8; const int nkb = K / 64, nnb = N / 32, nitems = nkb * nnb;
    for (int it = gw; it < nitems; it += NGW) { const int kb = it / nnb, nb = it % nnb; p0_item8(W, N, kb * 64, srcmap(nb * 32), WT, K, nb * 32, scale, gk, scr, F.lane); }
}
struct W8Task { const float* W; unsigned char* WT; int K, N, ngroups; float scale; const float* gk; int gu, nt; };
template <bool HAS_GK, class SrcMap> __device__ __forceinline__ void p0_w8_load(const W8Task& T, int it, f32x4 (&v)[8], float (&gv)[8], int lane, SrcMap srcmap) {
    const int nnb = T.N / 32, per = (T.K / 64) * nnb; const int g = it / per, r = it - g * per, kb = r / nnb, nb = r - kb * nnb;
    const float* W = T.W + (size_t)g * T.K * T.N; const int nsrc0 = srcmap(nb * 32), k0 = kb * 64;
#pragma unroll
    for (int i = 0; i < 8; ++i) { v[i] = __builtin_nontemporal_load((const f32x4*)(W + (size_t)(k0 + 8 * i + (lane >> 3)) * T.N + nsrc0 + 4 * (lane & 7))); if (HAS_GK) gv[i] = T.gk[k0 + 8 * i + (lane >> 3)]; }
}
template <bool HAS_GK> __device__ __forceinline__ void p0_w8_store(const W8Task& T, int it, const f32x4 (&v)[8], const float (&gv)[8], LAS float* scr, int lane) {
    const int nnb = T.N / 32, per = (T.K / 64) * nnb; const int g = it / per, r = it - g * per, kb = r / nnb, nb = r - kb * nnb;
    unsigned char* WT = T.WT + (size_t)g * T.K * T.N; const int k0 = kb * 64, ndst0 = nb * 32;
    const float gus = T.gu ? (((ndst0 >> 7) & 1) ? 1.0f / SWI_C : SWI_C) : 1.0f;
#pragma unroll
    for (int i = 0; i < 8; ++i) { float sc = T.scale * gus; if (HAS_GK) sc *= gv[i];
        LAS float* s = scr + (8 * i + (lane >> 3)) * 33 + 4 * (lane & 7); s[0] = v[i][0] * sc; s[1] = v[i][1] * sc; s[2] = v[i][2] * sc; s[3] = v[i][3] * sc; }
    asm volatile("s_waitcnt lgkmcnt(0)" ::: "memory");
    const int c = lane & 7;
#pragma unroll
    for (int j = 0; j < 4; ++j) { const int n = (lane >> 3) + 8 * j; const LAS float* s = scr + (8 * c) * 33 + n;
        u32x2 o; o.x = pk4_fp8(s[0 * 33], s[1 * 33], s[2 * 33], s[3 * 33]); o.y = pk4_fp8(s[4 * 33], s[5 * 33], s[6 * 33], s[7 * 33]);
        if (T.nt) __builtin_nontemporal_store(o, (u32x2*)(WT + (size_t)(ndst0 + n) * T.K + k0 + 8 * c)); else *(u32x2*)(WT + (size_t)(ndst0 + n) * T.K + k0 + 8 * c) = o; }
    asm volatile("s_waitcnt lgkmcnt(0)" ::: "memory");
}
template <bool HAS_GK, class SrcMap> __device__ __forceinline__ void p0_w8_run(const Frame& F, const W8Task& T, LAS float* scr, SrcMap srcmap, int gw = -1, int NGW = 0) {
    if (gw < 0) { gw = F.vcu * 8 + F.wave; NGW = F.G * 8; } const int total = T.ngroups * (T.K / 64) * (T.N / 32);
    f32x4 va[8], vb_[8]; float ga[8], gb[8]; int it = gw;
    if (it < total) p0_w8_load<HAS_GK>(T, it, va, ga, F.lane, srcmap);
    while (it < total) {
        const int i1 = it + NGW; if (i1 < total) p0_w8_load<HAS_GK>(T, i1, vb_, gb, F.lane, srcmap);
        p0_w8_store<HAS_GK>(T, it, va, ga, scr, F.lane);
        if (i1 >= total) break;
        const int i2 = i1 + NGW; if (i2 < total) p0_w8_load<HAS_GK>(T, i2, va, ga, F.lane, srcmap);
        p0_w8_store<HAS_GK>(T, i1, vb_, gb, scr, F.lane);
        it = i2;
    }
}
template <class SrcMap> __device__ __forceinline__ void p0_weight(const Frame& F, const float* W, int K, int N, bf16_t* WT, const float* gk, LAS float* scr, SrcMap srcmap) {
    const int gw = F.vcu * 8 + F.wave, NGW = F.G * 8; const int nkb = K / 64, nnb = N / 32, nitems = nkb * nnb;
    for (int it = gw; it < nitems; it += NGW) { const int kb = it / nnb, nb = it % nnb; p0_item(W, N, kb * 64, srcmap(nb * 32), WT, K, nb * 32, gk, scr, F.lane); }
}
struct MapId { __device__ __forceinline__ int operator()(int n) const { return n; } };
struct MapInProj { __device__ __forceinline__ int operator()(int n) const { const int pn = n >> 8, c = n & 255; return pn * 256 + 64 * ((c & 127) >> 5) + 32 * (c >> 7) + (c & 31); } };
struct MapGateUp { __device__ __forceinline__ int operator()(int n) const { const int pn = n >> 8, bj = (n >> 7) & 1, j = n & 127; return 1024 * bj + 128 * pn + j; } };

__device__ const double ROPE_INV[32] = {1.0, 0.7498942093324559, 0.5623413251903491, 0.4216965034285822, 0.31622776601683794, 0.23713737056616552, 0.1778279410038923, 0.1333521432163324, 0.1, 0.07498942093324558, 0.05623413251903491, 0.042169650342858224, 0.03162277660168379, 0.023713737056616554, 0.01778279410038923, 0.01333521432163324, 0.01, 0.007498942093324558, 0.005623413251903491, 0.004216965034285823, 0.0031622776601683794, 0.0023713737056616554, 0.0017782794100389228, 0.001333521432163324, 0.001, 0.0007498942093324559, 0.0005623413251903491, 0.00042169650342858224, 0.00031622776601683794, 0.00023713737056616554, 0.00017782794100389227, 0.0001333521432163324};

constexpr int NPHASE = 9;
#ifndef REP_PHASE
#define REP_PHASE -1
#endif
#define NREP(k) ((k) == REP_PHASE ? 2 : 1)
constexpr int N_LAUNCHES = MK_N_LAUNCHES;

__global__ void __launch_bounds__(512, 2) fwd_kernel(Args args) {
    extern __shared__ __attribute__((aligned(16))) unsigned char lds_raw[];
    Frame F;
    F.lds = (LAS unsigned char*)lds_raw;
    F.wave = __builtin_amdgcn_readfirstlane((int)threadIdx.x >> 6); F.lane = lane_fresh(); F.tid = F.wave * 64 + F.lane;
#define REFRESH_ID() do { F.lane = lane_fresh(); F.tid = F.wave * 64 + F.lane; } while (0)
    F.G = gridDim.x; { const int bx = blockIdx.x; F.vcu = (F.G % 8 == 0) ? (bx % 8) * (F.G / 8) + bx / 8 : bx; }
    unsigned char* ws = args.ws;
    unsigned* ctl = (unsigned*)(ws + WS_CTL);
    volatile LAS unsigned* LCTL = (volatile LAS unsigned*)(F.lds + LDSCTL_OFF);
    for (int u = F.tid; u < (LDS_BYTES - LDSCTL_OFF) / 4; u += 512) ((LAS unsigned*)(F.lds + LDSCTL_OFF))[u] = 0u;
    __syncthreads();
    XcdBarrier bar; bar.bar = ctl + CW_BAR; bar.x = 0; bar.st = nullptr;
    if (N_LAUNCHES == 1) bar = xcd_barrier_post(ctl + CW_BAR, LCTL + L_BARST, F.wave);
#define GRID_BAR() do { if (N_LAUNCHES == 1) xcd_barrier(bar, F.wave); } while (0)
    const int lo = args.ph_lo, hi = args.ph_hi;
#ifndef PHASE_MASK
#define PHASE_MASK 0x1ff
#endif
#define IN(k) (((PHASE_MASK >> (k)) & 1) && lo <= (k) && (k) < hi)
#define BOTH(k) (IN(k) && IN((k) + 1))

#define x_in ((const float*)args.in[0])
#define g_mix ((const float*)args.in[1])
#define w_in ((const float*)args.in[2])
#define qa_norm ((const float*)args.in[3])
#define ka_norm ((const float*)args.in[4])
#define sink_b ((const float*)args.in[5])
#define w_br_a ((const float*)args.in[6])
#define w_br_b ((const float*)args.in[7])
#define w_out ((const float*)args.in[8])
#define g_ffn ((const float*)args.in[9])
#define w_router ((const float*)args.in[10])
#define b_router ((const float*)args.in[11])
#define w_gate_up ((const float*)args.in[12])
#define b_gate_up ((const float*)args.in[13])
#define w_down ((const float*)args.in[14])
#define b_down ((const float*)args.in[15])
#define g_final ((const float*)args.in[16])
    float* out = args.out;
    float* RSTD = (float*)(ws + WS_RSTD); float* ROPE = (float*)(ws + WS_ROPE); u32x2* LIST2 = (u32x2*)(ws + WS_LIST2);
    unsigned char* WIN = (unsigned char*)(ws + WS_WIN); unsigned char* WA = (unsigned char*)(ws + WS_WA); unsigned char* WB = (unsigned char*)(ws + WS_WB); unsigned char* WOUT = (unsigned char*)(ws + WS_WOUT);
    unsigned char* XB = (unsigned char*)(ws + WS_XB); unsigned char* QA = (unsigned char*)(ws + WS_QA); unsigned char* QBb = (unsigned char*)(ws + WS_QB);
    bf16_t* KA = (bf16_t*)(ws + WS_KA); bf16_t* VA = (bf16_t*)(ws + WS_VA); bf16_t* KBb = (bf16_t*)(ws + WS_KB); bf16_t* VBb = (bf16_t*)(ws + WS_VB);
    unsigned char* GA = (unsigned char*)(ws + WS_GA); unsigned char* GB = (unsigned char*)(ws + WS_GB); unsigned char* MERGED = (unsigned char*)(ws + WS_MERGED); unsigned char* H2 = (unsigned char*)(ws + WS_H2);
    unsigned char* WGU = (unsigned char*)(ws + WS_WGU); unsigned char* WD = (unsigned char*)(ws + WS_WD); unsigned char* ACT = (unsigned char*)(ws + WS_ACT); unsigned char* YB = (unsigned char*)(ws + WS_Y);
    unsigned char* OA = (unsigned char*)(ws + WS_OA); unsigned char* OB = (unsigned char*)(ws + WS_OB); bf16_t* X1 = (bf16_t*)(ws + WS_X1);
    float* cosA = ROPE, *sinA = ROPE + SEQ * 32, *cosB = ROPE + 2 * SEQ * 32, *sinB = ROPE + 3 * SEQ * 32;
    const int gw = F.vcu * 8 + F.wave, NGW = F.G * 8;

    if (IN(0)) {
        REFRESH_ID();
        LAS float* scr = (LAS float*)(F.lds + RING_OFF + F.wave * 16384);
        for (int rep_ = 0; rep_ < NREP(0); ++rep_) {
        for (int m = gw; m < MTOK; m += 2 * NGW) {
            const int m1 = m + NGW; const bool has1 = m1 < MTOK;
            const f32x4* xr0 = (const f32x4*)(x_in + (size_t)m * DM) + F.lane; const f32x4* xr1 = (const f32x4*)(x_in + (size_t)(has1 ? m1 : m) * DM) + F.lane;
            f32x4 v0[4], v1[4]; float s0 = 0.f, s1 = 0.f;
#pragma unroll
            for (int j = 0; j < 4; ++j) { v0[j] = __builtin_nontemporal_load(xr0 + 64 * j); v1[j] = __builtin_nontemporal_load(xr1 + 64 * j); }
#pragma unroll
            for (int j = 0; j < 4; ++j) { s0 += (v0[j].x * v0[j].x + v0[j].y * v0[j].y) + (v0[j].z * v0[j].z + v0[j].w * v0[j].w); s1 += (v1[j].x * v1[j].x + v1[j].y * v1[j].y) + (v1[j].z * v1[j].z + v1[j].w * v1[j].w); }
            s0 = wave_sum(s0); s1 = wave_sum(s1);
            if (F.lane == 0) { RSTD[m] = rsqrtf(s0 * (1.0f / DM) + EPS); if (has1) RSTD[m1] = rsqrtf(s1 * (1.0f / DM) + EPS); }
            unsigned* o0 = (unsigned*)(XB + (size_t)m * DM) + F.lane; unsigned* o1 = (unsigned*)(XB + (size_t)m1 * DM) + F.lane;
#pragma unroll
            for (int j = 0; j < 4; ++j) { o0[64 * j] = pk4_fp8(v0[j].x, v0[j].y, v0[j].z, v0[j].w); if (has1) o1[64 * j] = pk4_fp8(v1[j].x, v1[j].y, v1[j].z, v1[j].w); }
        }
        { W8Task T{w_in, WIN, DM, IN_COLS, 1, 32.0f, g_mix}; p0_w8_run<true>(F, T, scr, MapInProj()); }
        { W8Task T{w_br_a, WA, QW, DM, 1, 32.0f, nullptr}; p0_w8_run<false>(F, T, scr, MapId()); }
        { W8Task T{w_br_b, WB, QW, DM, 1, 32.0f, nullptr}; p0_w8_run<false>(F, T, scr, MapId()); }
        { W8Task T{w_out, WOUT, DM, DM, 1, 32.0f, nullptr}; p0_w8_run<false>(F, T, scr, MapId()); }
        { W8Task T{w_down, WD, DFF, DM, NEXP, 32.0f, nullptr, 0, 1}; p0_w8_run<false>(F, T, scr, MapId()); }
        {
            for (int it = gw; it < SEQ * 32 / 64; it += NGW) {
                const int idx = it * 64 + F.lane, t = idx >> 5, i = idx & 31;
                const double i2pi = 0.15915494309189535;
                { const double ang = (i < 16) ? (double)(t >> 6) * ROPE_INV[2 * i] : (double)(t & 63) * ROPE_INV[2 * (i - 16)];
                  double rev = ang * i2pi; rev -= rint(rev); const float fr_ = (float)rev;
                  ((unsigned*)ROPE)[idx] = pk2(__builtin_amdgcn_cosf(fr_), __builtin_amdgcn_sinf(fr_)); }
                { const double ang = (double)t * ROPE_INV[i];
                  double rev = ang * i2pi; rev -= rint(rev); const float fr_ = (float)rev;
                  ((unsigned*)ROPE)[SEQ * 32 + idx] = pk2(__builtin_amdgcn_cosf(fr_), __builtin_amdgcn_sinf(fr_)); }
            }
        }
        }
        if (BOTH(0)) GRID_BAR();
    }
    int vb = (int)blockIdx.x;
    if (N_LAUNCHES == 1 && lo == 0 && hi > 1) {
        REFRESH_ID();
        if (F.tid == 0) { unsigned base = 0; for (unsigned j = 0; j < 16; ++j) { const unsigned c = xb_ld(&bar.bar[XB_XCNT(j)]); if (j < bar.x) base += c; } LCTL[L_BARST + 3] = base + LCTL[L_BARST + 2]; }
        __syncthreads();
        F.vcu = (int)LCTL[L_BARST + 3];
        if (F.G % 8 == 0) vb = (F.vcu % (F.G / 8)) * 8 + F.vcu / (F.G / 8); else vb = F.vcu;
    }

    if (IN(1)) {
        constexpr int NCONV = 14;
        { const int cpx_ = (F.G % 8 == 0) ? F.G / 8 : F.G, jj_ = F.vcu % cpx_, xg_ = F.vcu / cpx_, nconv_ = NCONV < cpx_ ? NCONV : cpx_;
          if (jj_ < nconv_) { LAS float* scr = (LAS float*)(F.lds + RING_OFF + F.wave * 16384); const int ngrp_ = F.G / cpx_;
              const int gwc = (xg_ * nconv_ + jj_) * 8 + F.wave, ngwc = ngrp_ * nconv_ * 8;
              { W8Task T{w_gate_up, WGU, DM, 2 * DFF, NEXP, 32.0f, nullptr, 1, 1}; p0_w8_run<false>(F, T, scr, MapGateUp(), gwc, ngwc); }
              asm volatile("s_waitcnt vmcnt(0) lgkmcnt(0)" ::: "memory"); __syncthreads(); } }
        pg8::TicketOrder S; S.init(MTOK, IN_COLS, F.G, F.vcu, ctl + CW_TKT, (volatile LAS int*)(LCTL + L_TKT), F.wave);
        EpiInProj E{RSTD, qa_norm, ka_norm, (const unsigned*)ROPE, (const unsigned*)ROPE + SEQ * 32, QA, KA, VA, QBb, KBb, VBb, GA, GB};
        for (int rep_ = 0; rep_ < NREP(1); ++rep_)
        pg8::gemm_phase<EpiInProj, pg8::TicketOrder, true, true, false, true>(F.lds + RING_OFF, XB, WIN, DM, IN_COLS / 256, S, E, F.wave);
        if (BOTH(1)) GRID_BAR();
    }

    if (IN(2)) {
        REFRESH_ID();
        char* shm = (char*)lds_raw + RING_OFF;
        float gq_ = fabsf(qa_norm[F.lane]), gk_ = fabsf(ka_norm[F.lane]);
        gq_ = wave_max(gq_); gk_ = wave_max(gk_);
        const float mrefA = 64.0f * gq_ * gk_ * C2 * 1.0001f;
        const bool nomax = mrefA < 64.0f;
        for (int rep_ = 0; rep_ < NREP(2); ++rep_) {
        for (int i = 0; i < 2; ++i) {
            const int uu = F.vcu + F.G * i; if (uu >= 512) break;
            const int ii = uu >> 8, v = uu & 255, combo = v >> 6, w = (v & 63) + 64 * ii, g = w >> 5, qb = w & 31;
            const int b = combo >> 1, h = (combo & 1) * 4 + g;
            if (nomax) attn_body::attn_unit<0, 8, true>(b, h, qb, QA, (const attn_body::bf16*)KA, (const attn_body::bf16*)VA, OA, shm, F.wave, 0.f, mrefA);
            else attn_body::attn_unit<0, 8>(b, h, qb, QA, (const attn_body::bf16*)KA, (const attn_body::bf16*)VA, OA, shm, F.wave, 0.f);
        }
        for (int i = 0; i < 2; ++i) {
            const int uu = F.vcu + F.G * i; if (uu >= 512) break;
            const int qb = uu & 31, h = (uu >> 5) & 7, b = uu >> 8;
            attn_body::attn_unit<1, 8>(b, h, qb, QBb, (const attn_body::bf16*)KBb, (const attn_body::bf16*)VBb, OB, shm, F.wave, sink_b[h] * 1.4426950408889634f);
        }
        }
        if (BOTH(2)) GRID_BAR();
    }

    if (IN(3)) {
        static_assert(WS_OB == WS_OA + (size_t)MTOK * QW && WS_WB == WS_WA + (size_t)DM * QW, "branch B operands follow branch A's");
        pg8::PairOrder S; S.init(MTOK, DM, F.G, vb);
        EpiGateFused E{GB, GA, MERGED};
        for (int rep_ = 0; rep_ < NREP(3); ++rep_)
        pg8::gemm_phase<EpiGateFused, pg8::PairOrder, true, true, false, true>(F.lds + RING_OFF, OA, WA, QW, DM / 256, S, E, F.wave, 0x7a7a7a7a);
        if (BOTH(3)) GRID_BAR();
    }

    u32x4 whi[4][2], wlo[4][2]; float be_r = 0.f;
#define SPLIT2(a_, b_, hi_, lo_) do { const float _a = (a_), _b = (b_); hi_ = pk2(_a, _b); lo_ = pk2(_a - bflo(hi_), _b - bfhi(hi_)); } while (0)
#define LOAD_WREG() do { const float* wp = w_router + (size_t)(F.wave * 128 + 8 * (F.lane >> 4)) * NEXP + (F.lane & 15); \
        _Pragma("unroll") for (int s_ = 0; s_ < 4; ++s_) _Pragma("unroll") for (int h_ = 0; h_ < 2; ++h_) { float w8[8]; \
            _Pragma("unroll") for (int i_ = 0; i_ < 8; ++i_) w8[i_] = wp[(size_t)(32 * s_ + i_) * NEXP + 16 * h_]; \
            SPLIT2(w8[0], w8[1], whi[s_][h_].x, wlo[s_][h_].x); SPLIT2(w8[2], w8[3], whi[s_][h_].y, wlo[s_][h_].y); SPLIT2(w8[4], w8[5], whi[s_][h_].z, wlo[s_][h_].z); SPLIT2(w8[6], w8[7], whi[s_][h_].w, wlo[s_][h_].w); } \
        be_r = b_router[F.lane & 31]; } while (0)
    if (IN(4)) {
        pg8::StaticOrder S; S.init(MTOK, DM, F.G, vb);
        EpiResid E{x_in, X1};
        for (int rep_ = 0; rep_ < NREP(4); ++rep_)
        pg8::gemm_phase<EpiResid, pg8::StaticOrder, true, true, false, true>(F.lds + RING_OFF, MERGED, WOUT, DM, DM / 256, S, E, F.wave, 0x7a7a7a7a);
        if (BOTH(4)) { REFRESH_ID(); LOAD_WREG(); GRID_BAR(); }
    }

    if (IN(5)) {
        REFRESH_ID();
        constexpr int HP = 1028;
        LAS float* hs = (LAS float*)(F.lds + RING_OFF);
        LAS float* part = (LAS float*)(F.lds + RING_OFF + 66560);
        volatile LAS int* lcnt = (volatile LAS int*)(LCTL + L_LCNT); volatile LAS int* lbase = (volatile LAS int*)(LCTL + L_LBASE);
        volatile LAS int* sele = (volatile LAS int*)(LCTL + L_SELE); volatile LAS int* selr = (volatile LAS int*)(LCTL + L_SELR); volatile LAS float* selg = (volatile LAS float*)(LCTL + L_SELG);
        const int e = F.lane & 31, kh = F.lane >> 5;
        if (!IN(4)) { LOAD_WREG(); }
        const float be = be_r;
        f32x4 gff[4];
#pragma unroll
        for (int j = 0; j < 4; ++j) gff[j] = *((const f32x4*)g_ffn + F.lane + 64 * j);
        for (int chunk = F.vcu; chunk < MTOK / 64; chunk += F.G) {
            if (F.tid < 32) lcnt[F.tid] = 0;
            const int row0 = chunk * 64;
            u32x2 xn[2][4];
#pragma unroll
            for (int rr = 0; rr < 2; ++rr)
#pragma unroll
                for (int j = 0; j < 4; ++j) xn[rr][j] = *((const u32x2*)(X1 + (size_t)(row0 + F.wave * 2 + rr) * DM) + F.lane + 64 * j);
            for (int step = 0; step < 4; ++step) {
                u32x2 xc[2][4];
#pragma unroll
                for (int rr = 0; rr < 2; ++rr)
#pragma unroll
                    for (int j = 0; j < 4; ++j) xc[rr][j] = xn[rr][j];
                if (step < 3) {
#pragma unroll
                    for (int rr = 0; rr < 2; ++rr)
#pragma unroll
                        for (int j = 0; j < 4; ++j) xn[rr][j] = *((const u32x2*)(X1 + (size_t)(row0 + (step + 1) * 16 + F.wave * 2 + rr) * DM) + F.lane + 64 * j);
                }
#pragma unroll
                for (int rr = 0; rr < 2; ++rr) {
                    const int rl = F.wave * 2 + rr, m = row0 + step * 16 + rl;
                    f32x4 v[4]; float ssum = 0.f;
#pragma unroll
                    for (int j = 0; j < 4; ++j) { const u32x2 w_ = xc[rr][j]; v[j] = (f32x4){bflo(w_.x), bfhi(w_.x), bflo(w_.y), bfhi(w_.y)}; ssum += (v[j].x * v[j].x + v[j].y * v[j].y) + (v[j].z * v[j].z + v[j].w * v[j].w); }
                    ssum = wave_sum(ssum); const float rs = rsqrtf(ssum * (1.0f / DM) + EPS);
                    unsigned* o8 = (unsigned*)(H2 + (size_t)m * DM) + F.lane;
#pragma unroll
                    for (int j = 0; j < 4; ++j) { const f32x4 hv = v[j] * rs * gff[j];
                        o8[64 * j] = pk4_fp8(hv.x, hv.y, hv.z, hv.w);
                        *(LAS f32x4*)(hs + rl * HP + 4 * F.lane + 256 * j) = hv; }
                }
                __syncthreads();
                {
                    const LAS float* ha = hs + (F.lane & 15) * HP + F.wave * 128 + 8 * (F.lane >> 4);
                    f32x4 c0 = {0.f, 0.f, 0.f, 0.f}, c1 = {0.f, 0.f, 0.f, 0.f};
#pragma unroll
                    for (int s_ = 0; s_ < 4; ++s_) { const f32x4 x0 = *(const LAS f32x4*)(ha + 32 * s_), x1 = *(const LAS f32x4*)(ha + 32 * s_ + 4);
                        u32x4 ah, al; SPLIT2(x0[0], x0[1], ah.x, al.x); SPLIT2(x0[2], x0[3], ah.y, al.y); SPLIT2(x1[0], x1[1], ah.z, al.z); SPLIT2(x1[2], x1[3], ah.w, al.w);
                        const bf16x8 ah8 = __builtin_bit_cast(bf16x8, ah), al8 = __builtin_bit_cast(bf16x8, al);
                        c0 = __builtin_amdgcn_mfma_f32_16x16x32_bf16(al8, __builtin_bit_cast(bf16x8, whi[s_][0]), c0, 0, 0, 0);
                        c1 = __builtin_amdgcn_mfma_f32_16x16x32_bf16(al8, __builtin_bit_cast(bf16x8, whi[s_][1]), c1, 0, 0, 0);
                        c0 = __builtin_amdgcn_mfma_f32_16x16x32_bf16(ah8, __builtin_bit_cast(bf16x8, wlo[s_][0]), c0, 0, 0, 0);
                        c1 = __builtin_amdgcn_mfma_f32_16x16x32_bf16(ah8, __builtin_bit_cast(bf16x8, wlo[s_][1]), c1, 0, 0, 0);
                        c0 = __builtin_amdgcn_mfma_f32_16x16x32_bf16(ah8, __builtin_bit_cast(bf16x8, whi[s_][0]), c0, 0, 0, 0);
                        c1 = __builtin_amdgcn_mfma_f32_16x16x32_bf16(ah8, __builtin_bit_cast(bf16x8, whi[s_][1]), c1, 0, 0, 0); }
                    LAS float* pw_ = part + (F.wave * 16 + 4 * (F.lane >> 4)) * 32 + (F.lane & 15);
#pragma unroll
                    for (int r = 0; r < 4; ++r) { pw_[r * 32] = c0[r]; pw_[r * 32 + 16] = c1[r]; }
                }
                __syncthreads();
                {
                    const int rl = F.wave * 2 + kh;
                    float cur = be;
#pragma unroll
                    for (int w = 0; w < 8; ++w) cur += part[(w * 16 + rl) * 32 + e];
                    float tv[4]; int ti[4];
#pragma unroll
                    for (int kk = 0; kk < 4; ++kk) {
                        const float bv = swap16_max(row_max16(cur));
                        const unsigned long long bm = __ballot(cur == bv);
                        const int bi = __builtin_ctz(kh ? (unsigned)(bm >> 32) : (unsigned)bm);
                        tv[kk] = bv; ti[kk] = bi; if (e == bi) cur = -INFINITY;
                    }
                    const float e1 = __expf(tv[1] - tv[0]), e2 = __expf(tv[2] - tv[0]), e3 = __expf(tv[3] - tv[0]);
                    const float inv = 1.0f / (1.0f + e1 + e2 + e3);
                    if (e < 4) {
                        const int kk = e; const int ex = kk == 0 ? ti[0] : kk == 1 ? ti[1] : kk == 2 ? ti[2] : ti[3];
                        const float gx = (kk == 0 ? 1.0f : kk == 1 ? e1 : kk == 2 ? e2 : e3) * inv;
                        const int a = (step * 16 + rl) * 4 + kk;
                        const int rank = __hip_atomic_fetch_add((LAS int*)&lcnt[ex], 1, __ATOMIC_RELAXED, __HIP_MEMORY_SCOPE_WORKGROUP);
                        sele[a] = ex; selr[a] = rank; selg[a] = gx;
                    }
                }
            }
            __syncthreads();
            if (F.tid < 32) lbase[F.tid] = (int)xb_add(ctl + CW_ECNT + F.tid, (unsigned)lcnt[F.tid]);
            __syncthreads();
            if (F.tid < 256) { const int a = F.tid; const int ex = sele[a]; const int pos = lbase[ex] + selr[a]; const int slot = (row0 + (a >> 2)) * 4 + (a & 3);
                u32x2 pr; pr.x = (unsigned)slot; pr.y = __float_as_uint(selg[a]); LIST2[ex * MTOK + pos] = pr; }
            __syncthreads();
        }
        if (BOTH(5)) GRID_BAR();
    }

    if (IN(6) || IN(7)) {
        REFRESH_ID();
        if (F.wave == 0) {
            const int e_ = F.lane & 31; const int c = (int)xb_ld(ctl + CW_ECNT + e_); const int tiles_ = (c + 255) >> 8;
            LAS int* tl = (LAS int*)(F.lds + LDSCTL_OFF) + L_LCNT;
            if (F.lane < 32) { LCTL[L_CNT + e_] = (unsigned)c; tl[e_] = tiles_; }
            asm volatile("s_waitcnt lgkmcnt(0)" ::: "memory");
            int pre_ = 0;
#pragma unroll
            for (int i = 0; i < NEXP; ++i) { const int t_ = tl[i]; pre_ += (i < e_) ? t_ : 0; }
            if (F.lane < 32) LCTL[L_PRE + e_] = (unsigned)pre_;
            if (F.lane == 31) LCTL[L_PRE + NEXP] = (unsigned)(pre_ + tiles_);
        }
        __syncthreads();
    }
    const LAS int* Lpre = (const LAS int*)(F.lds + LDSCTL_OFF) + L_PRE; const LAS int* Lcnt = (const LAS int*)(F.lds + LDSCTL_OFF) + L_CNT;

    if (IN(6)) {
        pg8::MoeOrder S; S.init(Lpre, Lcnt, LIST2, 2 * DFF / 256, F.G, F.vcu);
        EpiSwiglu E{b_gate_up, ACT};
        for (int rep_ = 0; rep_ < NREP(6); ++rep_)
        pg8::gemm_phase<EpiSwiglu, pg8::MoeOrder, true, true, true, true>(F.lds + RING_OFF, H2, WGU, DM, 2 * DFF / 256, S, E, F.wave);
        if (BOTH(6)) GRID_BAR();
    }

    if (IN(7)) {
        pg8::MoeOrder S; S.init(Lpre, Lcnt, LIST2, DM / 256, F.G, F.vcu);
        EpiDown E{b_down, LIST2, Lcnt, YB};
        for (int rep_ = 0; rep_ < NREP(7); ++rep_)
        pg8::gemm_phase<EpiDown, pg8::MoeOrder, true, true, false, true>(F.lds + RING_OFF, ACT, WD, DFF, DM / 256, S, E, F.wave);
        if (BOTH(7)) GRID_BAR();
    }

    if (IN(8)) {
        const int lane8 = (int)__builtin_amdgcn_mbcnt_hi(~0u, __builtin_amdgcn_mbcnt_lo(~0u, 0u));
        for (int rep_ = 0; rep_ < NREP(8); ++rep_)
        for (int m = gw; m < MTOK; m += NGW) {
            const u32x2* xin = (const u32x2*)(X1 + (size_t)m * DM) + lane8;
            f32x4* xr = (f32x4*)(out + (size_t)m * DM) + lane8;
            f32x4 v[4];
#pragma unroll
            for (int j = 0; j < 4; ++j) { const u32x2 w_ = xin[64 * j]; v[j] = (f32x4){bflo(w_.x), bfhi(w_.x), bflo(w_.y), bfhi(w_.y)}; }
#pragma unroll
            for (int k = 0; k < 4; ++k) { const unsigned* yr = (const unsigned*)(YB + ((size_t)m * 4 + k) * DM) + lane8;
#pragma unroll
                for (int j = 0; j < 4; ++j) { const int w = (int)yr[64 * j]; const f32x2 lo_ = __builtin_amdgcn_cvt_pk_f32_fp8(w, false), hi_ = __builtin_amdgcn_cvt_pk_f32_fp8(w, true);
                    v[j].x += 0.25f * lo_.x; v[j].y += 0.25f * lo_.y; v[j].z += 0.25f * hi_.x; v[j].w += 0.25f * hi_.y; } }
            float s = 0.f;
#pragma unroll
            for (int j = 0; j < 4; ++j) s += (v[j].x * v[j].x + v[j].y * v[j].y) + (v[j].z * v[j].z + v[j].w * v[j].w);
            s = wave_sum(s); const float rs = rsqrtf(s * (1.0f / DM) + EPS);
#pragma unroll
            for (int j = 0; j < 4; ++j) { const f32x4 gg = *((const f32x4*)g_final + lane8 + 64 * j); xr[64 * j] = v[j] * rs * gg; }
        }
    }
#undef IN
#undef BOTH
#undef GRID_BAR
#undef x_in
#undef g_mix
#undef w_in
#undef qa_norm
#undef ka_norm
#undef sink_b
#undef w_br_a
#undef w_br_b
#undef w_out
#undef g_ffn
#undef w_router
#undef b_router
#undef w_gate_up
#undef b_gate_up
#undef w_down
#undef b_down
#undef g_final
}

extern "C" void kernel_launch(void* const* d_in, const int* in_sizes, int n_in, void* d_out, int out_size, void* d_ws, size_t ws_size, hipStream_t stream) {
    static int grid = 0;
    if (grid == 0) {
        if (n_in != 17 || out_size != MTOK * DM || ws_size < WS_END) { fprintf(stderr, "kernel_launch: unexpected problem shape (n_in %d out %d ws %zu)\n", n_in, out_size, ws_size); grid = -1; return; }
        int dev = 0, cus = 0;
        if (hipGetDevice(&dev) != hipSuccess || hipDeviceGetAttribute(&cus, hipDeviceAttributeMultiprocessorCount, dev) != hipSuccess) { grid = -1; return; }
        if (hipFuncSetAttribute((const void*)fwd_kernel, hipFuncAttributeMaxDynamicSharedMemorySize, LDS_BYTES) != hipSuccess) { fprintf(stderr, "kernel_launch: hipFuncSetAttribute failed\n"); grid = -1; return; }
        int per_cu = 0;
        if (hipOccupancyMaxActiveBlocksPerMultiprocessor(&per_cu, (const void*)fwd_kernel, 512, LDS_BYTES) != hipSuccess || per_cu < 1) { fprintf(stderr, "kernel_launch: occupancy query says %d\n", per_cu); }
        (void)hipGetLastError();
        grid = cus;
    }
    if (grid < 0) return;
    (void)hipMemsetAsync((char*)d_ws + WS_CTL, 0, CTL_ZERO_BYTES, stream);
    Args a{};
    for (int i = 0; i < 17; ++i) a.in[i] = (const float*)d_in[i];
    a.out = (float*)d_out; a.ws = (unsigned char*)d_ws;
    if (N_LAUNCHES == 1) {
        a.ph_lo = 0; a.ph_hi = NPHASE; a.li = 0;
        hipLaunchKernelGGL(fwd_kernel, dim3(grid), dim3(512), LDS_BYTES, stream, a);
#if defined(PROBE_PHASE)
        a.ph_lo = PROBE_PHASE; a.ph_hi = PROBE_PHASE + 1; a.li = 1;
        hipLaunchKernelGGL(fwd_kernel, dim3(grid), dim3(512), LDS_BYTES, stream, a);
#endif
    } else {
        for (int li = 0; li < NPHASE; ++li) { a.ph_lo = li; a.ph_hi = li + 1; a.li = li; hipLaunchKernelGGL(fwd_kernel, dim3(grid), dim3(512), LDS_BYTES, stream, a); }
    }
}
```

```cpp
#include <hip/hip_runtime.h>
#include <hip/hip_bf16.h>
#include <cstdio>
#include <cstdint>
#include <cmath>

#ifndef MK_N_LAUNCHES
#define MK_N_LAUNCHES 1
#endif

constexpr int BATCH = 2, SEQ = 8192, DM = 1024, MTOK = BATCH * SEQ;
constexpr int HD = 64, NQH = 8, NKVH = 2, QW = NQH * HD  , KVW = NKVH * HD  ;
constexpr int IN_COLS = 3584, NEXP = 32, TOPK = 4, DFF = 1024;
constexpr int NSLOT_ASSIGN = MTOK * TOPK;
constexpr int ACT_ROWS = NSLOT_ASSIGN + NEXP * 256;
constexpr float EPS = 1e-6f;
constexpr float C2 = 0.125f * 1.4426950408889634f;

#define LAS __attribute__((address_space(3)))
#define GAS __attribute__((address_space(1)))
typedef unsigned short bf16_t;
typedef short bf16x8 __attribute__((ext_vector_type(8)));
typedef float f32x4 __attribute__((ext_vector_type(4)));
typedef float f32x2 __attribute__((ext_vector_type(2)));
typedef unsigned u32x4 __attribute__((ext_vector_type(4)));
typedef unsigned u32x2 __attribute__((ext_vector_type(2)));
typedef int i32x8 __attribute__((ext_vector_type(8)));
typedef int i32x4 __attribute__((ext_vector_type(4)));
typedef i32x8 i32x8_a16 __attribute__((aligned(16)));
__device__ __forceinline__ unsigned pk4_fp8(float a, float b, float c, float d) { int w = 0; w = __builtin_amdgcn_cvt_pk_fp8_f32(a, b, w, false); w = __builtin_amdgcn_cvt_pk_fp8_f32(c, d, w, true); return (unsigned)w; }

__device__ __forceinline__ unsigned f2bf(float f) { unsigned u = __builtin_bit_cast(unsigned, f); return (u + 0x7fffu + ((u >> 16) & 1u)) >> 16; }
typedef __bf16 bf16x2_hw __attribute__((ext_vector_type(2)));
__device__ __forceinline__ unsigned pk2(float lo, float hi) { f32x2 v = {lo, hi}; bf16x2_hw b = __builtin_convertvector(v, bf16x2_hw); return __builtin_bit_cast(unsigned, b); }
__device__ __forceinline__ float bf2f(unsigned short b) { return __builtin_bit_cast(float, (unsigned)b << 16); }
__device__ __forceinline__ float bflo(unsigned w) { return __builtin_bit_cast(float, w << 16); }
__device__ __forceinline__ float bfhi(unsigned w) { return __builtin_bit_cast(float, w & 0xffff0000u); }
constexpr float SWI_C = -1.702f * 1.4426950408889634f;
__device__ __forceinline__ float sigmoidf_(float v) { return __builtin_amdgcn_rcpf(1.0f + __builtin_amdgcn_exp2f(v * -1.4426950408889634f)); }
__device__ __forceinline__ int lane_fresh() { int l; asm volatile("v_mbcnt_lo_u32_b32 %0, -1, 0\n\tv_mbcnt_hi_u32_b32 %0, -1, %0" : "=v"(l)); return l; }
template <int CTRL> __device__ __forceinline__ float dpp_f(float v) { return __builtin_bit_cast(float, __builtin_amdgcn_update_dpp(0, __builtin_bit_cast(int, v), CTRL, 0xf, 0xf, true)); }
__device__ __forceinline__ float row_sum16(float v) { v += dpp_f<0xB1>(v); v += dpp_f<0x4E>(v); v += dpp_f<0x141>(v); v += dpp_f<0x140>(v); return v; }
__device__ __forceinline__ float row_max16(float v) { v = fmaxf(v, dpp_f<0xB1>(v)); v = fmaxf(v, dpp_f<0x4E>(v)); v = fmaxf(v, dpp_f<0x141>(v)); v = fmaxf(v, dpp_f<0x140>(v)); return v; }
__device__ __forceinline__ float swap16_sum(float v) { const auto r = __builtin_amdgcn_permlane16_swap(__float_as_uint(v), __float_as_uint(v), false, false); return __uint_as_float(r[0]) + __uint_as_float(r[1]); }
__device__ __forceinline__ float swap32_sum(float v) { const auto r = __builtin_amdgcn_permlane32_swap(__float_as_uint(v), __float_as_uint(v), false, false); return __uint_as_float(r[0]) + __uint_as_float(r[1]); }
__device__ __forceinline__ float swap16_max(float v) { const auto r = __builtin_amdgcn_permlane16_swap(__float_as_uint(v), __float_as_uint(v), false, false); return fmaxf(__uint_as_float(r[0]), __uint_as_float(r[1])); }
__device__ __forceinline__ float swap32_max(float v) { const auto r = __builtin_amdgcn_permlane32_swap(__float_as_uint(v), __float_as_uint(v), false, false); return fmaxf(__uint_as_float(r[0]), __uint_as_float(r[1])); }
__device__ __forceinline__ float wave_sum(float v) { return swap32_sum(swap16_sum(row_sum16(v))); }
__device__ __forceinline__ float wave_max(float v) { return swap32_max(swap16_max(row_max16(v))); }

namespace pg8 {
constexpr int BM = 256, BK = 64, HALF = 128, HTB = HALF * BK * 2, STAGE_BYTES = 8 * HTB, NXCD = 8, WGM = 8;
__host__ __device__ __forceinline__ int lds_byte(int r, int c) { const int st = (r >> 4) * 2 + (c >> 5), rr = r & 15, cc = c & 31, ob = rr * 64 + cc * 2; return st * 1024 + (ob ^ (((ob >> 9) & 1) << 5)); }
__host__ __device__ __forceinline__ void stage_rc(int b, int& R, int& C) { const int st = b / 1024, sb = b % 1024, swz = sb ^ (((sb >> 9) & 1) << 5); R = (st >> 1) * 16 + swz / 64; C = (st & 1) * 32 + (swz % 64) / 2; }
__host__ __device__ __forceinline__ int perm32(int rho) { const int n = rho >> 4, i = rho & 15; return 8 * (i >> 2) + 4 * n + (i & 3); }

struct Unit { int pm, pn, e, pml; };

struct StaticOrder {
    int nM, nN, nwg, G, c;
    __device__ void init(int M, int N, int G_, int c_) { nM = M / BM; nN = N / BM; nwg = nM * nN; G = G_; c = c_; }
    __device__ bool next(int i, Unit& u) const {
        const long L = (long)i * G + c; if (L >= nwg) return false;
        int wgid = (int)L; { const int q = nwg / NXCD, r = nwg % NXCD, xcd = wgid % NXCD, off = wgid / NXCD; wgid = (xcd < r ? xcd * (q + 1) : r * (q + 1) + (xcd - r) * q) + off; }
        const int nig = WGM * nN, gid = wgid / nig, fm = gid * WGM, gsz = (nM - fm) < WGM ? (nM - fm) : WGM;
        u.pm = fm + ((wgid % nig) % gsz); u.pn = (wgid % nig) / gsz; u.e = 0; u.pml = u.pm; return true;
    }
    __device__ __forceinline__ unsigned a_rowoff(const Unit&, int) const { return 0u; }
    static constexpr bool LAZY = false;
    __device__ __forceinline__ void prefetch(int) const {}
};

struct PairOrder {
    StaticOrder so; int nM;
    static constexpr bool LAZY = false;
    __device__ void init(int M, int N, int G, int c) { so.init(M, N, G, c); nM = M / BM; }
    __device__ bool next(int i, Unit& u) const { if (i >= 2 || !so.next(0, u)) return false; u.e = i; u.pml = u.pm; u.pm = u.pm + i * nM; return true; }
    __device__ __forceinline__ void prefetch(int) const {}
    __device__ __forceinline__ unsigned a_rowoff(const Unit&, int) const { return 0u; }
};

struct TicketOrder {
    StaticOrder so; unsigned* ctr; volatile LAS int* slot; int x, cpx, wave;
    static constexpr bool LAZY = true;
    __device__ void init(int M, int N, int G, int vcu, unsigned* ctr_base, volatile LAS int* slot_, int wave_) { wave = wave_; so.init(M, N, G, 0); cpx = (G % 8 == 0) ? G / 8 : G; x = vcu / cpx; ctr = ctr_base + 64 * x; slot = slot_; }
    __device__ __forceinline__ void prefetch(int i) const { if (wave == 0 && lane_fresh() == 0) { const int t = (int)__hip_atomic_fetch_add(ctr, 1u, __ATOMIC_RELAXED, __HIP_MEMORY_SCOPE_AGENT); slot[i & 1] = t; } }
    __device__ bool next(int i, Unit& u) const {
        const int t = slot[i & 1]; StaticOrder s2 = so; s2.c = 8 * (t % cpx) + x; if (so.G % 8 != 0) s2.c = t % cpx;
        return s2.next(t / cpx, u);
    }
    __device__ __forceinline__ unsigned a_rowoff(const Unit&, int) const { return 0u; }
};

struct MoeOrder {
    const LAS int* pre; const LAS int* cnt; const u32x2* list; int npn, lo, hi, j, cpx; unsigned rowbytes;
    __device__ void init(const LAS int* pre_, const LAS int* cnt_, const u32x2* list_, int npn_, int G, int vcu) {
        pre = pre_; cnt = cnt_; list = list_; npn = npn_; rowbytes = (unsigned)DM;
        const int U = pre[NEXP] * npn; cpx = (G % 8 == 0) ? G / 8 : G; const int nx = G / cpx, x = vcu / cpx; j = vcu % cpx;
        lo = (int)((long)U * x / nx); hi = (int)((long)U * (x + 1) / nx);
    }
    __device__ bool next(int i, Unit& u) const {
        const int L = lo + j + cpx * i; if (L >= hi) return false;
        const int tr = L / npn; u.pn = L % npn; int e = 0;
#pragma unroll
        for (int st = NEXP / 2; st > 0; st >>= 1) { if (pre[e + st] <= tr) e += st; }
        u.e = e; u.pm = tr; u.pml = tr - pre[e]; return true;
    }
    static constexpr bool LAZY = false;
    __device__ __forceinline__ void prefetch(int) const {}
    __device__ __forceinline__ unsigned a_rowoff(const Unit& u, int R) const {
        const int idx = u.pml * BM + R; const int ic = idx < cnt[u.e] ? idx : 0;
        const int slot = (int)list[u.e * MTOK + ic].x;
        return (unsigned)(slot >> 2) * rowbytes;
    }
};

template <class Epi, class Sched, bool ALIGN_EPI, bool SP2, bool GATHER, bool F8 = false>
__device__ __forceinline__ void gemm_phase(LAS unsigned char* lds, const void* Aptr, const void* Btptr, const int K, const int NBT, const Sched& S, const Epi& E, const int wave_, const int scla_ = 0x7f7f7f7f) {
    const int wid = wave_, lane = lane_fresh(), tid = wid * 64 + lane, wr = wid >> 2, wc = wid & 3, fr = lane & 15, fq = lane >> 4;
    constexpr int EB = F8 ? 1 : 2; const int nt = K * EB / (BK * 2);
    unsigned voffA[2], voffB[2]; int R0, C0;
#pragma unroll
    for (int i = 0; i < 2; ++i) { const int R = 8 * wid + 64 * i + (lane >> 3), cl = (lane & 7) ^ ((R >> 1) & 7); const int Rb = Epi::PERM ? ((R & ~31) + perm32(R & 31)) : R;
        voffA[i] = (unsigned)(R * K * EB + cl * 16); voffB[i] = (unsigned)(Rb * K * EB + cl * 16); if (i == 0) { R0 = R; C0 = cl * 8; } }
    const size_t kstep = (size_t)(BK * 2);
    const size_t hstep = (size_t)HALF * K * EB;
    const size_t tstep = 2 * hstep;
    const unsigned ldsw = (unsigned)wid * 1024u;
    const int sw_ = (fr >> 1) & 7; int aoffk[2], boffk[2];
#pragma unroll
    for (int k = 0; k < 2; ++k) { aoffk[k] = (wr * 64 + fr) * 128 + (((fq + 4 * k) ^ sw_) << 4); boffk[k] = (wc * 32 + fr) * 128 + (((fq + 4 * k) ^ sw_) << 4); }
    unsigned gc[2][2], gn[2][2];
#define PG8_SA(b, h) (((b) * 2 + (h)) * HTB)
#define PG8_SB(b, h) ((4 + (b) * 2 + (h)) * HTB)
#define PG8_GLDS(src, dstoff) __builtin_amdgcn_global_load_lds((const unsigned*)(src), (LAS unsigned*)(lds + (dstoff)), 16, 0, 0)
#define PG8_STAGE(bufoff, gbase, voff) do { _Pragma("unroll") for (int _i = 0; _i < 2; ++_i) PG8_GLDS((const char*)(gbase) + (voff)[_i], (bufoff) + ldsw + _i * 8192); } while (0)
#define PG8_STAGE_A(bufoff, kbase, h, usen) do { if constexpr (GATHER) { _Pragma("unroll") for (int _i = 0; _i < 2; ++_i) { const unsigned _o = (usen) ? gn[h][_i] : gc[h][_i]; PG8_GLDS((const char*)(kbase) + _o, (bufoff) + ldsw + _i * 8192); } } \
        else { PG8_STAGE(bufoff, (const char*)(kbase) + (h) * hstep, voffA); } } while (0)
#define PG8_GOFFS(g, u) do { _Pragma("unroll") for (int _h = 0; _h < 2; ++_h) _Pragma("unroll") for (int _i = 0; _i < 2; ++_i) g[_h][_i] = S.a_rowoff(u, _h * HALF + R0 + 64 * _i) + (unsigned)(C0 * 2); } while (0)
#define PG8_LDA8(dst, b, h) do { _Pragma("unroll") for (int m = 0; m < 4; ++m) { const i32x4 _lo = *(const LAS i32x4*)(lds + PG8_SA(b, h) + aoffk[0] + m * 2048), _hi = *(const LAS i32x4*)(lds + PG8_SA(b, h) + aoffk[1] + m * 2048); dst[m] = (i32x8){_lo.x, _lo.y, _lo.z, _lo.w, _hi.x, _hi.y, _hi.z, _hi.w}; } } while (0)
#define PG8_LDB8(dst, b, h) do { _Pragma("unroll") for (int n = 0; n < 2; ++n) { const i32x4 _lo = *(const LAS i32x4*)(lds + PG8_SB(b, h) + boffk[0] + n * 2048), _hi = *(const LAS i32x4*)(lds + PG8_SB(b, h) + boffk[1] + n * 2048); dst[n] = (i32x8){_lo.x, _lo.y, _lo.z, _lo.w, _hi.x, _hi.y, _hi.z, _hi.w}; } } while (0)
#define PG8_MMA8(ai, bj, At, Bt) do { __builtin_amdgcn_s_setprio(1); _Pragma("unroll") for (int m = 0; m < 4; ++m) _Pragma("unroll") for (int n = 0; n < 2; ++n) \
        asm volatile("v_mfma_scale_f32_16x16x128_f8f6f4 %0, %1, %2, %0, %3, %4 op_sel_hi:[0,0,0]" : "+v"(acc[ai][bj][m][n]) : "v"(Bt[n]), "v"(At[m]), "v"(sclw), "v"(scla)); __builtin_amdgcn_s_setprio(0); } while (0)
#define PG8_LDA(dst, b, h) do { _Pragma("unroll") for (int m = 0; m < 4; ++m) _Pragma("unroll") for (int k = 0; k < 2; ++k) dst[m][k] = *(const LAS bf16x8*)(lds + PG8_SA(b, h) + aoffk[k] + m * 2048); } while (0)
#define PG8_LDB(dst, b, h) do { _Pragma("unroll") for (int n = 0; n < 2; ++n) _Pragma("unroll") for (int k = 0; k < 2; ++k) dst[n][k] = *(const LAS bf16x8*)(lds + PG8_SB(b, h) + boffk[k] + n * 2048); } while (0)
#define PG8_MMA(ai, bj, At, Bt) do { __builtin_amdgcn_s_setprio(1); _Pragma("unroll") for (int m = 0; m < 4; ++m) _Pragma("unroll") for (int n = 0; n < 2; ++n) _Pragma("unroll") for (int k = 0; k < 2; ++k) \
        acc[ai][bj][m][n] = __builtin_amdgcn_mfma_f32_16x16x32_bf16(Bt[n][k], At[m][k], acc[ai][bj][m][n], 0, 0, 0); __builtin_amdgcn_s_setprio(0); } while (0)
#define PG8_WAIT_V(n) asm volatile("s_waitcnt vmcnt(" #n ")" ::: "memory")
#define PG8_WAIT_L(n) asm volatile("s_waitcnt lgkmcnt(" #n ")" ::: "memory")
#define PG8_BAR __builtin_amdgcn_s_barrier()
#define PG8_SCHED __builtin_amdgcn_sched_barrier(0)
    constexpr int ROWS_OFF = STAGE_BYTES + 6144;
    constexpr int PRE_OFF = STAGE_BYTES + 4096;
    Unit cur, nxt; int ui = 0;
    if constexpr (Sched::LAZY) { S.prefetch(0); asm volatile("s_waitcnt vmcnt(0) lgkmcnt(0)" ::: "memory"); __builtin_amdgcn_s_barrier(); asm volatile("" ::: "memory"); }
    if (!S.next(0, cur)) return;
    f32x4 acc[2][2][4][2];
#pragma unroll
    for (int a = 0; a < 2; ++a)
#pragma unroll
        for (int b = 0; b < 2; ++b)
#pragma unroll
            for (int m = 0; m < 4; ++m)
#pragma unroll
                for (int n = 0; n < 2; ++n) acc[a][b][m][n] = (f32x4){0.f, 0.f, 0.f, 0.f};
    bf16x8 At[4][2], B0[2][2], B1[2][2]; i32x8 At8[4], B08[2], B18[2];
    int sclw = 0x7a7a7a7a, scla = scla_; asm volatile("" : "+v"(sclw), "+v"(scla));
    const char* cA = GATHER ? (const char*)Aptr : (const char*)Aptr + (size_t)cur.pm * tstep;
    const char* cB = (const char*)Btptr + ((size_t)cur.e * NBT + cur.pn) * tstep;
    if constexpr (GATHER) { PG8_GOFFS(gc, cur); PG8_GOFFS(gn, cur); }
    if constexpr (Epi::HAS_PRE) { if (wid == 0) E.pre(cur, lds + PRE_OFF, lane); }
    static_assert(SP2, "only the SP2 loop is kept here");
    PG8_STAGE(PG8_SB(0, 0), cB, voffB); PG8_STAGE(PG8_SB(0, 1), cB + hstep, voffB); PG8_STAGE_A(PG8_SA(0, 0), cA, 0, false); PG8_STAGE_A(PG8_SA(0, 1), cA, 1, false);
    if (wr == 1) PG8_BAR;
    PG8_WAIT_V(2); PG8_BAR;
    PG8_STAGE(PG8_SB(1, 0), cB + kstep, voffB); PG8_STAGE_A(PG8_SA(1, 0), cA + kstep, 0, false); PG8_STAGE(PG8_SB(1, 1), cB + hstep + kstep, voffB);
    PG8_WAIT_V(6); PG8_BAR;
    if constexpr (Epi::HAS_PRE) E.init(acc, (const LAS float*)(lds + PRE_OFF), wc, fq);
    for (;;) {
        bool has_next = false; const char* nA = cA; const char* nB = cB;
        if constexpr (Epi::HAS_ROWS) E.rows(cur, lds + ROWS_OFF + (ui & 1) * 2048, wid, lane);
        if constexpr (Sched::LAZY) { S.prefetch(ui + 1); }
        else { has_next = S.next(ui + 1, nxt);
            nA = GATHER ? (const char*)Aptr : (has_next ? (const char*)Aptr + (size_t)nxt.pm * tstep : cA);
            nB = has_next ? (const char*)Btptr + ((size_t)nxt.e * NBT + nxt.pn) * tstep : cB;
            if constexpr (GATHER) { if (has_next) { PG8_GOFFS(gn, nxt); } }
            if constexpr (Epi::HAS_PRE) { if (has_next && wid == 0) E.pre(nxt, lds + PRE_OFF + ((ui + 1) & 1) * 1024, lane); } }
        for (int t = 0; t < nt; t += 2) {
            const bool last = (t == nt - 2);
            if constexpr (Sched::LAZY) { if (last) { has_next = S.next(ui + 1, nxt);
                nA = has_next ? (const char*)Aptr + (size_t)nxt.pm * tstep : cA; nB = has_next ? (const char*)Btptr + ((size_t)nxt.e * NBT + nxt.pn) * tstep : cB; } }
            const char* a1 = cA + (size_t)(t + 1) * kstep;
            const char* a2 = last ? nA : cA + (size_t)(t + 2) * kstep; const char* b2 = last ? nB : cB + (size_t)(t + 2) * kstep;
            const char* a3 = a2 + kstep; const char* b3 = b2 + kstep;
            const bool usen = last && has_next;
#define XLDB0(b, h) do { if constexpr (F8) { PG8_LDB8(B08, b, h); } else { PG8_LDB(B0, b, h); } } while (0)
#define XLDB1(b, h) do { if constexpr (F8) { PG8_LDB8(B18, b, h); } else { PG8_LDB(B1, b, h); } } while (0)
#define XLDA(b, h) do { if constexpr (F8) { PG8_LDA8(At8, b, h); } else { PG8_LDA(At, b, h); } } while (0)
#define XMMA0(ai) do { if constexpr (F8) { PG8_MMA8(ai, 0, At8, B08); } else { PG8_MMA(ai, 0, At, B0); } } while (0)
#define XMMA1(ai) do { if constexpr (F8) { PG8_MMA8(ai, 1, At8, B18); } else { PG8_MMA(ai, 1, At, B1); } } while (0)
            XLDB0(0, 0); XLDB1(0, 1); PG8_SCHED; XLDA(0, 0); PG8_STAGE_A(PG8_SA(1, 1), a1, 1, false);
            PG8_WAIT_V(8); PG8_WAIT_L(0); PG8_BAR; XMMA0(0); XMMA1(0); PG8_BAR; PG8_SCHED;
            XLDA(0, 1); PG8_STAGE(PG8_SB(0, 0), b2, voffB); PG8_STAGE(PG8_SB(0, 1), b2 + hstep, voffB); PG8_STAGE_A(PG8_SA(0, 0), a2, 0, usen);
            PG8_WAIT_V(8); PG8_WAIT_L(0); PG8_BAR; XMMA0(1); XMMA1(1); PG8_BAR; PG8_SCHED;
            XLDB0(1, 0); XLDB1(1, 1); PG8_SCHED; XLDA(1, 0); PG8_STAGE_A(PG8_SA(0, 1), a2, 1, usen);
            PG8_WAIT_V(8); PG8_WAIT_L(0); PG8_BAR; XMMA0(0); XMMA1(0); PG8_BAR; PG8_SCHED;
            XLDA(1, 1); PG8_STAGE(PG8_SB(1, 0), b3, voffB); PG8_STAGE(PG8_SB(1, 1), b3 + hstep, voffB); PG8_STAGE_A(PG8_SA(1, 0), a3, 0, usen);
            PG8_WAIT_V(8); PG8_WAIT_L(0); PG8_BAR; XMMA0(1); XMMA1(1); PG8_BAR; PG8_SCHED;
#undef XLDB0
#undef XLDB1
#undef XLDA
#undef XMMA0
#undef XMMA1
        }
        if constexpr (ALIGN_EPI) { if (wr == 0) PG8_BAR; }
        if constexpr (F8) asm volatile("s_nop 15\n\ts_nop 7" ::: "memory");
        if constexpr (Epi::HAS_ROWS) E(acc, cur, wr, wc, fr, fq, lds + ROWS_OFF + (ui & 1) * 2048); else E(acc, cur, wr, wc, fr, fq);
        if (!has_next) break;
        if constexpr (Epi::HAS_PRE) E.init(acc, (const LAS float*)(lds + PRE_OFF + ((ui + 1) & 1) * 1024), wc, fq);
        else if (!Epi::keeps(cur)) {
#pragma unroll
        for (int a = 0; a < 2; ++a)
#pragma unroll
            for (int b = 0; b < 2; ++b)
#pragma unroll
                for (int m = 0; m < 4; ++m)
#pragma unroll
                    for (int n = 0; n < 2; ++n) acc[a][b][m][n] = (f32x4){0.f, 0.f, 0.f, 0.f};
        }
        cur = nxt; cA = nA; cB = nB; ++ui;
        if constexpr (GATHER) {
#pragma unroll
            for (int h = 0; h < 2; ++h)
#pragma unroll
                for (int i = 0; i < 2; ++i) gc[h][i] = gn[h][i];
        }
        if constexpr (ALIGN_EPI) { if (wr == 1) PG8_BAR; }
    }
    PG8_WAIT_V(0);
    if constexpr (!ALIGN_EPI) { if (wr == 0) PG8_BAR; }
    PG8_BAR;
#undef PG8_SA
#undef PG8_SB
#undef PG8_GLDS
#undef PG8_STAGE
#undef PG8_STAGE_A
#undef PG8_GOFFS
#undef PG8_LDA
#undef PG8_LDA8
#undef PG8_LDB8
#undef PG8_MMA8
#undef PG8_LDB
#undef PG8_MMA
#undef PG8_WAIT_V
#undef PG8_WAIT_L
#undef PG8_BAR
#undef PG8_SCHED
}
}

__device__ __forceinline__ u32x4 swap16_pair(u32x2 x, u32x2 y) {
    const auto lo = __builtin_amdgcn_permlane16_swap(x.x, y.x, false, false);
    const auto hi = __builtin_amdgcn_permlane16_swap(x.y, y.y, false, false);
    u32x4 r; r.x = lo[0]; r.y = hi[0]; r.z = lo[1]; r.w = hi[1]; return r;
}

typedef f32x4 AccT[2][2][4][2];

struct EpiInProj {
    static constexpr bool PERM = true, HAS_PRE = false, HAS_ROWS = true;
    __device__ __forceinline__ static bool keeps(const pg8::Unit&) { return false; }
    const float* rstd; const float* qa_g; const float* ka_g; const unsigned* csA; const unsigned* csB;
    unsigned char *QA; bf16_t *KA, *VA; unsigned char *QB; bf16_t *KB, *VB; unsigned char *GA, *GB;
    __device__ __forceinline__ static void store16(bf16_t* rp, const f32x4 (&v)[2][2]) {
#pragma unroll
        for (int bj = 0; bj < 2; ++bj) { u32x4 w; w.x = pk2(v[bj][0][0], v[bj][0][1]); w.y = pk2(v[bj][0][2], v[bj][0][3]); w.z = pk2(v[bj][1][0], v[bj][1][1]); w.w = pk2(v[bj][1][2], v[bj][1][3]);
            *(u32x4*)(rp + 32 * bj) = w; }
    }
    __device__ __forceinline__ static void store_tile(bf16_t* buf, int tmode, int kvh, int row, int fq, const f32x4 (&v)[2][2]) {
        const int t = row & (SEQ - 1), bb = row >> 13, r = t & 63; char* tb = (char*)buf + ((size_t)((bb * NKVH + kvh) * (SEQ / 64) + (t >> 6))) * 8192;
#pragma unroll
        for (int bj = 0; bj < 2; ++bj) { u32x4 w; w.x = pk2(v[bj][0][0], v[bj][0][1]); w.y = pk2(v[bj][0][2], v[bj][0][3]); w.z = pk2(v[bj][1][0], v[bj][1][1]); w.w = pk2(v[bj][1][2], v[bj][1][3]);
            const int off = (tmode == 1) ? ((4 * bj + fq) * 1024 + r * 16) : ((bj * 4 + (r >> 4)) * 1024 + (r & 15) * 64 + 16 * fq);
            *(u32x4*)(tb + off) = w; }
    }
    __device__ __forceinline__ void rows(const pg8::Unit& u, LAS unsigned char* dst, int wid, int lane) const {
        if (wid == 0) __builtin_amdgcn_global_load_lds((const unsigned*)(rstd + u.pm * 256 + lane * 4), (LAS unsigned*)dst, 16, 0, 0);
    }
    __device__ __forceinline__ void operator()(const AccT& acc, const pg8::Unit& u, int wr, int wc, int fr, int fq, const LAS unsigned char* rl) const {
        const LAS float* rsl = (const LAS float*)rl + wr * 64 + fr;
        const int s = 4 * u.pn + wc;
        int kind; bf16_t* dst; int pitch; const float* gain = nullptr; const unsigned* ct = nullptr; float qs = 1.f; int tmode = 0, kvh_ = 0;
        unsigned char* qdst = nullptr;
        if (s < 8) { kind = 0; dst = nullptr; qdst = QA + s * 64; pitch = QW; gain = qa_g; ct = csA; qs = C2 * 8.0f; }
        else if (s < 10) { kind = 0; dst = KA; pitch = KVW; gain = ka_g; ct = csA; tmode = 1; kvh_ = s - 8; }
        else if (s < 12) { kind = 2; dst = VA; pitch = KVW; tmode = 2; kvh_ = s - 10; }
        else if (s < 20) { kind = 1; dst = nullptr; qdst = QB + (s - 12) * 64; pitch = QW; ct = csB; qs = C2 * 8.0f; }
        else if (s < 22) { kind = 1; dst = KB; pitch = KVW; ct = csB; tmode = 1; kvh_ = s - 20; }
        else if (s < 24) { kind = 2; dst = VB; pitch = KVW; tmode = 2; kvh_ = s - 22; }
        else { kind = 3; dst = nullptr; pitch = DM; }
        unsigned char* gdst = (s < 40) ? GA + (s - 24) * 64 : GB + (s - 40) * 64;
        const int row0 = u.pm * 256 + wr * 64 + fr;
        if (kind >= 2) {
#pragma unroll
            for (int ai = 0; ai < 2; ++ai) {
                float rs[2][4];
#pragma unroll
                for (int m = 0; m < 4; ++m) rs[ai][m] = rsl[ai * 128 + m * 16];
#pragma unroll
                for (int m = 0; m < 4; ++m) {
                    const int row = row0 + ai * 128 + m * 16; f32x4 v[2][2];
#pragma unroll
                    for (int bj = 0; bj < 2; ++bj)
#pragma unroll
                        for (int n = 0; n < 2; ++n) {
                            if (kind == 3) { const float rsn = rs[ai][m] * -1.4426950408889634f;
#pragma unroll
                                for (int j = 0; j < 4; ++j) v[bj][n][j] = __builtin_amdgcn_rcpf(1.0f + __builtin_amdgcn_exp2f(acc[ai][bj][m][n][j] * rsn)); }
                            else v[bj][n] = acc[ai][bj][m][n] * rs[ai][m]; }
                    if (kind == 3) {
                        u32x2 w[2];
#pragma unroll
                        for (int bj = 0; bj < 2; ++bj) { w[bj].x = pk4_fp8(v[bj][0][0], v[bj][0][1], v[bj][0][2], v[bj][0][3]); w[bj].y = pk4_fp8(v[bj][1][0], v[bj][1][1], v[bj][1][2], v[bj][1][3]); }
                        const u32x4 q = swap16_pair(w[0], w[1]);
                        *(u32x4*)(gdst + (size_t)row * DM + (fq & 1) * 32 + 16 * (fq >> 1)) = q;
                    }
                    else if (tmode) store_tile(dst, tmode, kvh_, row, fq, v); else store16(dst + (size_t)row * pitch + 8 * fq, v);
                }
            }
            return;
        }
        f32x4 gv[2][2];
        if (kind == 0) {
#pragma unroll
            for (int bj = 0; bj < 2; ++bj)
#pragma unroll
                for (int n = 0; n < 2; ++n) gv[bj][n] = *(const f32x4*)(gain + 32 * bj + 8 * fq + 4 * n);
        }
#pragma unroll
        for (int hm = 0; hm < 4; ++hm) {
            const int ai = hm >> 1, m0 = (hm & 1) * 2;
            float rs[2][4]; rs[ai][m0] = rsl[ai * 128 + m0 * 16]; rs[ai][m0 + 1] = rsl[ai * 128 + (m0 + 1) * 16];
            u32x4 tb[2][2];
#pragma unroll
            for (int mm = 0; mm < 2; ++mm) { const int t = (row0 + ai * 128 + (m0 + mm) * 16) & (SEQ - 1);
#pragma unroll
                for (int n = 0; n < 2; ++n) tb[mm][n] = *(const u32x4*)(ct + t * 32 + 8 * fq + 4 * n); }
#pragma unroll
            for (int mm = 0; mm < 2; ++mm) {
                const int m = m0 + mm; const int row = row0 + ai * 128 + m * 16; f32x4 v[2][2];
#pragma unroll
                for (int bj = 0; bj < 2; ++bj)
#pragma unroll
                    for (int n = 0; n < 2; ++n) v[bj][n] = acc[ai][bj][m][n] * (kind == 1 ? rs[ai][m] * qs : rs[ai][m]);
                if (kind == 0) {
                    float ss = 0.f;
#pragma unroll
                    for (int bj = 0; bj < 2; ++bj)
#pragma unroll
                        for (int n = 0; n < 2; ++n) { const f32x4 x = v[bj][n]; ss += (x[0] * x[0] + x[1] * x[1]) + (x[2] * x[2] + x[3] * x[3]); }
                    ss = swap32_sum(swap16_sum(ss));
                    const float r = rsqrtf(ss * (1.0f / 64.0f) + EPS) * qs;
#pragma unroll
                    for (int bj = 0; bj < 2; ++bj)
#pragma unroll
                        for (int n = 0; n < 2; ++n) v[bj][n] = v[bj][n] * r * gv[bj][n];
                }
#pragma unroll
                for (int n = 0; n < 2; ++n) { const f32x4 x1 = v[0][n], x2 = v[1][n]; const u32x4 w = tb[mm][n];
                    const f32x4 c_ = {bflo(w.x), bflo(w.y), bflo(w.z), bflo(w.w)}, s_ = {bfhi(w.x), bfhi(w.y), bfhi(w.z), bfhi(w.w)};
                    v[0][n] = x1 * c_ - x2 * s_; v[1][n] = x2 * c_ + x1 * s_; }
                if (tmode) store_tile(dst, tmode, kvh_, row, fq, v);
                else {
                    u32x2 w[2];
#pragma unroll
                    for (int bj = 0; bj < 2; ++bj) { w[bj].x = pk4_fp8(v[bj][0][0], v[bj][0][1], v[bj][0][2], v[bj][0][3]); w[bj].y = pk4_fp8(v[bj][1][0], v[bj][1][1], v[bj][1][2], v[bj][1][3]); }
                    const u32x4 q = swap16_pair(w[0], w[1]);
                    *(u32x4*)(qdst + (size_t)row * QW + (fq & 1) * 32 + 16 * (fq >> 1)) = q;
                }
            }
        }
    }
};

template <bool FIRST> struct EpiGate {
    static constexpr bool PERM = true, HAS_PRE = false, HAS_ROWS = false;
    __device__ __forceinline__ static bool keeps(const pg8::Unit&) { return false; }
    const bf16_t* G; bf16_t* O;
    __device__ __forceinline__ void operator()(const AccT& acc, const pg8::Unit& u, int wr, int wc, int fr, int fq) const {
#pragma unroll
        for (int ai = 0; ai < 2; ++ai)
#pragma unroll
            for (int m = 0; m < 4; ++m) {
                const size_t row = (size_t)(u.pm * 256 + ai * 128 + wr * 64 + m * 16 + fr);
#pragma unroll
                for (int bj = 0; bj < 2; ++bj) {
                    const size_t off = row * DM + u.pn * 256 + bj * 128 + wc * 32 + 8 * fq;
                    const u32x4 g = *(const u32x4*)(G + off);
                    f32x4 v0 = acc[ai][bj][m][0], v1 = acc[ai][bj][m][1];
                    v0[0] *= bflo(g.x); v0[1] *= bfhi(g.x); v0[2] *= bflo(g.y); v0[3] *= bfhi(g.y);
                    v1[0] *= bflo(g.z); v1[1] *= bfhi(g.z); v1[2] *= bflo(g.w); v1[3] *= bfhi(g.w);
                    if (!FIRST) { const u32x4 p = *(const u32x4*)(O + off);
                        v0[0] += bflo(p.x); v0[1] += bfhi(p.x); v0[2] += bflo(p.y); v0[3] += bfhi(p.y);
                        v1[0] += bflo(p.z); v1[1] += bfhi(p.z); v1[2] += bflo(p.w); v1[3] += bfhi(p.w); }
                    u32x4 w; w.x = pk2(v0[0], v0[1]); w.y = pk2(v0[2], v0[3]); w.z = pk2(v1[0], v1[1]); w.w = pk2(v1[2], v1[3]);
                    *(u32x4*)(O + off) = w;
                }
            }
    }
};

struct EpiGateFused {
    static constexpr bool PERM = true, HAS_PRE = false, HAS_ROWS = false;
    const unsigned char* GA; const unsigned char* GB; unsigned char* O;
    __device__ __forceinline__ static bool keeps(const pg8::Unit& u) { return u.e == 0; }
    __device__ __forceinline__ void operator()(AccT& acc, const pg8::Unit& u, int wr, int wc, int fr, int fq) const {
        const size_t base = (size_t)(u.pml * 256 + wr * 64 + fr) * DM + u.pn * 256 + wc * 32 + 8 * fq;
        if (u.e == 0) {
#pragma unroll
            for (int ai = 0; ai < 2; ++ai)
#pragma unroll
                for (int m = 0; m < 4; ++m)
#pragma unroll
                    for (int bj = 0; bj < 2; ++bj) {
                        const size_t off = base + (size_t)(ai * 128 + m * 16) * DM + bj * 128;
                        const u32x2 a = *(const u32x2*)(GA + off), b = *(const u32x2*)(GB + off);
                        const f32x2 a0 = __builtin_amdgcn_cvt_pk_f32_fp8((int)a.x, false), a1 = __builtin_amdgcn_cvt_pk_f32_fp8((int)a.x, true), a2 = __builtin_amdgcn_cvt_pk_f32_fp8((int)a.y, false), a3 = __builtin_amdgcn_cvt_pk_f32_fp8((int)a.y, true);
                        const f32x2 b0 = __builtin_amdgcn_cvt_pk_f32_fp8((int)b.x, false), b1 = __builtin_amdgcn_cvt_pk_f32_fp8((int)b.x, true), b2 = __builtin_amdgcn_cvt_pk_f32_fp8((int)b.y, false), b3 = __builtin_amdgcn_cvt_pk_f32_fp8((int)b.y, true);
                        f32x4& v0 = acc[ai][bj][m][0]; f32x4& v1 = acc[ai][bj][m][1];
                        v0[0] *= b0.x * __builtin_amdgcn_rcpf(fmaxf(a0.x, 1e-30f)); v0[1] *= b0.y * __builtin_amdgcn_rcpf(fmaxf(a0.y, 1e-30f)); v0[2] *= b1.x * __builtin_amdgcn_rcpf(fmaxf(a1.x, 1e-30f)); v0[3] *= b1.y * __builtin_amdgcn_rcpf(fmaxf(a1.y, 1e-30f));
                        v1[0] *= b2.x * __builtin_amdgcn_rcpf(fmaxf(a2.x, 1e-30f)); v1[1] *= b2.y * __builtin_amdgcn_rcpf(fmaxf(a2.y, 1e-30f)); v1[2] *= b3.x * __builtin_amdgcn_rcpf(fmaxf(a3.x, 1e-30f)); v1[3] *= b3.y * __builtin_amdgcn_rcpf(fmaxf(a3.y, 1e-30f));
                    }
        } else {
#pragma unroll
            for (int ai = 0; ai < 2; ++ai)
#pragma unroll
                for (int m = 0; m < 4; ++m)
                {
                    u32x2 w[2];
#pragma unroll
                    for (int bj = 0; bj < 2; ++bj) {
                        const size_t off = base + (size_t)(ai * 128 + m * 16) * DM + bj * 128;
                        const u32x2 a = *(const u32x2*)(GA + off);
                        const f32x2 a0 = __builtin_amdgcn_cvt_pk_f32_fp8((int)a.x, false), a1 = __builtin_amdgcn_cvt_pk_f32_fp8((int)a.x, true), a2 = __builtin_amdgcn_cvt_pk_f32_fp8((int)a.y, false), a3 = __builtin_amdgcn_cvt_pk_f32_fp8((int)a.y, true);
                        const f32x4 v0 = acc[ai][bj][m][0] * 32.0f, v1 = acc[ai][bj][m][1] * 32.0f;
                        w[bj].x = pk4_fp8(v0[0] * a0.x, v0[1] * a0.y, v0[2] * a1.x, v0[3] * a1.y); w[bj].y = pk4_fp8(v1[0] * a2.x, v1[1] * a2.y, v1[2] * a3.x, v1[3] * a3.y);
                    }
                    const u32x4 q = swap16_pair(w[0], w[1]);
                    *(u32x4*)(O + (size_t)(u.pml * 256 + wr * 64 + fr + ai * 128 + m * 16) * DM + u.pn * 256 + (fq & 1) * 128 + wc * 32 + 16 * (fq >> 1)) = q;
                }
        }
    }
};

struct EpiResid {
    static constexpr bool PERM = true, HAS_PRE = false, HAS_ROWS = false;
    __device__ __forceinline__ static bool keeps(const pg8::Unit&) { return false; }
    const float* X; bf16_t* O;
    __device__ __forceinline__ void operator()(const AccT& acc, const pg8::Unit& u, int wr, int wc, int fr, int fq) const {
#pragma unroll
        for (int ai = 0; ai < 2; ++ai)
#pragma unroll
            for (int m = 0; m < 4; ++m) {
                const size_t row = (size_t)(u.pm * 256 + ai * 128 + wr * 64 + m * 16 + fr);
#pragma unroll
                for (int bj = 0; bj < 2; ++bj) {
                    const size_t off = row * DM + u.pn * 256 + bj * 128 + wc * 32 + 8 * fq;
                    const f32x4 v0 = __builtin_nontemporal_load((const f32x4*)(X + off)) + acc[ai][bj][m][0], v1 = __builtin_nontemporal_load((const f32x4*)(X + off + 4)) + acc[ai][bj][m][1];
                    u32x4 w; w.x = pk2(v0[0], v0[1]); w.y = pk2(v0[2], v0[3]); w.z = pk2(v1[0], v1[1]); w.w = pk2(v1[2], v1[3]);
                    *(u32x4*)(O + off) = w;
                }
            }
    }
};

struct EpiSwiglu {
    static constexpr bool PERM = true, HAS_PRE = true, HAS_ROWS = false;
    __device__ __forceinline__ static bool keeps(const pg8::Unit&) { return false; }
    const float* bgu; unsigned char* ACT;
    __device__ __forceinline__ void pre(const pg8::Unit& u, LAS unsigned char* dst, int lane) const {
        const float* src = bgu + (size_t)u.e * 2048 + (lane >> 5) * 1024 + u.pn * 128 + 4 * (lane & 31);
        __builtin_amdgcn_global_load_lds((const unsigned*)src, (LAS unsigned*)dst, 16, 0, 0);
    }
    __device__ __forceinline__ void init(AccT& acc, const LAS float* pb, int wc, int fq) const {
        const int cl = wc * 32 + 8 * fq;
#pragma unroll
        for (int n = 0; n < 2; ++n) { const f32x4 bg = *(const LAS f32x4*)(pb + cl + 4 * n) * SWI_C, bu = (*(const LAS f32x4*)(pb + 128 + cl + 4 * n) + 1.0f) * (1.0f / SWI_C);
#pragma unroll
            for (int ai = 0; ai < 2; ++ai)
#pragma unroll
                for (int m = 0; m < 4; ++m) { acc[ai][0][m][n] = bg; acc[ai][1][m][n] = bu; } }
    }
    __device__ __forceinline__ void operator()(const AccT& acc, const pg8::Unit& u, int wr, int wc, int fr, int fq) const {
#pragma unroll
        for (int ai = 0; ai < 2; ++ai)
#pragma unroll
            for (int mp = 0; mp < 2; ++mp) {
                u32x2 w[2];
#pragma unroll
                for (int mm = 0; mm < 2; ++mm) { const int m = 2 * mp + mm; float a[8];
#pragma unroll
                    for (int n = 0; n < 2; ++n)
#pragma unroll
                        for (int j = 0; j < 4; ++j) {
                            const float g = fmaxf(acc[ai][0][m][n][j], 7.0f * SWI_C), up1 = __builtin_amdgcn_fmed3f(acc[ai][1][m][n][j], 8.0f / SWI_C, -6.0f / SWI_C);
                            a[4 * n + j] = up1 * (g * __builtin_amdgcn_rcpf(1.0f + __builtin_amdgcn_exp2f(g)));
                        }
                    w[mm].x = pk4_fp8(a[0], a[1], a[2], a[3]); w[mm].y = pk4_fp8(a[4], a[5], a[6], a[7]); }
                const u32x4 q = swap16_pair(w[0], w[1]);
                const size_t row = (size_t)(u.pm * 256 + ai * 128 + wr * 64 + (2 * mp + (fq & 1)) * 16 + fr);
                *(u32x4*)(ACT + row * DFF + u.pn * 128 + wc * 32 + 16 * (fq >> 1)) = q;
            }
    }
};

struct EpiDown {
    static constexpr bool PERM = true, HAS_PRE = true, HAS_ROWS = true;
    __device__ __forceinline__ static bool keeps(const pg8::Unit&) { return false; }
    const float* bd; const u32x2* list2; const LAS int* cnt; unsigned char* Y;
    __device__ __forceinline__ void pre(const pg8::Unit& u, LAS unsigned char* dst, int lane) const {
        const float* src = bd + (size_t)u.e * DM + u.pn * 256 + 4 * lane;
        __builtin_amdgcn_global_load_lds((const unsigned*)src, (LAS unsigned*)dst, 16, 0, 0);
    }
    __device__ __forceinline__ void init(AccT& acc, const LAS float* pb, int wc, int fq) const {
        const int cl = wc * 32 + 8 * fq;
#pragma unroll
        for (int bj = 0; bj < 2; ++bj)
#pragma unroll
            for (int n = 0; n < 2; ++n) { const f32x4 bv = *(const LAS f32x4*)(pb + bj * 128 + cl + 4 * n);
#pragma unroll
                for (int ai = 0; ai < 2; ++ai)
#pragma unroll
                    for (int m = 0; m < 4; ++m) acc[ai][bj][m][n] = bv; }
    }
    __device__ __forceinline__ void rows(const pg8::Unit& u, LAS unsigned char* dst, int wid, int lane) const {
        if (wid < 2) __builtin_amdgcn_global_load_lds((const unsigned*)(list2 + (size_t)u.e * MTOK + u.pml * 256 + wid * 128 + lane * 2), (LAS unsigned*)(dst + wid * 1024), 16, 0, 0);
    }
    __device__ __forceinline__ void operator()(const AccT& acc, const pg8::Unit& u, int wr, int wc, int fr, int fq, const LAS unsigned char* rl) const {
        const int ne = cnt[u.e];
        u32x2 sg[2][4];
#pragma unroll
        for (int ai = 0; ai < 2; ++ai)
#pragma unroll
            for (int m = 0; m < 4; ++m) { const int rloc = ai * 128 + wr * 64 + m * 16 + fr;
                sg[ai][m] = *(const LAS u32x2*)(rl + rloc * 8); if (u.pml * 256 + rloc >= ne) sg[ai][m].x = 0xffffffffu; }
#pragma unroll
        for (int ai = 0; ai < 2; ++ai)
#pragma unroll
            for (int m = 0; m < 4; ++m) {
                const float gg = __uint_as_float(sg[ai][m].y) * 4.0f;
                u32x2 w[2];
#pragma unroll
                for (int bj = 0; bj < 2; ++bj) {
                    const f32x4 v0 = acc[ai][bj][m][0] * gg, v1 = acc[ai][bj][m][1] * gg;
                    w[bj].x = pk4_fp8(v0[0], v0[1], v0[2], v0[3]); w[bj].y = pk4_fp8(v1[0], v1[1], v1[2], v1[3]); }
                const u32x4 q = swap16_pair(w[0], w[1]);
                if (sg[ai][m].x != 0xffffffffu)
                    *(u32x4*)(Y + (size_t)sg[ai][m].x * DM + u.pn * 256 + (fq & 1) * 128 + wc * 32 + 16 * (fq >> 1)) = q;
            }
    }
};

namespace attn_body {
using bf16 = __hip_bfloat16;
using s16x4 = __attribute__((ext_vector_type(4))) short;
using f32x16 = __attribute__((ext_vector_type(16))) float;
constexpr int D = 64, QP = QW, KP = KVW;
constexpr int NW = 8, QBLK = 32, QB = QBLK * NW, KVBLK = 64;
__device__ __forceinline__ int crow(int r, int hi) { return (r & 3) + 8 * (r >> 2) + 4 * hi; }
#define SBAR() __builtin_amdgcn_sched_barrier(0)
constexpr int NSLOT = 3, SLOTB = 8192;
constexpr int LDS_K = 0, LDS_V = NSLOT * SLOTB, LDS_WS = 2 * NSLOT * SLOTB, LDS_OST = LDS_WS + NW * 64 * 4, LDS_BYTES = LDS_OST + NW * 4096;
__device__ __forceinline__ void glds16(const void* gsrc, unsigned lds_dst) { unsigned keep;
    asm volatile("s_mov_b32 %0, m0\n\ts_mov_b32 m0, %2\n\ts_nop 0\n\tglobal_load_lds_dwordx4 %1, off\n\ts_mov_b32 m0, %0" : "=&s"(keep) : "v"(gsrc), "s"(lds_dst) : "memory"); }
__device__ __forceinline__ float max3f(float a, float b, float c) { float r; asm("v_max3_f32 %0, %1, %2, %3" : "=v"(r) : "v"(a), "v"(b), "v"(c)); return r; }
__device__ __forceinline__ float max2f(float a, float b) { float r; asm("v_max_f32_e32 %0, %1, %2" : "=v"(r) : "v"(a), "v"(b)); return r; }
__device__ __forceinline__ float fadd_s(float a, float b) { float r; asm("v_add_f32_e32 %0, %1, %2" : "=v"(r) : "v"(a), "v"(b)); return r; }
__device__ __forceinline__ float fsub_s(float a, float b) { float r; asm("v_sub_f32_e32 %0, %1, %2" : "=v"(r) : "v"(a), "v"(b)); return r; }
typedef float f32x2_t __attribute__((ext_vector_type(2))); typedef __bf16 bf16x2_t __attribute__((ext_vector_type(2)));
__device__ __forceinline__ unsigned cvtpk_s(float lo, float hi) { f32x2_t v = {lo, hi}; bf16x2_t b = __builtin_convertvector(v, bf16x2_t); return __builtin_bit_cast(unsigned, b); }
#define WAIT_BAR(N) asm volatile("s_waitcnt vmcnt(" #N ") lgkmcnt(0)\n\ts_barrier" ::: "memory")

__device__ __forceinline__ void qkt(f32x16& p0, f32x16& p1, const char* Kslot, const bf16x8* qr, const f32x16& negm, int r32, int hi) {
    const char* kb = Kslot + hi * 1024 + r32 * 16;
#pragma unroll
    for (int d0 = 0; d0 < 4; ++d0) {
        const bf16x8 b0 = *reinterpret_cast<const bf16x8*>(kb + d0 * 2048);
        const bf16x8 b1 = *reinterpret_cast<const bf16x8*>(kb + d0 * 2048 + 512);
        if (d0 == 0) { p0 = __builtin_amdgcn_mfma_f32_32x32x16_bf16(b0, qr[0], negm, 0, 0, 0); p1 = __builtin_amdgcn_mfma_f32_32x32x16_bf16(b1, qr[0], negm, 0, 0, 0); }
        else { p0 = __builtin_amdgcn_mfma_f32_32x32x16_bf16(b0, qr[d0], p0, 0, 0, 0); p1 = __builtin_amdgcn_mfma_f32_32x32x16_bf16(b1, qr[d0], p1, 0, 0, 0); } }
}
typedef __attribute__((address_space(3))) const char* lds_cptr;
typedef short v4i16_t __attribute__((ext_vector_type(4)));
__device__ __forceinline__ void kload8(bf16x8* kf, lds_cptr kp) {
    kf[0] = *(const LAS bf16x8*)(kp);        kf[1] = *(const LAS bf16x8*)(kp + 512);
    kf[2] = *(const LAS bf16x8*)(kp + 2048); kf[3] = *(const LAS bf16x8*)(kp + 2560);
    kf[4] = *(const LAS bf16x8*)(kp + 4096); kf[5] = *(const LAS bf16x8*)(kp + 4608);
    kf[6] = *(const LAS bf16x8*)(kp + 6144); kf[7] = *(const LAS bf16x8*)(kp + 6656);
}
__device__ __forceinline__ void kload2(bf16x8* kf, lds_cptr kp, int j) { kf[2 * j] = *(const LAS bf16x8*)(kp + j * 2048); kf[2 * j + 1] = *(const LAS bf16x8*)(kp + j * 2048 + 512); }
__device__ __forceinline__ s16x4 vtr(lds_cptr p) { return __builtin_bit_cast(s16x4, __builtin_amdgcn_ds_read_tr16_b64_v4i16((LAS v4i16_t*)p)); }
__device__ __forceinline__ float rowmax(const f32x16& p0, const f32x16& p1) {
    float a = max3f(p0[0], p0[1], p1[0]), b = max3f(p0[2], p0[3], p1[1]); a = max3f(a, p1[2], p1[3]);
#pragma unroll
    for (int r = 4; r < 16; r += 4) { a = max3f(a, p0[r], p0[r + 1]); b = max3f(b, p0[r + 2], p0[r + 3]); a = max3f(a, p1[r], p1[r + 1]); b = max3f(b, p1[r + 2], p1[r + 3]); }
    const float m = max2f(a, b);
    auto rr = __builtin_amdgcn_permlane32_swap(__float_as_uint(m), __float_as_uint(m), false, false);
    return max2f(__uint_as_float(rr[0]), __uint_as_float(rr[1]));
}
__device__ __forceinline__ void pv(f32x16* o, int vb, bf16x8 pa0, bf16x8 pa1, bf16x8 pa2, bf16x8 pa3) {
#pragma unroll
    for (int d0 = 0; d0 < 2; ++d0) { s16x4 lo[4], hi[4];
#pragma unroll
        for (int ks = 0; ks < 4; ++ks) {
            asm volatile("ds_read_b64_tr_b16 %0,%1 offset:%c2" : "=&v"(lo[ks]) : "v"(vb), "i"(d0 * 4096 + ks * 1024) : "memory");
            asm volatile("ds_read_b64_tr_b16 %0,%1 offset:%c2" : "=&v"(hi[ks]) : "v"(vb), "i"(d0 * 4096 + ks * 1024 + 512) : "memory"); }
        asm volatile("s_waitcnt lgkmcnt(0)" ::: "memory"); SBAR();
#define PK(k) (bf16x8){lo[k][0], lo[k][1], lo[k][2], lo[k][3], hi[k][0], hi[k][1], hi[k][2], hi[k][3]}
        o[d0] = __builtin_amdgcn_mfma_f32_32x32x16_bf16(pa0, PK(0), o[d0], 0, 0, 0);
        o[d0] = __builtin_amdgcn_mfma_f32_32x32x16_bf16(pa1, PK(1), o[d0], 0, 0, 0);
        o[d0] = __builtin_amdgcn_mfma_f32_32x32x16_bf16(pa2, PK(2), o[d0], 0, 0, 0);
        o[d0] = __builtin_amdgcn_mfma_f32_32x32x16_bf16(pa3, PK(3), o[d0], 0, 0, 0);
#undef PK
    }
}
__device__ __forceinline__ void wmask(f32x16& p0, f32x16& p1, int base) {
    const float NEG = -INFINITY;
#pragma unroll
    for (int r = 0; r < 16; ++r) { const int d0 = base + (r & 3) + 8 * (r >> 2), d1 = d0 + 32;
        if (d0 > 128 || d0 < -128) p0[r] = NEG; if (d1 > 128 || d1 < -128) p1[r] = NEG; }
}

template <int MODE, int THRL, bool NOMAX = false> __device__ __forceinline__ void attn_unit(int b, int h, int qb, const unsigned char* Q, const bf16* __restrict__ K, const bf16* __restrict__ V, unsigned char* O, char* shm, int wave_, float sink2, float mref = 0.f) {
    const int wid = wave_, lane = lane_fresh(), tid = wid * 64 + lane, r32 = lane & 31, hi = lane >> 5;
    const long rowbase = (long)b * SEQ; const int q0 = qb * QB; const int kvh = h >> 2;
    int kt0 = 0, NT = SEQ / KVBLK;
    if (MODE == 1) { kt0 = 4 * qb - 2; int kt1 = 4 * qb + 6; if (kt0 < 0) kt0 = 0; if (kt1 > SEQ / KVBLK) kt1 = SEQ / KVBLK; NT = kt1 - kt0; }
    const unsigned char* Qw = Q + (rowbase + q0 + wid * QBLK) * QP + h * D;
    const unsigned lds0 = (unsigned)(uintptr_t)shm;
    float* wsf = (float*)(shm + LDS_WS) + wid * 64;
    const char* ksrc = (const char*)K + ((size_t)((b * NKVH + kvh) * (SEQ / KVBLK) + kt0)) * 8192 + wid * 1024 + lane * 16;
    const char* vsrc = (const char*)V + ((size_t)((b * NKVH + kvh) * (SEQ / KVBLK) + kt0)) * 8192 + wid * 1024 + lane * 16;
    const unsigned kdst = lds0 + LDS_K + wid * 1024, vdst = lds0 + LDS_V + wid * 1024;
#define DMA_K(t, slot) glds16(ksrc + (size_t)(t) * 8192, (unsigned)__builtin_amdgcn_readfirstlane(kdst + (slot)))
#define DMA_V(t, slot) glds16(vsrc + (size_t)(t) * 8192, (unsigned)__builtin_amdgcn_readfirstlane(vdst + (slot)))
    const int vb0 = (int)(lds0 + LDS_V) + ((lane >> 4) & 1) * 32 + (lane & 3) * 8 + (4 * hi + ((lane & 15) >> 2)) * 64;
    const char* Kbase = shm + LDS_K; bf16x8 kf[8];
    const lds_cptr shm3 = (lds_cptr)shm; const lds_cptr kp0 = shm3 + LDS_K + hi * 1024 + r32 * 16; const lds_cptr vp0 = shm3 + LDS_V + ((lane >> 4) & 1) * 32 + (lane & 3) * 8 + (4 * hi + ((lane & 15) >> 2)) * 64;
    DMA_K(0, 0); DMA_V(0, 0); DMA_K(1, SLOTB);
    bf16x8 qr[4];
#pragma unroll
    for (int d0 = 0; d0 < 4; ++d0) { const u32x2 w8 = *reinterpret_cast<const u32x2*>(&Qw[(long)r32 * QP + d0 * 16 + hi * 8]);
        const f32x2_t a0 = __builtin_amdgcn_cvt_pk_f32_fp8((int)w8.x, false), a1 = __builtin_amdgcn_cvt_pk_f32_fp8((int)w8.x, true), a2 = __builtin_amdgcn_cvt_pk_f32_fp8((int)w8.y, false), a3 = __builtin_amdgcn_cvt_pk_f32_fp8((int)w8.y, true);
        const u32x4 qw = {cvtpk_s(a0.x * 0.125f, a0.y * 0.125f), cvtpk_s(a1.x * 0.125f, a1.y * 0.125f), cvtpk_s(a2.x * 0.125f, a2.y * 0.125f), cvtpk_s(a3.x * 0.125f, a3.y * 0.125f)};
        qr[d0] = __builtin_bit_cast(bf16x8, qw); }
    float mhat = 0.f, l_reg = 0.f; f32x16 o[2]; o[0] = f32x16{}; o[1] = f32x16{}; f32x16 negm = f32x16{}; asm volatile("" : "+v"(negm));
    const int mbase = kt0 * KVBLK + 4 * hi - (q0 + wid * QBLK + r32);
#define CMASK(P0, P1, t) do { if (MODE == 1) wmask(P0, P1, mbase + (t) * KVBLK); } while (0)
    bool resc = false;
#define START(P0, P1) do { const float rm = NOMAX ? mref : rowmax(P0, P1); resc = false; \
    { const float dl = (MODE == 1) ? __builtin_fmaxf(rm, -500.f) : rm; mhat = fadd_s(mhat, dl); \
      _Pragma("unroll") for (int r = 0; r < 16; ++r) { P0[r] = fsub_s(P0[r], dl); P1[r] = fsub_s(P1[r], dl); } \
      _Pragma("unroll") for (int r = 0; r < 16; ++r) negm[r] = -mhat; asm volatile("" : "+v"(negm)); } \
    _Pragma("unroll") for (int r = 0; r < 16; ++r) P0[r] = __builtin_amdgcn_exp2f(P0[r]); } while (0)
#define RESC() do { if (resc) { asm volatile("s_waitcnt lgkmcnt(0)" ::: "memory"); \
      _Pragma("unroll") for (int d_ = 0; d_ < 2; ++d_) _Pragma("unroll") for (int r = 0; r < 16; ++r) o[d_][r] *= wsf[crow(r, hi)]; } } while (0)
    f32x16 pA0, pA1, pB0, pB1;
    int sl_prev = 0, sl_cur = 0, sl_next = SLOTB;
#define ROT() do { sl_prev = sl_cur; sl_cur = sl_next; sl_next = (sl_next == (NSLOT - 1) * SLOTB) ? 0 : sl_next + SLOTB; } while (0)
    DMA_K(2, 2 * SLOTB);
    WAIT_BAR(3);
    qkt(pA0, pA1, Kbase, qr, negm, r32, hi); asm volatile("s_nop 15\n\ts_nop 7" : "+v"(pA0), "+v"(pA1)); CMASK(pA0, pA1, 0);
    START(pA0, pA1);
    _Pragma("unroll") for (int r = 0; r < 16; ++r) pA1[r] = __builtin_amdgcn_exp2f(pA1[r]);
    WAIT_BAR(0);
    DMA_K(3, 0); DMA_V(1, SLOTB);
    ROT();
    kload8(kf, kp0 + sl_cur);
    WAIT_BAR(2);
    s16x4 vlo[8], vhi[8]; u32x4 pw0, pw1, pw2, pw3;
#define PKW(P, B) cvtpk_s(P[B], P[B + 1])
#define PAF(k) __builtin_bit_cast(bf16x8, pw##k)
#define VFR(i) (bf16x8){vlo[i][0], vlo[i][1], vlo[i][2], vlo[i][3], vhi[i][0], vhi[i][1], vhi[i][2], vhi[i][3]}
#define PIN(x) asm volatile("" : "+v"(x))
#define MX3(a, b, c) __builtin_fmaxf(__builtin_fmaxf((a), (b)), (c))
#define GAPA(MF, A0, A1, A2, A3, W0, W1, PW) do { MF; sacc += A0; sacc += A1; sacc += A2; sacc += A3; PIN(sacc); W0; W1; PIN(PW); SBAR(); } while (0)
#define EX(v) __builtin_amdgcn_exp2f(v)
#define GAPB(MF, X, B) do { MF; X[B] = EX(X[B]); X[B + 1] = EX(X[B + 1]); X[B + 2] = EX(X[B + 2]); X[B + 3] = EX(X[B + 3]); PIN(X); SBAR(); } while (0)
#define VRD(i) do { vlo[i] = vtr(vp_ + (((i) >> 2) * 4096 + ((i) & 3) * 1024)); vhi[i] = vtr(vp_ + (((i) >> 2) * 4096 + ((i) & 3) * 1024 + 512)); } while (0)
#define KRD(G, j) do { if (G) { kload2(kf, kp0 + sl_next, j); SBAR(); } } while (0)
#define STEP(C0, C1, P0, P1, t, GK, GV, GL) do { SBAR(); \
    const lds_cptr vp_ = vp0 + sl_prev; \
    VRD(0); SBAR(); float sacc = (P0[0] + P0[1]); \
    GAPA(C0 = __builtin_amdgcn_mfma_f32_32x32x16_bf16(kf[0], qr[0], negm, 0, 0, 0), P0[2], P0[3], P0[4], P0[5],     pw0[0] = PKW(P0, 0), pw0[1] = PKW(P0, 2), pw0); \
    VRD(4); SBAR(); GAPA(C1 = __builtin_amdgcn_mfma_f32_32x32x16_bf16(kf[1], qr[0], negm, 0, 0, 0), P0[6], P0[7], P0[8], P0[9],     pw0[2] = PKW(P0, 4), pw0[3] = PKW(P0, 6), pw0); \
    VRD(1); SBAR(); GAPA(C0 = __builtin_amdgcn_mfma_f32_32x32x16_bf16(kf[2], qr[1], C0, 0, 0, 0),   P0[10], P0[11], P0[12], P0[13], pw1[0] = PKW(P0, 8), pw1[1] = PKW(P0, 10), pw1); \
    VRD(5); SBAR(); GAPA(C1 = __builtin_amdgcn_mfma_f32_32x32x16_bf16(kf[3], qr[1], C1, 0, 0, 0),   P0[14], P0[15], P1[0], P1[1],   pw1[2] = PKW(P0, 12), pw1[3] = PKW(P0, 14), pw1); \
    VRD(2); SBAR(); GAPA(C0 = __builtin_amdgcn_mfma_f32_32x32x16_bf16(kf[4], qr[2], C0, 0, 0, 0),   P1[2], P1[3], P1[4], P1[5],     pw2[0] = PKW(P1, 0), pw2[1] = PKW(P1, 2), pw2); \
    VRD(6); SBAR(); GAPA(C1 = __builtin_amdgcn_mfma_f32_32x32x16_bf16(kf[5], qr[2], C1, 0, 0, 0),   P1[6], P1[7], P1[8], P1[9],     pw2[2] = PKW(P1, 4), pw2[3] = PKW(P1, 6), pw2); \
    VRD(3); SBAR(); GAPA(C0 = __builtin_amdgcn_mfma_f32_32x32x16_bf16(kf[6], qr[3], C0, 0, 0, 0),   P1[10], P1[11], P1[12], P1[13], pw3[0] = PKW(P1, 8), pw3[1] = PKW(P1, 10), pw3); \
    VRD(7); SBAR(); GAPA(C1 = __builtin_amdgcn_mfma_f32_32x32x16_bf16(kf[7], qr[3], C1, 0, 0, 0),   P1[14], P1[15], 0.f, 0.f,       pw3[2] = PKW(P1, 12), pw3[3] = PKW(P1, 14), pw3); \
    l_reg += sacc; \
    if (GK) { DMA_K((t) + 3, sl_cur); } if (GV) { DMA_V((t) + 1, sl_next); } \
    CMASK(C0, C1, t); \
    if (!NOMAX) { float a = MX3(C0[0], C0[1], C1[0]), b = MX3(C0[2], C0[3], C1[1]); a = MX3(a, C1[2], C1[3]); \
      _Pragma("unroll") for (int r = 4; r < 16; r += 4) { a = MX3(a, C0[r], C0[r + 1]); b = MX3(b, C0[r + 2], C0[r + 3]); a = MX3(a, C1[r], C1[r + 1]); b = MX3(b, C1[r + 2], C1[r + 3]); } \
      float rm = __builtin_fmaxf(a, b); { auto rr = __builtin_amdgcn_permlane32_swap(__float_as_uint(rm), __float_as_uint(rm), false, false); rm = __builtin_fmaxf(__uint_as_float(rr[0]), __uint_as_float(rr[1])); } \
      resc = false; \
      if (__builtin_expect(__any(rm > (float)THRL), 0)) { const float dl = __builtin_fmaxf(rm, 0.f); mhat += dl; \
        _Pragma("unroll") for (int r = 0; r < 16; ++r) { C0[r] -= dl; C1[r] -= dl; } \
        _Pragma("unroll") for (int r = 0; r < 16; ++r) negm[r] = -mhat; asm volatile("" : "+v"(negm)); \
        const float f = __builtin_amdgcn_exp2f(-dl); l_reg *= f; if (hi == 0) wsf[r32] = f; resc = true; } } \
    SBAR(); \
    GAPB(o[0] = __builtin_amdgcn_mfma_f32_32x32x16_bf16(PAF(0), VFR(0), o[0], 0, 0, 0), C0, 0); \
    GAPB(o[1] = __builtin_amdgcn_mfma_f32_32x32x16_bf16(PAF(0), VFR(4), o[1], 0, 0, 0), C0, 4); \
    KRD(GL, 0); GAPB(o[0] = __builtin_amdgcn_mfma_f32_32x32x16_bf16(PAF(1), VFR(1), o[0], 0, 0, 0), C0, 8); \
    KRD(GL, 1); GAPB(o[1] = __builtin_amdgcn_mfma_f32_32x32x16_bf16(PAF(1), VFR(5), o[1], 0, 0, 0), C0, 12); \
    KRD(GL, 2); GAPB(o[0] = __builtin_amdgcn_mfma_f32_32x32x16_bf16(PAF(2), VFR(2), o[0], 0, 0, 0), C1, 0); \
    KRD(GL, 3); GAPB(o[1] = __builtin_amdgcn_mfma_f32_32x32x16_bf16(PAF(2), VFR(6), o[1], 0, 0, 0), C1, 4); \
    GAPB(o[0] = __builtin_amdgcn_mfma_f32_32x32x16_bf16(PAF(3), VFR(3), o[0], 0, 0, 0), C1, 8); \
    GAPB(o[1] = __builtin_amdgcn_mfma_f32_32x32x16_bf16(PAF(3), VFR(7), o[1], 0, 0, 0), C1, 12); \
    } while (0)
    int t = 1;
    for (; t + 5 < NT; t += 2) {
        STEP(pB0, pB1, pA0, pA1, t, true, true, true);     WAIT_BAR(2); RESC(); ROT();
        STEP(pA0, pA1, pB0, pB1, t + 1, true, true, true); WAIT_BAR(2); RESC(); ROT();
    }
#define ENDW(tt) do { if ((tt) + 3 < NT) { WAIT_BAR(2); } else if ((tt) + 2 < NT) { WAIT_BAR(1); } else { WAIT_BAR(0); } } while (0)
    for (; t + 1 < NT; t += 2) {
        STEP(pB0, pB1, pA0, pA1, t, (t + 3 < NT), (t + 1 < NT), (t + 1 < NT));         ENDW(t);     RESC(); ROT();
        STEP(pA0, pA1, pB0, pB1, t + 1, (t + 4 < NT), (t + 2 < NT), (t + 2 < NT));     ENDW(t + 1); RESC(); ROT();
    }
    STEP(pB0, pB1, pA0, pA1, NT - 1, false, false, false); RESC();
    { float sacc = pB0[0] + pB0[1]; _Pragma("unroll") for (int r = 2; r < 16; ++r) sacc += pB0[r]; _Pragma("unroll") for (int r = 0; r < 16; ++r) sacc += pB1[r]; l_reg += sacc;
      pw0 = (u32x4){PKW(pB0, 0), PKW(pB0, 2), PKW(pB0, 4), PKW(pB0, 6)}; pw1 = (u32x4){PKW(pB0, 8), PKW(pB0, 10), PKW(pB0, 12), PKW(pB0, 14)}; pw2 = (u32x4){PKW(pB1, 0), PKW(pB1, 2), PKW(pB1, 4), PKW(pB1, 6)}; pw3 = (u32x4){PKW(pB1, 8), PKW(pB1, 10), PKW(pB1, 12), PKW(pB1, 14)};
      SBAR(); pv(o, vb0 + sl_cur, PAF(0), PAF(1), PAF(2), PAF(3)); }
#undef PKW
#undef PAF
#undef VFR
#undef PIN
#undef MX3
#undef GAPA
#undef GAPB
#undef EX
#undef VRD
#undef KRD
#undef STEP
#undef ENDW
    { auto rr = __builtin_amdgcn_permlane32_swap(__float_as_uint(l_reg), __float_as_uint(l_reg), false, false); l_reg = __uint_as_float(rr[0]) + __uint_as_float(rr[1]); }
    if (MODE == 1) l_reg += __builtin_amdgcn_exp2f(sink2 - mhat);
    if (hi == 0) wsf[32 + r32] = l_reg; asm volatile("s_waitcnt lgkmcnt(0)" ::: "memory");
    float rli[16];
#pragma unroll
    for (int r = 0; r < 16; ++r) rli[r] = __builtin_amdgcn_rcpf(wsf[32 + crow(r, hi)]);
    unsigned char* Ow = O + (rowbase + q0 + wid * QBLK) * QP + h * D;
    { unsigned char* stg = (unsigned char*)(shm + LDS_OST) + wid * 2048;
#pragma unroll
      for (int r = 0; r < 16; ++r) { const int orow = crow(r, hi); const float sc = rli[r] * 32.0f;
        const unsigned pk = (unsigned)__builtin_amdgcn_cvt_pk_fp8_f32(o[0][r] * sc, o[1][r] * sc, 0, false);
        stg[orow * 64 + r32] = (unsigned char)(pk & 0xffu); stg[orow * 64 + 32 + r32] = (unsigned char)((pk >> 8) & 0xffu); }
      asm volatile("s_waitcnt lgkmcnt(0)" ::: "memory");
#pragma unroll
      for (int i = 0; i < 2; ++i) { const int row = i * 16 + (lane >> 2), ch = lane & 3; const u32x4 v = *(const u32x4*)(stg + row * 64 + ch * 16); *(u32x4*)(Ow + (long)row * QP + ch * 16) = v; } }
    asm volatile("s_waitcnt lgkmcnt(0)\n\ts_barrier" ::: "memory");
#undef DMA_K
#undef DMA_V
#undef CMASK
#undef START
#undef RESC
#undef ROT
}
#undef SBAR
#undef WAIT_BAR
}

constexpr size_t MiB = 1u << 20;
constexpr size_t WS_CTL = 0, CTL_ZERO_BYTES = 1 * MiB;
constexpr size_t WS_RSTD = 1 * MiB;
constexpr size_t WS_ROPE = 2 * MiB;
constexpr size_t WS_GATEW = 6 * MiB;
constexpr size_t WS_LIST = 7 * MiB;
constexpr size_t WS_WIN = 10 * MiB;
constexpr size_t WS_WA = 18 * MiB, WS_WB = WS_WA + MiB / 2, WS_WOUT = 20 * MiB;
constexpr size_t WS_XB = 24 * MiB;
constexpr size_t WS_QA = 56 * MiB, WS_QB = 72 * MiB;
constexpr size_t WS_KA = 88 * MiB, WS_VA = 92 * MiB, WS_KB = 96 * MiB, WS_VB = 100 * MiB;
constexpr size_t WS_GA = 104 * MiB, WS_GB = 136 * MiB;
constexpr size_t WS_MERGED = 168 * MiB;
constexpr size_t WS_H2 = 200 * MiB;
constexpr size_t WS_WGU = 232 * MiB;
constexpr size_t WS_WD = 360 * MiB;
constexpr size_t WS_ACT = 424 * MiB;
constexpr size_t WS_Y = 568 * MiB;
constexpr size_t WS_OA = 696 * MiB, WS_OB = 704 * MiB;
constexpr size_t WS_X1 = 728 * MiB;
constexpr size_t WS_LIST2 = 792 * MiB;
constexpr size_t WS_END = 796 * MiB;
static_assert((size_t)ACT_ROWS * DFF * 2 <= WS_Y - WS_ACT, "ACT fits");
constexpr int CW_ECNT = 64;
constexpr int CW_TKT = 512;
constexpr int CW_BAR = 4096;

constexpr int RING_OFF = 0, RING_BYTES = 131072;
constexpr int LDSCTL_OFF = RING_BYTES;
constexpr int L_BARST = 0;
constexpr int L_TKT = 8;
constexpr int L_PRE = 16;
constexpr int L_CNT = 64;
constexpr int L_LCNT = 96;
constexpr int L_LBASE = 128;
constexpr int L_SELE = 256, L_SELR = 512, L_SELG = 768;
constexpr int LDS_BYTES = 147456;
static_assert(LDSCTL_OFF + 1024 * 4 <= LDS_BYTES, "LDS map");

#define XB_TMO      128
#define XB_XCNT(j)  (256  + 64 * (j))
#define XB_XSUB(j)  (1280 + 64 * (j))
#define XB_XGEN(j)  (2304 + 64 * (j))
#define XB_TOP      3328
#define XB_TOPGEN   3392
#define XCD_BAR_WORDS 3456
#define XB_SPIN_CAP (1u << 22)
__device__ __forceinline__ unsigned xb_ld(unsigned* p)              { return __hip_atomic_load(p, __ATOMIC_RELAXED, __HIP_MEMORY_SCOPE_AGENT); }
__device__ __forceinline__ unsigned xb_add(unsigned* p, unsigned v) { return __hip_atomic_fetch_add(p, v, __ATOMIC_RELAXED, __HIP_MEMORY_SCOPE_AGENT); }
__device__ __forceinline__ unsigned xb_xcc_id() { return (unsigned)__builtin_amdgcn_s_getreg((3 << 11) | 20) & 0xFu; }
#define XB_SPIN(cond, bar) do { unsigned _sp = 0; while (cond) { __builtin_amdgcn_s_sleep(1); \
    if ((++_sp & 255u) == 0u) { if (xb_ld(&(bar)[XB_TMO])) break; if (_sp > XB_SPIN_CAP) { atomicAdd(&(bar)[XB_TMO], 1u); break; } } } } while (0)
struct XcdBarrier { unsigned* bar; unsigned x; volatile LAS unsigned* st; };
__device__ __forceinline__ XcdBarrier xcd_barrier_post(unsigned* bar, volatile LAS unsigned* st, int wave) {
    XcdBarrier b; b.bar = bar; b.x = xb_xcc_id(); b.st = st;
    if (wave == 0 && lane_fresh() == 0) st[2] = xb_add(&bar[XB_XCNT(b.x)], 1u);
    return b;
}
__device__ __forceinline__ void xcd_barrier_complete(unsigned* bar, unsigned x, unsigned& nloc, unsigned& nx) {
    const unsigned G = gridDim.x * gridDim.y * gridDim.z;
    unsigned sum, cnt, mine, sp = 0u;
    for (;;) {
        sum = 0u; cnt = 0u; mine = 0u;
#pragma unroll
        for (unsigned j = 0; j < 16; ++j) { const unsigned c = xb_ld(&bar[XB_XCNT(j)]); sum += c; cnt += (c > 0u) ? 1u : 0u; mine = (j == x) ? c : mine; }
        if (sum == G) break;
        __builtin_amdgcn_s_sleep(1);
        if ((++sp & 255u) == 0u) { if (xb_ld(&bar[XB_TMO])) break; if (sp > XB_SPIN_CAP) { atomicAdd(&bar[XB_TMO], 1u); break; } }
    }
    nloc = mine > 0u ? mine : 1u; nx = cnt > 0u ? cnt : 1u;
}
__device__ __forceinline__ void xcd_barrier(const XcdBarrier& b, int wave) {
    asm volatile("s_waitcnt vmcnt(0)" ::: "memory");
    __syncthreads();
    if (wave == 0 && lane_fresh() == 0) {
        unsigned* bar = b.bar;
        __builtin_amdgcn_s_waitcnt(0);
        unsigned nloc = b.st[0], nx = b.st[1];
        if (nloc == 0u) { xcd_barrier_complete(bar, b.x, nloc, nx); b.st[0] = nloc; b.st[1] = nx; }
        const unsigned old = xb_add(&bar[XB_XSUB(b.x)], 1u);
        const unsigned gen = old / nloc;
        if (old + 1u == (gen + 1u) * nloc) {
            __builtin_amdgcn_fence(__ATOMIC_RELEASE, "agent");
            asm volatile("s_waitcnt vmcnt(0)" ::: "memory");
            const unsigned og = xb_add(&bar[XB_TOP], 1u);
            const unsigned tg = og / nx;
            if (og + 1u == (tg + 1u) * nx) xb_add(&bar[XB_TOPGEN], 1u);
            else XB_SPIN(xb_ld(&bar[XB_TOPGEN]) == tg, bar);
            __builtin_amdgcn_fence(__ATOMIC_ACQUIRE, "agent");
            xb_add(&bar[XB_XGEN(b.x)], 1u);
            asm volatile("s_waitcnt vmcnt(0)" ::: "memory");
        } else {
            XB_SPIN(xb_ld(&bar[XB_XGEN(b.x)]) == gen, bar);
            __builtin_amdgcn_fence(__ATOMIC_ACQUIRE, "agent");
            asm volatile("s_waitcnt vmcnt(0)" ::: "memory");
        }
    }
    __syncthreads();
}

struct Args { const float* in[17]; float* out; unsigned char* ws; int ph_lo, ph_hi, li, pad; };
struct Frame {
    LAS unsigned char* lds; int tid, lane, wave, vcu, G;
};

__device__ __forceinline__ void p0_item(const float* W, int ldw, int k0, int nsrc0, bf16_t* WT, int K, int ndst0, const float* gk, LAS float* scr, int lane) {
    f32x4 v[8];
#pragma unroll
    for (int i = 0; i < 8; ++i) v[i] = *(const f32x4*)(W + (size_t)(k0 + 8 * i + (lane >> 3)) * ldw + nsrc0 + 4 * (lane & 7));
    if (gk) {
#pragma unroll
        for (int i = 0; i < 8; ++i) v[i] = v[i] * gk[k0 + 8 * i + (lane >> 3)];
    }
#pragma unroll
    for (int i = 0; i < 8; ++i) { LAS float* s = scr + (8 * i + (lane >> 3)) * 33 + 4 * (lane & 7); s[0] = v[i][0]; s[1] = v[i][1]; s[2] = v[i][2]; s[3] = v[i][3]; }
    asm volatile("s_waitcnt lgkmcnt(0)" ::: "memory");
    const int c = lane & 7;
#pragma unroll
    for (int j = 0; j < 4; ++j) { const int n = (lane >> 3) + 8 * j; const LAS float* s = scr + (8 * c) * 33 + n;
        u32x4 o; o.x = pk2(s[0 * 33], s[1 * 33]); o.y = pk2(s[2 * 33], s[3 * 33]); o.z = pk2(s[4 * 33], s[5 * 33]); o.w = pk2(s[6 * 33], s[7 * 33]);
        *(u32x4*)(WT + (size_t)(ndst0 + n) * K + k0 + 8 * c) = o; }
    asm volatile("s_waitcnt lgkmcnt(0)" ::: "memory");
}
__device__ __forceinline__ void p0_item8(const float* W, int ldw, int k0, int nsrc0, unsigned char* WT, int K, int ndst0, float scale, const float* gk, LAS float* scr, int lane) {
    f32x4 v[8];
#pragma unroll
    for (int i = 0; i < 8; ++i) v[i] = *(const f32x4*)(W + (size_t)(k0 + 8 * i + (lane >> 3)) * ldw + nsrc0 + 4 * (lane & 7));
    if (gk) {
#pragma unroll
        for (int i = 0; i < 8; ++i) v[i] = v[i] * gk[k0 + 8 * i + (lane >> 3)];
    }
#pragma unroll
    for (int i = 0; i < 8; ++i) { LAS float* s = scr + (8 * i + (lane >> 3)) * 33 + 4 * (lane & 7); s[0] = v[i][0] * scale; s[1] = v[i][1] * scale; s[2] = v[i][2] * scale; s[3] = v[i][3] * scale; }
    asm volatile("s_waitcnt lgkmcnt(0)" ::: "memory");
    const int c = lane & 7;
#pragma unroll
    for (int j = 0; j < 4; ++j) { const int n = (lane >> 3) + 8 * j; const LAS float* s = scr + (8 * c) * 33 + n;
        u32x2 o; o.x = pk4_fp8(s[0 * 33], s[1 * 33], s[2 * 33], s[3 * 33]); o.y = pk4_fp8(s[4 * 33], s[5 * 33], s[6 * 33], s[7 * 33]);
        *(u32x2*)(WT + (size_t)(ndst0 + n) * K + k0 + 8 * c) = o; }
    asm volatile("s_waitcnt lgkmcnt(0)" ::: "memory");
}
template <class SrcMap> __device__ __forceinline__ void p0_weight8(const Frame& F, const float* W, int K, int N, unsigned char* WT, float scale, const float* gk, LAS float* scr, SrcMap srcmap) {
    const int gw = F.vcu * 8 + F.wave, NGW = F.G * 8; const int nkb = K / 64, nnb = N / 32, nitems = nkb * nnb;
    for (int it = gw; it < nitems; it += NGW) { const int kb = it / nnb, nb = it % nnb; p0_item8(W, N, kb * 64, srcmap(nb * 32), WT, K, nb * 32, scale, gk, scr, F.lane); }
}
struct W8Task { const float* W; unsigned char* WT; int K, N, ngroups; float scale; const float* gk; int gu, nt; };
template <bool HAS_GK, class SrcMap> __device__ __forceinline__ void p0_w8_load(const W8Task& T, int it, f32x4 (&v)[8], float (&gv)[8], int lane, SrcMap srcmap) {
    const int nnb = T.N / 32, per = (T.K / 64) * nnb; const int g = it / per, r = it - g * per, kb = r / nnb, nb = r - kb * nnb;
    const float* W = T.W + (size_t)g * T.K * T.N; const int nsrc0 = srcmap(nb * 32), k0 = kb * 64;
#pragma unroll
    for (int i = 0; i < 8; ++i) { v[i] = __builtin_nontemporal_load((const f32x4*)(W + (size_t)(k0 + 8 * i + (lane >> 3)) * T.N + nsrc0 + 4 * (lane & 7))); if (HAS_GK) gv[i] = T.gk[k0 + 8 * i + (lane >> 3)]; }
}
template <bool HAS_GK> __device__ __forceinline__ void p0_w8_store(const W8Task& T, int it, const f32x4 (&v)[8], const float (&gv)[8], LAS float* scr, int lane) {
    const int nnb = T.N / 32, per = (T.K / 64) * nnb; const int g = it / per, r = it - g * per, kb = r / nnb, nb = r - kb * nnb;
    unsigned char* WT = T.WT + (size_t)g * T.K * T.N; const int k0 = kb * 64, ndst0 = nb * 32;
    const float gus = T.gu ? (((ndst0 >> 7) & 1) ? 1.0f / SWI_C : SWI_C) : 1.0f;
#pragma unroll
    for (int i = 0; i < 8; ++i) { float sc = T.scale * gus; if (HAS_GK) sc *= gv[i];
        LAS float* s = scr + (8 * i + (lane >> 3)) * 33 + 4 * (lane & 7); s[0] = v[i][0] * sc; s[1] = v[i][1] * sc; s[2] = v[i][2] * sc; s[3] = v[i][3] * sc; }
    asm volatile("s_waitcnt lgkmcnt(0)" ::: "memory");
    const int c = lane & 7;
#pragma unroll
    for (int j = 0; j < 4; ++j) { const int n = (lane >> 3) + 8 * j; const LAS float* s = scr + (8 * c) * 33 + n;
        u32x2 o; o.x = pk4_fp8(s[0 * 33], s[1 * 33], s[2 * 33], s[3 * 33]); o.y = pk4_fp8(s[4 * 33], s[5 * 33], s[6 * 33], s[7 * 33]);
        if (T.nt) __builtin_nontemporal_store(o, (u32x2*)(WT + (size_t)(ndst0 + n) * T.K + k0 + 8 * c)); else *(u32x2*)(WT + (size_t)(ndst0 + n) * T.K + k0 + 8 * c) = o; }
    asm volatile("s_waitcnt lgkmcnt(0)" ::: "memory");
}
template <bool HAS_GK, class SrcMap> __device__ __forceinline__ void p0_w8_run(const Frame& F, const W8Task& T, LAS float* scr, SrcMap srcmap, int gw = -1, int NGW = 0) {
    if (gw < 0) { gw = F.vcu * 8 + F.wave; NGW = F.G * 8; } const int total = T.ngroups * (T.K / 64) * (T.N / 32);
    f32x4 va[8], vb_[8]; float ga[8], gb[8]; int it = gw;
    if (it < total) p0_w8_load<HAS_GK>(T, it, va, ga, F.lane, srcmap);
    while (it < total) {
        const int i1 = it + NGW; if (i1 < total) p0_w8_load<HAS_GK>(T, i1, vb_, gb, F.lane, srcmap);
        p0_w8_store<HAS_GK>(T, it, va, ga, scr, F.lane);
        if (i1 >= total) break;
        const int i2 = i1 + NGW; if (i2 < total) p0_w8_load<HAS_GK>(T, i2, va, ga, F.lane, srcmap);
        p0_w8_store<HAS_GK>(T, i1, vb_, gb, scr, F.lane);
        it = i2;
    }
}
template <class SrcMap> __device__ __forceinline__ void p0_weight(const Frame& F, const float* W, int K, int N, bf16_t* WT, const float* gk, LAS float* scr, SrcMap srcmap) {
    const int gw = F.vcu * 8 + F.wave, NGW = F.G * 8; const int nkb = K / 64, nnb = N / 32, nitems = nkb * nnb;
    for (int it = gw; it < nitems; it += NGW) { const int kb = it / nnb, nb = it % nnb; p0_item(W, N, kb * 64, srcmap(nb * 32), WT, K, nb * 32, gk, scr, F.lane); }
}
struct MapId { __device__ __forceinline__ int operator()(int n) const { return n; } };
struct MapInProj { __device__ __forceinline__ int operator()(int n) const { const int pn = n >> 8, c = n & 255; return pn * 256 + 64 * ((c & 127) >> 5) + 32 * (c >> 7) + (c & 31); } };
struct MapGateUp { __device__ __forceinline__ int operator()(int n) const { const int pn = n >> 8, bj = (n >> 7) & 1, j = n & 127; return 1024 * bj + 128 * pn + j; } };

__device__ const double ROPE_INV[32] = {1.0, 0.7498942093324559, 0.5623413251903491, 0.4216965034285822, 0.31622776601683794, 0.23713737056616552, 0.1778279410038923, 0.1333521432163324, 0.1, 0.07498942093324558, 0.05623413251903491, 0.042169650342858224, 0.03162277660168379, 0.023713737056616554, 0.01778279410038923, 0.01333521432163324, 0.01, 0.007498942093324558, 0.005623413251903491, 0.004216965034285823, 0.0031622776601683794, 0.0023713737056616554, 0.0017782794100389228, 0.001333521432163324, 0.001, 0.0007498942093324559, 0.0005623413251903491, 0.00042169650342858224, 0.00031622776601683794, 0.00023713737056616554, 0.00017782794100389227, 0.0001333521432163324};

constexpr int NPHASE = 9;
#ifndef REP_PHASE
#define REP_PHASE -1
#endif
#define NREP(k) ((k) == REP_PHASE ? 2 : 1)
constexpr int N_LAUNCHES = MK_N_LAUNCHES;

__global__ void __launch_bounds__(512, 2) fwd_kernel(Args args) {
    extern __shared__ __attribute__((aligned(16))) unsigned char lds_raw[];
    Frame F;
    F.lds = (LAS unsigned char*)lds_raw;
    F.wave = __builtin_amdgcn_readfirstlane((int)threadIdx.x >> 6); F.lane = lane_fresh(); F.tid = F.wave * 64 + F.lane;
#define REFRESH_ID() do { F.lane = lane_fresh(); F.tid = F.wave * 64 + F.lane; } while (0)
    F.G = gridDim.x; { const int bx = blockIdx.x; F.vcu = (F.G % 8 == 0) ? (bx % 8) * (F.G / 8) + bx / 8 : bx; }
    unsigned char* ws = args.ws;
    unsigned* ctl = (unsigned*)(ws + WS_CTL);
    volatile LAS unsigned* LCTL = (volatile LAS unsigned*)(F.lds + LDSCTL_OFF);
    for (int u = F.tid; u < (LDS_BYTES - LDSCTL_OFF) / 4; u += 512) ((LAS unsigned*)(F.lds + LDSCTL_OFF))[u] = 0u;
    __syncthreads();
    XcdBarrier bar; bar.bar = ctl + CW_BAR; bar.x = 0; bar.st = nullptr;
    if (N_LAUNCHES == 1) bar = xcd_barrier_post(ctl + CW_BAR, LCTL + L_BARST, F.wave);
#define GRID_BAR() do { if (N_LAUNCHES == 1) xcd_barrier(bar, F.wave); } while (0)
    const int lo = args.ph_lo, hi = args.ph_hi;
#ifndef PHASE_MASK
#define PHASE_MASK 0x1ff
#endif
#define IN(k) (((PHASE_MASK >> (k)) & 1) && lo <= (k) && (k) < hi)
#define BOTH(k) (IN(k) && IN((k) + 1))

#define x_in ((const float*)args.in[0])
#define g_mix ((const float*)args.in[1])
#define w_in ((const float*)args.in[2])
#define qa_norm ((const float*)args.in[3])
#define ka_norm ((const float*)args.in[4])
#define sink_b ((const float*)args.in[5])
#define w_br_a ((const float*)args.in[6])
#define w_br_b ((const float*)args.in[7])
#define w_out ((const float*)args.in[8])
#define g_ffn ((const float*)args.in[9])
#define w_router ((const float*)args.in[10])
#define b_router ((const float*)args.in[11])
#define w_gate_up ((const float*)args.in[12])
#define b_gate_up ((const float*)args.in[13])
#define w_down ((const float*)args.in[14])
#define b_down ((const float*)args.in[15])
#define g_final ((const float*)args.in[16])
    float* out = args.out;
    float* RSTD = (float*)(ws + WS_RSTD); float* ROPE = (float*)(ws + WS_ROPE); u32x2* LIST2 = (u32x2*)(ws + WS_LIST2);
    unsigned char* WIN = (unsigned char*)(ws + WS_WIN); unsigned char* WA = (unsigned char*)(ws + WS_WA); unsigned char* WB = (unsigned char*)(ws + WS_WB); unsigned char* WOUT = (unsigned char*)(ws + WS_WOUT);
    unsigned char* XB = (unsigned char*)(ws + WS_XB); unsigned char* QA = (unsigned char*)(ws + WS_QA); unsigned char* QBb = (unsigned char*)(ws + WS_QB);
    bf16_t* KA = (bf16_t*)(ws + WS_KA); bf16_t* VA = (bf16_t*)(ws + WS_VA); bf16_t* KBb = (bf16_t*)(ws + WS_KB); bf16_t* VBb = (bf16_t*)(ws + WS_VB);
    unsigned char* GA = (unsigned char*)(ws + WS_GA); unsigned char* GB = (unsigned char*)(ws + WS_GB); unsigned char* MERGED = (unsigned char*)(ws + WS_MERGED); unsigned char* H2 = (unsigned char*)(ws + WS_H2);
    unsigned char* WGU = (unsigned char*)(ws + WS_WGU); unsigned char* WD = (unsigned char*)(ws + WS_WD); unsigned char* ACT = (unsigned char*)(ws + WS_ACT); unsigned char* YB = (unsigned char*)(ws + WS_Y);
    unsigned char* OA = (unsigned char*)(ws + WS_OA); unsigned char* OB = (unsigned char*)(ws + WS_OB); bf16_t* X1 = (bf16_t*)(ws + WS_X1);
    float* cosA = ROPE, *sinA = ROPE + SEQ * 32, *cosB = ROPE + 2 * SEQ * 32, *sinB = ROPE + 3 * SEQ * 32;
    const int gw = F.vcu * 8 + F.wave, NGW = F.G * 8;

    if (IN(0)) {
        REFRESH_ID();
        LAS float* scr = (LAS float*)(F.lds + RING_OFF + F.wave * 16384);
        for (int rep_ = 0; rep_ < NREP(0); ++rep_) {
        for (int m = gw; m < MTOK; m += 2 * NGW) {
            const int m1 = m + NGW; const bool has1 = m1 < MTOK;
            const f32x4* xr0 = (const f32x4*)(x_in + (size_t)m * DM) + F.lane; const f32x4* xr1 = (const f32x4*)(x_in + (size_t)(has1 ? m1 : m) * DM) + F.lane;
            f32x4 v0[4], v1[4]; float s0 = 0.f, s1 = 0.f;
#pragma unroll
            for (int j = 0; j < 4; ++j) { v0[j] = __builtin_nontemporal_load(xr0 + 64 * j); v1[j] = __builtin_nontemporal_load(xr1 + 64 * j); }
#pragma unroll
            for (int j = 0; j < 4; ++j) { s0 += (v0[j].x * v0[j].x + v0[j].y * v0[j].y) + (v0[j].z * v0[j].z + v0[j].w * v0[j].w); s1 += (v1[j].x * v1[j].x + v1[j].y * v1[j].y) + (v1[j].z * v1[j].z + v1[j].w * v1[j].w); }
            s0 = wave_sum(s0); s1 = wave_sum(s1);
            if (F.lane == 0) { RSTD[m] = rsqrtf(s0 * (1.0f / DM) + EPS); if (has1) RSTD[m1] = rsqrtf(s1 * (1.0f / DM) + EPS); }
            unsigned* o0 = (unsigned*)(XB + (size_t)m * DM) + F.lane; unsigned* o1 = (unsigned*)(XB + (size_t)m1 * DM) + F.lane;
#pragma unroll
            for (int j = 0; j < 4; ++j) { o0[64 * j] = pk4_fp8(v0[j].x, v0[j].y, v0[j].z, v0[j].w); if (has1) o1[64 * j] = pk4_fp8(v1[j].x, v1[j].y, v1[j].z, v1[j].w); }
        }
        { W8Task T{w_in, WIN, DM, IN_COLS, 1, 32.0f, g_mix}; p0_w8_run<true>(F, T, scr, MapInProj()); }
        { W8Task T{w_br_a, WA, QW, DM, 1, 32.0f, nullptr}; p0_w8_run<false>(F, T, scr, MapId()); }
        { W8Task T{w_br_b, WB, QW, DM, 1, 32.0f, nullptr}; p0_w8_run<false>(F, T, scr, MapId()); }
        { W8Task T{w_out, WOUT, DM, DM, 1, 32.0f, nullptr}; p0_w8_run<false>(F, T, scr, MapId()); }
        { W8Task T{w_down, WD, DFF, DM, NEXP, 32.0f, nullptr, 0, 1}; p0_w8_run<false>(F, T, scr, MapId()); }
        {
            for (int it = gw; it < SEQ * 32 / 64; it += NGW) {
                const int idx = it * 64 + F.lane, t = idx >> 5, i = idx & 31;
                const double i2pi = 0.15915494309189535;
                { const double ang = (i < 16) ? (double)(t >> 6) * ROPE_INV[2 * i] : (double)(t & 63) * ROPE_INV[2 * (i - 16)];
                  double rev = ang * i2pi; rev -= rint(rev); const float fr_ = (float)rev;
                  ((unsigned*)ROPE)[idx] = pk2(__builtin_amdgcn_cosf(fr_), __builtin_amdgcn_sinf(fr_)); }
                { const double ang = (double)t * ROPE_INV[i];
                  double rev = ang * i2pi; rev -= rint(rev); const float fr_ = (float)rev;
                  ((unsigned*)ROPE)[SEQ * 32 + idx] = pk2(__builtin_amdgcn_cosf(fr_), __builtin_amdgcn_sinf(fr_)); }
            }
        }
        }
        if (BOTH(0)) GRID_BAR();
    }
    int vb = (int)blockIdx.x;
    if (N_LAUNCHES == 1 && lo == 0 && hi > 1) {
        REFRESH_ID();
        if (F.tid == 0) { unsigned base = 0; for (unsigned j = 0; j < 16; ++j) { const unsigned c = xb_ld(&bar.bar[XB_XCNT(j)]); if (j < bar.x) base += c; } LCTL[L_BARST + 3] = base + LCTL[L_BARST + 2]; }
        __syncthreads();
        F.vcu = (int)LCTL[L_BARST + 3];
        if (F.G % 8 == 0) vb = (F.vcu % (F.G / 8)) * 8 + F.vcu / (F.G / 8); else vb = F.vcu;
    }

    if (IN(1)) {
        constexpr int NCONV = 14;
        { const int cpx_ = (F.G % 8 == 0) ? F.G / 8 : F.G, jj_ = F.vcu % cpx_, xg_ = F.vcu / cpx_, nconv_ = NCONV < cpx_ ? NCONV : cpx_;
          if (jj_ < nconv_) { LAS float* scr = (LAS float*)(F.lds + RING_OFF + F.wave * 16384); const int ngrp_ = F.G / cpx_;
              const int gwc = (xg_ * nconv_ + jj_) * 8 + F.wave, ngwc = ngrp_ * nconv_ * 8;
              { W8Task T{w_gate_up, WGU, DM, 2 * DFF, NEXP, 32.0f, nullptr, 1, 1}; p0_w8_run<false>(F, T, scr, MapGateUp(), gwc, ngwc); }
              asm volatile("s_waitcnt vmcnt(0) lgkmcnt(0)" ::: "memory"); __syncthreads(); } }
        pg8::TicketOrder S; S.init(MTOK, IN_COLS, F.G, F.vcu, ctl + CW_TKT, (volatile LAS int*)(LCTL + L_TKT), F.wave);
        EpiInProj E{RSTD, qa_norm, ka_norm, (const unsigned*)ROPE, (const unsigned*)ROPE + SEQ * 32, QA, KA, VA, QBb, KBb, VBb, GA, GB};
        for (int rep_ = 0; rep_ < NREP(1); ++rep_)
        pg8::gemm_phase<EpiInProj, pg8::TicketOrder, true, true, false, true>(F.lds + RING_OFF, XB, WIN, DM, IN_COLS / 256, S, E, F.wave);
        if (BOTH(1)) GRID_BAR();
    }

    if (IN(2)) {
        REFRESH_ID();
        char* shm = (char*)lds_raw + RING_OFF;
        float gq_ = fabsf(qa_norm[F.lane]), gk_ = fabsf(ka_norm[F.lane]);
        gq_ = wave_max(gq_); gk_ = wave_max(gk_);
        const float mrefA = 64.0f * gq_ * gk_ * C2 * 1.0001f;
        const bool nomax = mrefA < 64.0f;
        for (int rep_ = 0; rep_ < NREP(2); ++rep_) {
        for (int i = 0; i < 2; ++i) {
            const int uu = F.vcu + F.G * i; if (uu >= 512) break;
            const int ii = uu >> 8, v = uu & 255, combo = v >> 6, w = (v & 63) + 64 * ii, g = w >> 5, qb = w & 31;
            const int b = combo >> 1, h = (combo & 1) * 4 + g;
            if (nomax) attn_body::attn_unit<0, 8, true>(b, h, qb, QA, (const attn_body::bf16*)KA, (const attn_body::bf16*)VA, OA, shm, F.wave, 0.f, mrefA);
            else attn_body::attn_unit<0, 8>(b, h, qb, QA, (const attn_body::bf16*)KA, (const attn_body::bf16*)VA, OA, shm, F.wave, 0.f);
        }
        for (int i = 0; i < 2; ++i) {
            const int uu = F.vcu + F.G * i; if (uu >= 512) break;
            const int qb = uu & 31, h = (uu >> 5) & 7, b = uu >> 8;
            attn_body::attn_unit<1, 8>(b, h, qb, QBb, (const attn_body::bf16*)KBb, (const attn_body::bf16*)VBb, OB, shm, F.wave, sink_b[h] * 1.4426950408889634f);
        }
        }
        if (BOTH(2)) GRID_BAR();
    }

    if (IN(3)) {
        static_assert(WS_OB == WS_OA + (size_t)MTOK * QW && WS_WB == WS_WA + (size_t)DM * QW, "branch B operands follow branch A's");
        pg8::PairOrder S; S.init(MTOK, DM, F.G, vb);
        EpiGateFused E{GB, GA, MERGED};
        for (int rep_ = 0; rep_ < NREP(3); ++rep_)
        pg8::gemm_phase<EpiGateFused, pg8::PairOrder, true, true, false, true>(F.lds + RING_OFF, OA, WA, QW, DM / 256, S, E, F.wave, 0x7a7a7a7a);
        if (BOTH(3)) GRID_BAR();
    }

    u32x4 whi[4][2], wlo[4][2]; float be_r = 0.f;
#define SPLIT2(a_, b_, hi_, lo_) do { const float _a = (a_), _b = (b_); hi_ = pk2(_a, _b); lo_ = pk2(_a - bflo(hi_), _b - bfhi(hi_)); } while (0)
#define LOAD_WREG() do { const float* wp = w_router + (size_t)(F.wave * 128 + 8 * (F.lane >> 4)) * NEXP + (F.lane & 15); \
        _Pragma("unroll") for (int s_ = 0; s_ < 4; ++s_) _Pragma("unroll") for (int h_ = 0; h_ < 2; ++h_) { float w8[8]; \
            _Pragma("unroll") for (int i_ = 0; i_ < 8; ++i_) w8[i_] = wp[(size_t)(32 * s_ + i_) * NEXP + 16 * h_]; \
            SPLIT2(w8[0], w8[1], whi[s_][h_].x, wlo[s_][h_].x); SPLIT2(w8[2], w8[3], whi[s_][h_].y, wlo[s_][h_].y); SPLIT2(w8[4], w8[5], whi[s_][h_].z, wlo[s_][h_].z); SPLIT2(w8[6], w8[7], whi[s_][h_].w, wlo[s_][h_].w); } \
        be_r = b_router[F.lane & 31]; } while (0)
    if (IN(4)) {
        pg8::StaticOrder S; S.init(MTOK, DM, F.G, vb);
        EpiResid E{x_in, X1};
        for (int rep_ = 0; rep_ < NREP(4); ++rep_)
        pg8::gemm_phase<EpiResid, pg8::StaticOrder, true, true, false, true>(F.lds + RING_OFF, MERGED, WOUT, DM, DM / 256, S, E, F.wave, 0x7a7a7a7a);
        if (BOTH(4)) { REFRESH_ID(); LOAD_WREG(); GRID_BAR(); }
    }

    if (IN(5)) {
        REFRESH_ID();
        constexpr int HP = 1028;
        LAS float* hs = (LAS float*)(F.lds + RING_OFF);
        LAS float* part = (LAS float*)(F.lds + RING_OFF + 66560);
        volatile LAS int* lcnt = (volatile LAS int*)(LCTL + L_LCNT); volatile LAS int* lbase = (volatile LAS int*)(LCTL + L_LBASE);
        volatile LAS int* sele = (volatile LAS int*)(LCTL + L_SELE); volatile LAS int* selr = (volatile LAS int*)(LCTL + L_SELR); volatile LAS float* selg = (volatile LAS float*)(LCTL + L_SELG);
        const int e = F.lane & 31, kh = F.lane >> 5;
        if (!IN(4)) { LOAD_WREG(); }
        const float be = be_r;
        f32x4 gff[4];
#pragma unroll
        for (int j = 0; j < 4; ++j) gff[j] = *((const f32x4*)g_ffn + F.lane + 64 * j);
        for (int chunk = F.vcu; chunk < MTOK / 64; chunk += F.G) {
            if (F.tid < 32) lcnt[F.tid] = 0;
            const int row0 = chunk * 64;
            u32x2 xn[2][4];
#pragma unroll
            for (int rr = 0; rr < 2; ++rr)
#pragma unroll
                for (int j = 0; j < 4; ++j) xn[rr][j] = *((const u32x2*)(X1 + (size_t)(row0 + F.wave * 2 + rr) * DM) + F.lane + 64 * j);
            for (int step = 0; step < 4; ++step) {
                u32x2 xc[2][4];
#pragma unroll
                for (int rr = 0; rr < 2; ++rr)
#pragma unroll
                    for (int j = 0; j < 4; ++j) xc[rr][j] = xn[rr][j];
                if (step < 3) {
#pragma unroll
                    for (int rr = 0; rr < 2; ++rr)
#pragma unroll
                        for (int j = 0; j < 4; ++j) xn[rr][j] = *((const u32x2*)(X1 + (size_t)(row0 + (step + 1) * 16 + F.wave * 2 + rr) * DM) + F.lane + 64 * j);
                }
#pragma unroll
                for (int rr = 0; rr < 2; ++rr) {
                    const int rl = F.wave * 2 + rr, m = row0 + step * 16 + rl;
                    f32x4 v[4]; float ssum = 0.f;
#pragma unroll
                    for (int j = 0; j < 4; ++j) { const u32x2 w_ = xc[rr][j]; v[j] = (f32x4){bflo(w_.x), bfhi(w_.x), bflo(w_.y), bfhi(w_.y)}; ssum += (v[j].x * v[j].x + v[j].y * v[j].y) + (v[j].z * v[j].z + v[j].w * v[j].w); }
                    ssum = wave_sum(ssum); const float rs = rsqrtf(ssum * (1.0f / DM) + EPS);
                    unsigned* o8 = (unsigned*)(H2 + (size_t)m * DM) + F.lane;
#pragma unroll
                    for (int j = 0; j < 4; ++j) { const f32x4 hv = v[j] * rs * gff[j];
                        o8[64 * j] = pk4_fp8(hv.x, hv.y, hv.z, hv.w);
                        *(LAS f32x4*)(hs + rl * HP + 4 * F.lane + 256 * j) = hv; }
                }
                __syncthreads();
                {
                    const LAS float* ha = hs + (F.lane & 15) * HP + F.wave * 128 + 8 * (F.lane >> 4);
                    f32x4 c0 = {0.f, 0.f, 0.f, 0.f}, c1 = {0.f, 0.f, 0.f, 0.f};
#pragma unroll
                    for (int s_ = 0; s_ < 4; ++s_) { const f32x4 x0 = *(const LAS f32x4*)(ha + 32 * s_), x1 = *(const LAS f32x4*)(ha + 32 * s_ + 4);
                        u32x4 ah, al; SPLIT2(x0[0], x0[1], ah.x, al.x); SPLIT2(x0[2], x0[3], ah.y, al.y); SPLIT2(x1[0], x1[1], ah.z, al.z); SPLIT2(x1[2], x1[3], ah.w, al.w);
                        const bf16x8 ah8 = __builtin_bit_cast(bf16x8, ah), al8 = __builtin_bit_cast(bf16x8, al);
                        c0 = __builtin_amdgcn_mfma_f32_16x16x32_bf16(al8, __builtin_bit_cast(bf16x8, whi[s_][0]), c0, 0, 0, 0);
                        c1 = __builtin_amdgcn_mfma_f32_16x16x32_bf16(al8, __builtin_bit_cast(bf16x8, whi[s_][1]), c1, 0, 0, 0);
                        c0 = __builtin_amdgcn_mfma_f32_16x16x32_bf16(ah8, __builtin_bit_cast(bf16x8, wlo[s_][0]), c0, 0, 0, 0);
                        c1 = __builtin_amdgcn_mfma_f32_16x16x32_bf16(ah8, __builtin_bit_cast(bf16x8, wlo[s_][1]), c1, 0, 0, 0);
                        c0 = __builtin_amdgcn_mfma_f32_16x16x32_bf16(ah8, __builtin_bit_cast(bf16x8, whi[s_][0]), c0, 0, 0, 0);
                        c1 = __builtin_amdgcn_mfma_f32_16x16x32_bf16(ah8, __builtin_bit_cast(bf16x8, whi[s_][1]), c1, 0, 0, 0); }
                    LAS float* pw_ = part + (F.wave * 16 + 4 * (F.lane >> 4)) * 32 + (F.lane & 15);
#pragma unroll
                    for (int r = 0; r < 4; ++r) { pw_[r * 32] = c0[r]; pw_[r * 32 + 16] = c1[r]; }
                }
                __syncthreads();
                {
                    const int rl = F.wave * 2 + kh;
                    float cur = be;
#pragma unroll
                    for (int w = 0; w < 8; ++w) cur += part[(w * 16 + rl) * 32 + e];
                    float tv[4]; int ti[4];
#pragma unroll
                    for (int kk = 0; kk < 4; ++kk) {
                        const float bv = swap16_max(row_max16(cur));
                        const unsigned long long bm = __ballot(cur == bv);
                        const int bi = __builtin_ctz(kh ? (unsigned)(bm >> 32) : (unsigned)bm);
                        tv[kk] = bv; ti[kk] = bi; if (e == bi) cur = -INFINITY;
                    }
                    const float e1 = __expf(tv[1] - tv[0]), e2 = __expf(tv[2] - tv[0]), e3 = __expf(tv[3] - tv[0]);
                    const float inv = 1.0f / (1.0f + e1 + e2 + e3);
                    if (e < 4) {
                        const int kk = e; const int ex = kk == 0 ? ti[0] : kk == 1 ? ti[1] : kk == 2 ? ti[2] : ti[3];
                        const float gx = (kk == 0 ? 1.0f : kk == 1 ? e1 : kk == 2 ? e2 : e3) * inv;
                        const int a = (step * 16 + rl) * 4 + kk;
                        const int rank = __hip_atomic_fetch_add((LAS int*)&lcnt[ex], 1, __ATOMIC_RELAXED, __HIP_MEMORY_SCOPE_WORKGROUP);
                        sele[a] = ex; selr[a] = rank; selg[a] = gx;
                    }
                }
            }
            __syncthreads();
            if (F.tid < 32) lbase[F.tid] = (int)xb_add(ctl + CW_ECNT + F.tid, (unsigned)lcnt[F.tid]);
            __syncthreads();
            if (F.tid < 256) { const int a = F.tid; const int ex = sele[a]; const int pos = lbase[ex] + selr[a]; const int slot = (row0 + (a >> 2)) * 4 + (a & 3);
                u32x2 pr; pr.x = (unsigned)slot; pr.y = __float_as_uint(selg[a]); LIST2[ex * MTOK + pos] = pr; }
            __syncthreads();
        }
        if (BOTH(5)) GRID_BAR();
    }

    if (IN(6) || IN(7)) {
        REFRESH_ID();
        if (F.wave == 0) {
            const int e_ = F.lane & 31; const int c = (int)xb_ld(ctl + CW_ECNT + e_); const int tiles_ = (c + 255) >> 8;
            LAS int* tl = (LAS int*)(F.lds + LDSCTL_OFF) + L_LCNT;
            if (F.lane < 32) { LCTL[L_CNT + e_] = (unsigned)c; tl[e_] = tiles_; }
            asm volatile("s_waitcnt lgkmcnt(0)" ::: "memory");
            int pre_ = 0;
#pragma unroll
            for (int i = 0; i < NEXP; ++i) { const int t_ = tl[i]; pre_ += (i < e_) ? t_ : 0; }
            if (F.lane < 32) LCTL[L_PRE + e_] = (unsigned)pre_;
            if (F.lane == 31) LCTL[L_PRE + NEXP] = (unsigned)(pre_ + tiles_);
        }
        __syncthreads();
    }
    const LAS int* Lpre = (const LAS int*)(F.lds + LDSCTL_OFF) + L_PRE; const LAS int* Lcnt = (const LAS int*)(F.lds + LDSCTL_OFF) + L_CNT;

    if (IN(6)) {
        pg8::MoeOrder S; S.init(Lpre, Lcnt, LIST2, 2 * DFF / 256, F.G, F.vcu);
        EpiSwiglu E{b_gate_up, ACT};
        for (int rep_ = 0; rep_ < NREP(6); ++rep_)
        pg8::gemm_phase<EpiSwiglu, pg8::MoeOrder, true, true, true, true>(F.lds + RING_OFF, H2, WGU, DM, 2 * DFF / 256, S, E, F.wave);
        if (BOTH(6)) GRID_BAR();
    }

    if (IN(7)) {
        pg8::MoeOrder S; S.init(Lpre, Lcnt, LIST2, DM / 256, F.G, F.vcu);
        EpiDown E{b_down, LIST2, Lcnt, YB};
        for (int rep_ = 0; rep_ < NREP(7); ++rep_)
        pg8::gemm_phase<EpiDown, pg8::MoeOrder, true, true, false, true>(F.lds + RING_OFF, ACT, WD, DFF, DM / 256, S, E, F.wave);
        if (BOTH(7)) GRID_BAR();
    }

    if (IN(8)) {
        const int lane8 = (int)__builtin_amdgcn_mbcnt_hi(~0u, __builtin_amdgcn_mbcnt_lo(~0u, 0u));
        f32x4 gfin[4];
#pragma unroll
        for (int j = 0; j < 4; ++j) gfin[j] = *((const f32x4*)g_final + lane8 + 64 * j);
        for (int rep_ = 0; rep_ < NREP(8); ++rep_)
        for (int m = gw; m < MTOK; m += NGW) {
            const u32x2* xin = (const u32x2*)(X1 + (size_t)m * DM) + lane8;
            f32x4* xr = (f32x4*)(out + (size_t)m * DM) + lane8;
            f32x4 v[4];
#pragma unroll
            for (int j = 0; j < 4; ++j) { const u32x2 w_ = xin[64 * j]; v[j] = (f32x4){bflo(w_.x), bfhi(w_.x), bflo(w_.y), bfhi(w_.y)}; }
#pragma unroll
            for (int k = 0; k < 4; ++k) { const unsigned* yr = (const unsigned*)(YB + ((size_t)m * 4 + k) * DM) + lane8;
#pragma unroll
                for (int j = 0; j < 4; ++j) { const int w = (int)yr[64 * j]; const f32x2 lo_ = __builtin_amdgcn_cvt_pk_f32_fp8(w, false), hi_ = __builtin_amdgcn_cvt_pk_f32_fp8(w, true);
                    v[j].x += 0.25f * lo_.x; v[j].y += 0.25f * lo_.y; v[j].z += 0.25f * hi_.x; v[j].w += 0.25f * hi_.y; } }
            float s = 0.f;
#pragma unroll
            for (int j = 0; j < 4; ++j) s += (v[j].x * v[j].x + v[j].y * v[j].y) + (v[j].z * v[j].z + v[j].w * v[j].w);
            s = wave_sum(s); const float rs = rsqrtf(s * (1.0f / DM) + EPS);
#pragma unroll
            for (int j = 0; j < 4; ++j) xr[64 * j] = v[j] * rs * gfin[j];
        }
    }
#undef IN
#undef BOTH
#undef GRID_BAR
#undef x_in
#undef g_mix
#undef w_in
#undef qa_norm
#undef ka_norm
#undef sink_b
#undef w_br_a
#undef w_br_b
#undef w_out
#undef g_ffn
#undef w_router
#undef b_router
#undef w_gate_up
#undef b_gate_up
#undef w_down
#undef b_down
#undef g_final
}

extern "C" void kernel_launch(void* const* d_in, const int* in_sizes, int n_in, void* d_out, int out_size, void* d_ws, size_t ws_size, hipStream_t stream) {
    static int grid = 0;
    if (grid == 0) {
        if (n_in != 17 || out_size != MTOK * DM || ws_size < WS_END) { fprintf(stderr, "kernel_launch: unexpected problem shape (n_in %d out %d ws %zu)\n", n_in, out_size, ws_size); grid = -1; return; }
        int dev = 0, cus = 0;
        if (hipGetDevice(&dev) != hipSuccess || hipDeviceGetAttribute(&cus, hipDeviceAttributeMultiprocessorCount, dev) != hipSuccess) { grid = -1; return; }
        if (hipFuncSetAttribute((const void*)fwd_kernel, hipFuncAttributeMaxDynamicSharedMemorySize, LDS_BYTES) != hipSuccess) { fprintf(stderr, "kernel_launch: hipFuncSetAttribute failed\n"); grid = -1; return; }
        int per_cu = 0;
        if (hipOccupancyMaxActiveBlocksPerMultiprocessor(&per_cu, (const void*)fwd_kernel, 512, LDS_BYTES) != hipSuccess || per_cu < 1) { fprintf(stderr, "kernel_launch: occupancy query says %d\n", per_cu); }
        (void)hipGetLastError();
        grid = cus;
    }
    if (grid < 0) return;
    (void)hipMemsetAsync((char*)d_ws + WS_CTL, 0, CTL_ZERO_BYTES, stream);
    Args a{};
    for (int i = 0; i < 17; ++i) a.in[i] = (const float*)d_in[i];
    a.out = (float*)d_out; a.ws = (unsigned char*)d_ws;
    if (N_LAUNCHES == 1) {
        a.ph_lo = 0; a.ph_hi = NPHASE; a.li = 0;
        hipLaunchKernelGGL(fwd_kernel, dim3(grid), dim3(512), LDS_BYTES, stream, a);
#if defined(PROBE_PHASE)
        a.ph_lo = PROBE_PHASE; a.ph_hi = PROBE_PHASE + 1; a.li = 1;
        hipLaunchKernelGGL(fwd_kernel, dim3(grid), dim3(512), LDS_BYTES, stream, a);
#endif
    } else {
        for (int li = 0; li < NPHASE; ++li) { a.ph_lo = li; a.ph_hi = li + 1; a.li = li; hipLaunchKernelGGL(fwd_kernel, dim3(grid), dim3(512), LDS_BYTES, stream, a); }
    }
}
```

```cpp
#include <hip/hip_runtime.h>
#include <hip/hip_bf16.h>
#include <cstdio>
#include <cstdint>
#include <cmath>

#ifndef MK_N_LAUNCHES
#define MK_N_LAUNCHES 1
#endif

constexpr int BATCH = 2, SEQ = 8192, DM = 1024, MTOK = BATCH * SEQ;
constexpr int HD = 64, NQH = 8, NKVH = 2, QW = NQH * HD  , KVW = NKVH * HD  ;
constexpr int IN_COLS = 3584, NEXP = 32, TOPK = 4, DFF = 1024;
constexpr int NSLOT_ASSIGN = MTOK * TOPK;
constexpr int ACT_ROWS = NSLOT_ASSIGN + NEXP * 256;
constexpr float EPS = 1e-6f;
constexpr float C2 = 0.125f * 1.4426950408889634f;

#define LAS __attribute__((address_space(3)))
#define GAS __attribute__((address_space(1)))
typedef unsigned short bf16_t;
typedef short bf16x8 __attribute__((ext_vector_type(8)));
typedef float f32x4 __attribute__((ext_vector_type(4)));
typedef float f32x2 __attribute__((ext_vector_type(2)));
typedef unsigned u32x4 __attribute__((ext_vector_type(4)));
typedef unsigned u32x2 __attribute__((ext_vector_type(2)));
typedef int i32x8 __attribute__((ext_vector_type(8)));
typedef int i32x4 __attribute__((ext_vector_type(4)));
typedef i32x8 i32x8_a16 __attribute__((aligned(16)));
__device__ __forceinline__ unsigned pk4_fp8(float a, float b, float c, float d) { int w = 0; w = __builtin_amdgcn_cvt_pk_fp8_f32(a, b, w, false); w = __builtin_amdgcn_cvt_pk_fp8_f32(c, d, w, true); return (unsigned)w; }

__device__ __forceinline__ unsigned f2bf(float f) { unsigned u = __builtin_bit_cast(unsigned, f); return (u + 0x7fffu + ((u >> 16) & 1u)) >> 16; }
typedef __bf16 bf16x2_hw __attribute__((ext_vector_type(2)));
__device__ __forceinline__ unsigned pk2(float lo, float hi) { f32x2 v = {lo, hi}; bf16x2_hw b = __builtin_convertvector(v, bf16x2_hw); return __builtin_bit_cast(unsigned, b); }
__device__ __forceinline__ float bf2f(unsigned short b) { return __builtin_bit_cast(float, (unsigned)b << 16); }
__device__ __forceinline__ float bflo(unsigned w) { return __builtin_bit_cast(float, w << 16); }
__device__ __forceinline__ float bfhi(unsigned w) { return __builtin_bit_cast(float, w & 0xffff0000u); }
constexpr float SWI_C = -1.702f * 1.4426950408889634f;
__device__ __forceinline__ float sigmoidf_(float v) { return __builtin_amdgcn_rcpf(1.0f + __builtin_amdgcn_exp2f(v * -1.4426950408889634f)); }
__device__ __forceinline__ int lane_fresh() { int l; asm volatile("v_mbcnt_lo_u32_b32 %0, -1, 0\n\tv_mbcnt_hi_u32_b32 %0, -1, %0" : "=v"(l)); return l; }
template <int CTRL> __device__ __forceinline__ float dpp_f(float v) { return __builtin_bit_cast(float, __builtin_amdgcn_update_dpp(0, __builtin_bit_cast(int, v), CTRL, 0xf, 0xf, true)); }
__device__ __forceinline__ float row_sum16(float v) { v += dpp_f<0xB1>(v); v += dpp_f<0x4E>(v); v += dpp_f<0x141>(v); v += dpp_f<0x140>(v); return v; }
__device__ __forceinline__ float row_max16(float v) { v = fmaxf(v, dpp_f<0xB1>(v)); v = fmaxf(v, dpp_f<0x4E>(v)); v = fmaxf(v, dpp_f<0x141>(v)); v = fmaxf(v, dpp_f<0x140>(v)); return v; }
__device__ __forceinline__ float swap16_sum(float v) { const auto r = __builtin_amdgcn_permlane16_swap(__float_as_uint(v), __float_as_uint(v), false, false); return __uint_as_float(r[0]) + __uint_as_float(r[1]); }
__device__ __forceinline__ float swap32_sum(float v) { const auto r = __builtin_amdgcn_permlane32_swap(__float_as_uint(v), __float_as_uint(v), false, false); return __uint_as_float(r[0]) + __uint_as_float(r[1]); }
__device__ __forceinline__ float swap16_max(float v) { const auto r = __builtin_amdgcn_permlane16_swap(__float_as_uint(v), __float_as_uint(v), false, false); return fmaxf(__uint_as_float(r[0]), __uint_as_float(r[1])); }
__device__ __forceinline__ float swap32_max(float v) { const auto r = __builtin_amdgcn_permlane32_swap(__float_as_uint(v), __float_as_uint(v), false, false); return fmaxf(__uint_as_float(r[0]), __uint_as_float(r[1])); }
__device__ __forceinline__ float wave_sum(float v) { return swap32_sum(swap16_sum(row_sum16(v))); }
__device__ __forceinline__ float wave_max(float v) { return swap32_max(swap16_max(row_max16(v))); }

namespace pg8 {
constexpr int BM = 256, BK = 64, HALF = 128, HTB = HALF * BK * 2, STAGE_BYTES = 8 * HTB, NXCD = 8, WGM = 8;
__host__ __device__ __forceinline__ int lds_byte(int r, int c) { const int st = (r >> 4) * 2 + (c >> 5), rr = r & 15, cc = c & 31, ob = rr * 64 + cc * 2; return st * 1024 + (ob ^ (((ob >> 9) & 1) << 5)); }
__host__ __device__ __forceinline__ void stage_rc(int b, int& R, int& C) { const int st = b / 1024, sb = b % 1024, swz = sb ^ (((sb >> 9) & 1) << 5); R = (st >> 1) * 16 + swz / 64; C = (st & 1) * 32 + (swz % 64) / 2; }
__host__ __device__ __forceinline__ int perm32(int rho) { const int n = rho >> 4, i = rho & 15; return 8 * (i >> 2) + 4 * n + (i & 3); }

struct Unit { int pm, pn, e, pml; };

struct StaticOrder {
    int nM, nN, nwg, G, c;
    __device__ void init(int M, int N, int G_, int c_) { nM = M / BM; nN = N / BM; nwg = nM * nN; G = G_; c = c_; }
    __device__ bool next(int i, Unit& u) const {
        const long L = (long)i * G + c; if (L >= nwg) return false;
        int wgid = (int)L; { const int q = nwg / NXCD, r = nwg % NXCD, xcd = wgid % NXCD, off = wgid / NXCD; wgid = (xcd < r ? xcd * (q + 1) : r * (q + 1) + (xcd - r) * q) + off; }
        const int nig = WGM * nN, gid = wgid / nig, fm = gid * WGM, gsz = (nM - fm) < WGM ? (nM - fm) : WGM;
        u.pm = fm + ((wgid % nig) % gsz); u.pn = (wgid % nig) / gsz; u.e = 0; u.pml = u.pm; return true;
    }
    __device__ __forceinline__ unsigned a_rowoff(const Unit&, int) const { return 0u; }
    static constexpr bool LAZY = false;
    __device__ __forceinline__ void prefetch(int) const {}
};

struct PairOrder {
    StaticOrder so; int nM;
    static constexpr bool LAZY = false;
    __device__ void init(int M, int N, int G, int c) { so.init(M, N, G, c); nM = M / BM; }
    __device__ bool next(int i, Unit& u) const { if (i >= 2 || !so.next(0, u)) return false; u.e = i; u.pml = u.pm; u.pm = u.pm + i * nM; return true; }
    __device__ __forceinline__ void prefetch(int) const {}
    __device__ __forceinline__ unsigned a_rowoff(const Unit&, int) const { return 0u; }
};

struct TicketOrder {
    StaticOrder so; unsigned* ctr; volatile LAS int* slot; int x, cpx, wave;
    static constexpr bool LAZY = true;
    __device__ void init(int M, int N, int G, int vcu, unsigned* ctr_base, volatile LAS int* slot_, int wave_) { wave = wave_; so.init(M, N, G, 0); cpx = (G % 8 == 0) ? G / 8 : G; x = vcu / cpx; ctr = ctr_base + 64 * x; slot = slot_; }
    __device__ __forceinline__ void prefetch(int i) const { if (wave == 0 && lane_fresh() == 0) { const int t = (int)__hip_atomic_fetch_add(ctr, 1u, __ATOMIC_RELAXED, __HIP_MEMORY_SCOPE_AGENT); slot[i & 1] = t; } }
    __device__ bool next(int i, Unit& u) const {
        const int t = slot[i & 1]; StaticOrder s2 = so; s2.c = 8 * (t % cpx) + x; if (so.G % 8 != 0) s2.c = t % cpx;
        return s2.next(t / cpx, u);
    }
    __device__ __forceinline__ unsigned a_rowoff(const Unit&, int) const { return 0u; }
};

struct MoeOrder {
    const LAS int* pre; const LAS int* cnt; const u32x2* list; int npn, lo, hi, j, cpx; unsigned rowbytes;
    __device__ void init(const LAS int* pre_, const LAS int* cnt_, const u32x2* list_, int npn_, int G, int vcu) {
        pre = pre_; cnt = cnt_; list = list_; npn = npn_; rowbytes = (unsigned)DM;
        const int U = pre[NEXP] * npn; cpx = (G % 8 == 0) ? G / 8 : G; const int nx = G / cpx, x = vcu / cpx; j = vcu % cpx;
        lo = (int)((long)U * x / nx); hi = (int)((long)U * (x + 1) / nx);
    }
    __device__ bool next(int i, Unit& u) const {
        const int L = lo + j + cpx * i; if (L >= hi) return false;
        const int tr = L / npn; u.pn = L % npn; int e = 0;
#pragma unroll
        for (int st = NEXP / 2; st > 0; st >>= 1) { if (pre[e + st] <= tr) e += st; }
        u.e = e; u.pm = tr; u.pml = tr - pre[e]; return true;
    }
    static constexpr bool LAZY = false;
    __device__ __forceinline__ void prefetch(int) const {}
    __device__ __forceinline__ unsigned a_rowoff(const Unit& u, int R) const {
        const int idx = u.pml * BM + R; const int ic = idx < cnt[u.e] ? idx : 0;
        const int slot = (int)list[u.e * MTOK + ic].x;
        return (unsigned)(slot >> 2) * rowbytes;
    }
};

template <class Epi, class Sched, bool ALIGN_EPI, bool SP2, bool GATHER, bool F8 = false>
__device__ __forceinline__ void gemm_phase(LAS unsigned char* lds, const void* Aptr, const void* Btptr, const int K, const int NBT, const Sched& S, const Epi& E, const int wave_, const int scla_ = 0x7f7f7f7f) {
    const int wid = wave_, lane = lane_fresh(), tid = wid * 64 + lane, wr = wid >> 2, wc = wid & 3, fr = lane & 15, fq = lane >> 4;
    constexpr int EB = F8 ? 1 : 2; const int nt = K * EB / (BK * 2);
    unsigned voffA[2], voffB[2]; int R0, C0;
#pragma unroll
    for (int i = 0; i < 2; ++i) { const int R = 8 * wid + 64 * i + (lane >> 3), cl = (lane & 7) ^ ((R >> 1) & 7); const int Rb = Epi::PERM ? ((R & ~31) + perm32(R & 31)) : R;
        voffA[i] = (unsigned)(R * K * EB + cl * 16); voffB[i] = (unsigned)(Rb * K * EB + cl * 16); if (i == 0) { R0 = R; C0 = cl * 8; } }
    const size_t kstep = (size_t)(BK * 2);
    const size_t hstep = (size_t)HALF * K * EB;
    const size_t tstep = 2 * hstep;
    const unsigned ldsw = (unsigned)wid * 1024u;
    const int sw_ = (fr >> 1) & 7; int aoffk[2], boffk[2];
#pragma unroll
    for (int k = 0; k < 2; ++k) { aoffk[k] = (wr * 64 + fr) * 128 + (((fq + 4 * k) ^ sw_) << 4); boffk[k] = (wc * 32 + fr) * 128 + (((fq + 4 * k) ^ sw_) << 4); }
    unsigned gc[2][2], gn[2][2];
#define PG8_SA(b, h) (((b) * 2 + (h)) * HTB)
#define PG8_SB(b, h) ((4 + (b) * 2 + (h)) * HTB)
#define PG8_GLDS(src, dstoff) __builtin_amdgcn_global_load_lds((const unsigned*)(src), (LAS unsigned*)(lds + (dstoff)), 16, 0, 0)
#define PG8_STAGE(bufoff, gbase, voff) do { _Pragma("unroll") for (int _i = 0; _i < 2; ++_i) PG8_GLDS((const char*)(gbase) + (voff)[_i], (bufoff) + ldsw + _i * 8192); } while (0)
#define PG8_STAGE_A(bufoff, kbase, h, usen) do { if constexpr (GATHER) { _Pragma("unroll") for (int _i = 0; _i < 2; ++_i) { const unsigned _o = (usen) ? gn[h][_i] : gc[h][_i]; PG8_GLDS((const char*)(kbase) + _o, (bufoff) + ldsw + _i * 8192); } } \
        else { PG8_STAGE(bufoff, (const char*)(kbase) + (h) * hstep, voffA); } } while (0)
#define PG8_GOFFS(g, u) do { _Pragma("unroll") for (int _h = 0; _h < 2; ++_h) _Pragma("unroll") for (int _i = 0; _i < 2; ++_i) g[_h][_i] = S.a_rowoff(u, _h * HALF + R0 + 64 * _i) + (unsigned)(C0 * 2); } while (0)
#define PG8_LDA8(dst, b, h) do { _Pragma("unroll") for (int m = 0; m < 4; ++m) { const i32x4 _lo = *(const LAS i32x4*)(lds + PG8_SA(b, h) + aoffk[0] + m * 2048), _hi = *(const LAS i32x4*)(lds + PG8_SA(b, h) + aoffk[1] + m * 2048); dst[m] = (i32x8){_lo.x, _lo.y, _lo.z, _lo.w, _hi.x, _hi.y, _hi.z, _hi.w}; } } while (0)
#define PG8_LDB8(dst, b, h) do { _Pragma("unroll") for (int n = 0; n < 2; ++n) { const i32x4 _lo = *(const LAS i32x4*)(lds + PG8_SB(b, h) + boffk[0] + n * 2048), _hi = *(const LAS i32x4*)(lds + PG8_SB(b, h) + boffk[1] + n * 2048); dst[n] = (i32x8){_lo.x, _lo.y, _lo.z, _lo.w, _hi.x, _hi.y, _hi.z, _hi.w}; } } while (0)
#define PG8_MMA8(ai, bj, At, Bt) do { __builtin_amdgcn_s_setprio(1); _Pragma("unroll") for (int m = 0; m < 4; ++m) _Pragma("unroll") for (int n = 0; n < 2; ++n) \
        asm volatile("v_mfma_scale_f32_16x16x128_f8f6f4 %0, %1, %2, %0, %3, %4 op_sel_hi:[0,0,0]" : "+v"(acc[ai][bj][m][n]) : "v"(Bt[n]), "v"(At[m]), "v"(sclw), "v"(scla)); __builtin_amdgcn_s_setprio(0); } while (0)
#define PG8_LDA(dst, b, h) do { _Pragma("unroll") for (int m = 0; m < 4; ++m) _Pragma("unroll") for (int k = 0; k < 2; ++k) dst[m][k] = *(const LAS bf16x8*)(lds + PG8_SA(b, h) + aoffk[k] + m * 2048); } while (0)
#define PG8_LDB(dst, b, h) do { _Pragma("unroll") for (int n = 0; n < 2; ++n) _Pragma("unroll") for (int k = 0; k < 2; ++k) dst[n][k] = *(const LAS bf16x8*)(lds + PG8_SB(b, h) + boffk[k] + n * 2048); } while (0)
#define PG8_MMA(ai, bj, At, Bt) do { __builtin_amdgcn_s_setprio(1); _Pragma("unroll") for (int m = 0; m < 4; ++m) _Pragma("unroll") for (int n = 0; n < 2; ++n) _Pragma("unroll") for (int k = 0; k < 2; ++k) \
        acc[ai][bj][m][n] = __builtin_amdgcn_mfma_f32_16x16x32_bf16(Bt[n][k], At[m][k], acc[ai][bj][m][n], 0, 0, 0); __builtin_amdgcn_s_setprio(0); } while (0)
#define PG8_WAIT_V(n) asm volatile("s_waitcnt vmcnt(" #n ")" ::: "memory")
#define PG8_WAIT_L(n) asm volatile("s_waitcnt lgkmcnt(" #n ")" ::: "memory")
#define PG8_BAR __builtin_amdgcn_s_barrier()
#define PG8_SCHED __builtin_amdgcn_sched_barrier(0)
    constexpr int ROWS_OFF = STAGE_BYTES + 6144;
    constexpr int PRE_OFF = STAGE_BYTES + 4096;
    Unit cur, nxt; int ui = 0;
    if constexpr (Sched::LAZY) { S.prefetch(0); asm volatile("s_waitcnt vmcnt(0) lgkmcnt(0)" ::: "memory"); __builtin_amdgcn_s_barrier(); asm volatile("" ::: "memory"); }
    if (!S.next(0, cur)) return;
    f32x4 acc[2][2][4][2];
#pragma unroll
    for (int a = 0; a < 2; ++a)
#pragma unroll
        for (int b = 0; b < 2; ++b)
#pragma unroll
            for (int m = 0; m < 4; ++m)
#pragma unroll
                for (int n = 0; n < 2; ++n) acc[a][b][m][n] = (f32x4){0.f, 0.f, 0.f, 0.f};
    bf16x8 At[4][2], B0[2][2], B1[2][2]; i32x8 At8[4], B08[2], B18[2];
    int sclw = 0x7a7a7a7a, scla = scla_; asm volatile("" : "+v"(sclw), "+v"(scla));
    const char* cA = GATHER ? (const char*)Aptr : (const char*)Aptr + (size_t)cur.pm * tstep;
    const char* cB = (const char*)Btptr + ((size_t)cur.e * NBT + cur.pn) * tstep;
    if constexpr (GATHER) { PG8_GOFFS(gc, cur); PG8_GOFFS(gn, cur); }
    if constexpr (Epi::HAS_PRE) { if (wid == 0) E.pre(cur, lds + PRE_OFF, lane); }
    static_assert(SP2, "only the SP2 loop is kept here");
    PG8_STAGE(PG8_SB(0, 0), cB, voffB); PG8_STAGE(PG8_SB(0, 1), cB + hstep, voffB); PG8_STAGE_A(PG8_SA(0, 0), cA, 0, false); PG8_STAGE_A(PG8_SA(0, 1), cA, 1, false);
    if (wr == 1) PG8_BAR;
    PG8_WAIT_V(2); PG8_BAR;
    PG8_STAGE(PG8_SB(1, 0), cB + kstep, voffB); PG8_STAGE_A(PG8_SA(1, 0), cA + kstep, 0, false); PG8_STAGE(PG8_SB(1, 1), cB + hstep + kstep, voffB);
    PG8_WAIT_V(6); PG8_BAR;
    if constexpr (Epi::HAS_PRE) E.init(acc, (const LAS float*)(lds + PRE_OFF), wc, fq);
    for (;;) {
        bool has_next = false; const char* nA = cA; const char* nB = cB;
        if constexpr (Epi::HAS_ROWS) E.rows(cur, lds + ROWS_OFF + (ui & 1) * 2048, wid, lane);
        if constexpr (Sched::LAZY) { S.prefetch(ui + 1); }
        else { has_next = S.next(ui + 1, nxt);
            nA = GATHER ? (const char*)Aptr : (has_next ? (const char*)Aptr + (size_t)nxt.pm * tstep : cA);
            nB = has_next ? (const char*)Btptr + ((size_t)nxt.e * NBT + nxt.pn) * tstep : cB;
            if constexpr (GATHER) { if (has_next) { PG8_GOFFS(gn, nxt); } }
            if constexpr (Epi::HAS_PRE) { if (has_next && wid == 0) E.pre(nxt, lds + PRE_OFF + ((ui + 1) & 1) * 1024, lane); } }
        for (int t = 0; t < nt; t += 2) {
            const bool last = (t == nt - 2);
            if constexpr (Sched::LAZY) { if (last) { has_next = S.next(ui + 1, nxt);
                nA = has_next ? (const char*)Aptr + (size_t)nxt.pm * tstep : cA; nB = has_next ? (const char*)Btptr + ((size_t)nxt.e * NBT + nxt.pn) * tstep : cB; } }
            const char* a1 = cA + (size_t)(t + 1) * kstep;
            const char* a2 = last ? nA : cA + (size_t)(t + 2) * kstep; const char* b2 = last ? nB : cB + (size_t)(t + 2) * kstep;
            const char* a3 = a2 + kstep; const char* b3 = b2 + kstep;
            const bool usen = last && has_next;
#define XLDB0(b, h) do { if constexpr (F8) { PG8_LDB8(B08, b, h); } else { PG8_LDB(B0, b, h); } } while (0)
#define XLDB1(b, h) do { if constexpr (F8) { PG8_LDB8(B18, b, h); } else { PG8_LDB(B1, b, h); } } while (0)
#define XLDA(b, h) do { if constexpr (F8) { PG8_LDA8(At8, b, h); } else { PG8_LDA(At, b, h); } } while (0)
#define XMMA0(ai) do { if constexpr (F8) { PG8_MMA8(ai, 0, At8, B08); } else { PG8_MMA(ai, 0, At, B0); } } while (0)
#define XMMA1(ai) do { if constexpr (F8) { PG8_MMA8(ai, 1, At8, B18); } else { PG8_MMA(ai, 1, At, B1); } } while (0)
            XLDB0(0, 0); XLDB1(0, 1); PG8_SCHED; XLDA(0, 0); PG8_STAGE_A(PG8_SA(1, 1), a1, 1, false);
            PG8_WAIT_V(8); PG8_WAIT_L(0); PG8_BAR; XMMA0(0); XMMA1(0); PG8_BAR; PG8_SCHED;
            XLDA(0, 1); PG8_STAGE(PG8_SB(0, 0), b2, voffB); PG8_STAGE(PG8_SB(0, 1), b2 + hstep, voffB); PG8_STAGE_A(PG8_SA(0, 0), a2, 0, usen);
            PG8_WAIT_V(8); PG8_WAIT_L(0); PG8_BAR; XMMA0(1); XMMA1(1); PG8_BAR; PG8_SCHED;
            XLDB0(1, 0); XLDB1(1, 1); PG8_SCHED; XLDA(1, 0); PG8_STAGE_A(PG8_SA(0, 1), a2, 1, usen);
            PG8_WAIT_V(8); PG8_WAIT_L(0); PG8_BAR; XMMA0(0); XMMA1(0); PG8_BAR; PG8_SCHED;
            XLDA(1, 1); PG8_STAGE(PG8_SB(1, 0), b3, voffB); PG8_STAGE(PG8_SB(1, 1), b3 + hstep, voffB); PG8_STAGE_A(PG8_SA(1, 0), a3, 0, usen);
            PG8_WAIT_V(8); PG8_WAIT_L(0); PG8_BAR; XMMA0(1); XMMA1(1); PG8_BAR; PG8_SCHED;
#undef XLDB0
#undef XLDB1
#undef XLDA
#undef XMMA0
#undef XMMA1
        }
        if constexpr (ALIGN_EPI) { if (wr == 0) PG8_BAR; }
        if constexpr (F8) asm volatile("s_nop 15\n\ts_nop 7" ::: "memory");
        if constexpr (Epi::HAS_ROWS) E(acc, cur, wr, wc, fr, fq, lds + ROWS_OFF + (ui & 1) * 2048); else E(acc, cur, wr, wc, fr, fq);
        if (!has_next) break;
        if constexpr (Epi::HAS_PRE) E.init(acc, (const LAS float*)(lds + PRE_OFF + ((ui + 1) & 1) * 1024), wc, fq);
        else if (!Epi::keeps(cur)) {
#pragma unroll
        for (int a = 0; a < 2; ++a)
#pragma unroll
            for (int b = 0; b < 2; ++b)
#pragma unroll
                for (int m = 0; m < 4; ++m)
#pragma unroll
                    for (int n = 0; n < 2; ++n) acc[a][b][m][n] = (f32x4){0.f, 0.f, 0.f, 0.f};
        }
        cur = nxt; cA = nA; cB = nB; ++ui;
        if constexpr (GATHER) {
#pragma unroll
            for (int h = 0; h < 2; ++h)
#pragma unroll
                for (int i = 0; i < 2; ++i) gc[h][i] = gn[h][i];
        }
        if constexpr (ALIGN_EPI) { if (wr == 1) PG8_BAR; }
    }
    PG8_WAIT_V(0);
    if constexpr (!ALIGN_EPI) { if (wr == 0) PG8_BAR; }
    PG8_BAR;
#undef PG8_SA
#undef PG8_SB
#undef PG8_GLDS
#undef PG8_STAGE
#undef PG8_STAGE_A
#undef PG8_GOFFS
#undef PG8_LDA
#undef PG8_LDA8
#undef PG8_LDB8
#undef PG8_MMA8
#undef PG8_LDB
#undef PG8_MMA
#undef PG8_WAIT_V
#undef PG8_WAIT_L
#undef PG8_BAR
#undef PG8_SCHED
}
}

__device__ __forceinline__ u32x4 swap16_pair(u32x2 x, u32x2 y) {
    const auto lo = __builtin_amdgcn_permlane16_swap(x.x, y.x, false, false);
    const auto hi = __builtin_amdgcn_permlane16_swap(x.y, y.y, false, false);
    u32x4 r; r.x = lo[0]; r.y = hi[0]; r.z = lo[1]; r.w = hi[1]; return r;
}

typedef f32x4 AccT[2][2][4][2];

struct EpiInProj {
    static constexpr bool PERM = true, HAS_PRE = false, HAS_ROWS = true;
    __device__ __forceinline__ static bool keeps(const pg8::Unit&) { return false; }
    const float* rstd; const float* qa_g; const float* ka_g; const unsigned* csA; const unsigned* csB;
    unsigned char *QA; bf16_t *KA, *VA; unsigned char *QB; bf16_t *KB, *VB; unsigned char *GA, *GB;
    __device__ __forceinline__ static void store16(bf16_t* rp, const f32x4 (&v)[2][2]) {
#pragma unroll
        for (int bj = 0; bj < 2; ++bj) { u32x4 w; w.x = pk2(v[bj][0][0], v[bj][0][1]); w.y = pk2(v[bj][0][2], v[bj][0][3]); w.z = pk2(v[bj][1][0], v[bj][1][1]); w.w = pk2(v[bj][1][2], v[bj][1][3]);
            *(u32x4*)(rp + 32 * bj) = w; }
    }
    __device__ __forceinline__ static void store_tile(bf16_t* buf, int tmode, int kvh, int row, int fq, const f32x4 (&v)[2][2]) {
        const int t = row & (SEQ - 1), bb = row >> 13, r = t & 63; char* tb = (char*)buf + ((size_t)((bb * NKVH + kvh) * (SEQ / 64) + (t >> 6))) * 8192;
#pragma unroll
        for (int bj = 0; bj < 2; ++bj) { u32x4 w; w.x = pk2(v[bj][0][0], v[bj][0][1]); w.y = pk2(v[bj][0][2], v[bj][0][3]); w.z = pk2(v[bj][1][0], v[bj][1][1]); w.w = pk2(v[bj][1][2], v[bj][1][3]);
            const int off = (tmode == 1) ? ((4 * bj + fq) * 1024 + r * 16) : ((bj * 4 + (r >> 4)) * 1024 + (r & 15) * 64 + 16 * fq);
            *(u32x4*)(tb + off) = w; }
    }
    __device__ __forceinline__ void rows(const pg8::Unit& u, LAS unsigned char* dst, int wid, int lane) const {
        if (wid == 0) __builtin_amdgcn_global_load_lds((const unsigned*)(rstd + u.pm * 256 + lane * 4), (LAS unsigned*)dst, 16, 0, 0);
    }
    __device__ __forceinline__ void operator()(const AccT& acc, const pg8::Unit& u, int wr, int wc, int fr, int fq, const LAS unsigned char* rl) const {
        const LAS float* rsl = (const LAS float*)rl + wr * 64 + fr;
        const int s = 4 * u.pn + wc;
        int kind; bf16_t* dst; int pitch; const float* gain = nullptr; const unsigned* ct = nullptr; float qs = 1.f; int tmode = 0, kvh_ = 0;
        unsigned char* qdst = nullptr;
        if (s < 8) { kind = 0; dst = nullptr; qdst = QA + s * 64; pitch = QW; gain = qa_g; ct = csA; qs = C2 * 8.0f; }
        else if (s < 10) { kind = 0; dst = KA; pitch = KVW; gain = ka_g; ct = csA; tmode = 1; kvh_ = s - 8; }
        else if (s < 12) { kind = 2; dst = VA; pitch = KVW; tmode = 2; kvh_ = s - 10; }
        else if (s < 20) { kind = 1; dst = nullptr; qdst = QB + (s - 12) * 64; pitch = QW; ct = csB; qs = C2 * 8.0f; }
        else if (s < 22) { kind = 1; dst = KB; pitch = KVW; ct = csB; tmode = 1; kvh_ = s - 20; }
        else if (s < 24) { kind = 2; dst = VB; pitch = KVW; tmode = 2; kvh_ = s - 22; }
        else { kind = 3; dst = nullptr; pitch = DM; }
        unsigned char* gdst = (s < 40) ? GA + (s - 24) * 64 : GB + (s - 40) * 64;
        const int row0 = u.pm * 256 + wr * 64 + fr;
        if (kind >= 2) {
#pragma unroll
            for (int ai = 0; ai < 2; ++ai) {
                float rs[2][4];
#pragma unroll
                for (int m = 0; m < 4; ++m) rs[ai][m] = rsl[ai * 128 + m * 16];
#pragma unroll
                for (int m = 0; m < 4; ++m) {
                    const int row = row0 + ai * 128 + m * 16; f32x4 v[2][2];
#pragma unroll
                    for (int bj = 0; bj < 2; ++bj)
#pragma unroll
                        for (int n = 0; n < 2; ++n) {
                            if (kind == 3) { const float rsn = rs[ai][m] * -1.4426950408889634f;
#pragma unroll
                                for (int j = 0; j < 4; ++j) v[bj][n][j] = __builtin_amdgcn_rcpf(1.0f + __builtin_amdgcn_exp2f(acc[ai][bj][m][n][j] * rsn)); }
                            else v[bj][n] = acc[ai][bj][m][n] * rs[ai][m]; }
                    if (kind == 3) {
                        u32x2 w[2];
#pragma unroll
                        for (int bj = 0; bj < 2; ++bj) { w[bj].x = pk4_fp8(v[bj][0][0], v[bj][0][1], v[bj][0][2], v[bj][0][3]); w[bj].y = pk4_fp8(v[bj][1][0], v[bj][1][1], v[bj][1][2], v[bj][1][3]); }
                        const u32x4 q = swap16_pair(w[0], w[1]);
                        *(u32x4*)(gdst + (size_t)row * DM + (fq & 1) * 32 + 16 * (fq >> 1)) = q;
                    }
                    else if (tmode) store_tile(dst, tmode, kvh_, row, fq, v); else store16(dst + (size_t)row * pitch + 8 * fq, v);
                }
            }
            return;
        }
        f32x4 gv[2][2];
        if (kind == 0) {
#pragma unroll
            for (int bj = 0; bj < 2; ++bj)
#pragma unroll
                for (int n = 0; n < 2; ++n) gv[bj][n] = *(const f32x4*)(gain + 32 * bj + 8 * fq + 4 * n);
        }
#pragma unroll
        for (int hm = 0; hm < 4; ++hm) {
            const int ai = hm >> 1, m0 = (hm & 1) * 2;
            float rs[2][4]; rs[ai][m0] = rsl[ai * 128 + m0 * 16]; rs[ai][m0 + 1] = rsl[ai * 128 + (m0 + 1) * 16];
            u32x4 tb[2][2];
#pragma unroll
            for (int mm = 0; mm < 2; ++mm) { const int t = (row0 + ai * 128 + (m0 + mm) * 16) & (SEQ - 1);
#pragma unroll
                for (int n = 0; n < 2; ++n) tb[mm][n] = *(const u32x4*)(ct + t * 32 + 8 * fq + 4 * n); }
#pragma unroll
            for (int mm = 0; mm < 2; ++mm) {
                const int m = m0 + mm; const int row = row0 + ai * 128 + m * 16; f32x4 v[2][2];
#pragma unroll
                for (int bj = 0; bj < 2; ++bj)
#pragma unroll
                    for (int n = 0; n < 2; ++n) v[bj][n] = acc[ai][bj][m][n] * (kind == 1 ? rs[ai][m] * qs : rs[ai][m]);
                if (kind == 0) {
                    float ss = 0.f;
#pragma unroll
                    for (int bj = 0; bj < 2; ++bj)
#pragma unroll
                        for (int n = 0; n < 2; ++n) { const f32x4 x = v[bj][n]; ss += (x[0] * x[0] + x[1] * x[1]) + (x[2] * x[2] + x[3] * x[3]); }
                    ss = swap32_sum(swap16_sum(ss));
                    const float r = rsqrtf(ss * (1.0f / 64.0f) + EPS) * qs;
#pragma unroll
                    for (int bj = 0; bj < 2; ++bj)
#pragma unroll
                        for (int n = 0; n < 2; ++n) v[bj][n] = v[bj][n] * r * gv[bj][n];
                }
#pragma unroll
                for (int n = 0; n < 2; ++n) { const f32x4 x1 = v[0][n], x2 = v[1][n]; const u32x4 w = tb[mm][n];
                    const f32x4 c_ = {bflo(w.x), bflo(w.y), bflo(w.z), bflo(w.w)}, s_ = {bfhi(w.x), bfhi(w.y), bfhi(w.z), bfhi(w.w)};
                    v[0][n] = x1 * c_ - x2 * s_; v[1][n] = x2 * c_ + x1 * s_; }
                if (tmode) store_tile(dst, tmode, kvh_, row, fq, v);
                else {
                    u32x2 w[2];
#pragma unroll
                    for (int bj = 0; bj < 2; ++bj) { w[bj].x = pk4_fp8(v[bj][0][0], v[bj][0][1], v[bj][0][2], v[bj][0][3]); w[bj].y = pk4_fp8(v[bj][1][0], v[bj][1][1], v[bj][1][2], v[bj][1][3]); }
                    const u32x4 q = swap16_pair(w[0], w[1]);
                    *(u32x4*)(qdst + (size_t)row * QW + (fq & 1) * 32 + 16 * (fq >> 1)) = q;
                }
            }
        }
    }
};

template <bool FIRST> struct EpiGate {
    static constexpr bool PERM = true, HAS_PRE = false, HAS_ROWS = false;
    __device__ __forceinline__ static bool keeps(const pg8::Unit&) { return false; }
    const bf16_t* G; bf16_t* O;
    __device__ __forceinline__ void operator()(const AccT& acc, const pg8::Unit& u, int wr, int wc, int fr, int fq) const {
#pragma unroll
        for (int ai = 0; ai < 2; ++ai)
#pragma unroll
            for (int m = 0; m < 4; ++m) {
                const size_t row = (size_t)(u.pm * 256 + ai * 128 + wr * 64 + m * 16 + fr);
#pragma unroll
                for (int bj = 0; bj < 2; ++bj) {
                    const size_t off = row * DM + u.pn * 256 + bj * 128 + wc * 32 + 8 * fq;
                    const u32x4 g = *(const u32x4*)(G + off);
                    f32x4 v0 = acc[ai][bj][m][0], v1 = acc[ai][bj][m][1];
                    v0[0] *= bflo(g.x); v0[1] *= bfhi(g.x); v0[2] *= bflo(g.y); v0[3] *= bfhi(g.y);
                    v1[0] *= bflo(g.z); v1[1] *= bfhi(g.z); v1[2] *= bflo(g.w); v1[3] *= bfhi(g.w);
                    if (!FIRST) { const u32x4 p = *(const u32x4*)(O + off);
                        v0[0] += bflo(p.x); v0[1] += bfhi(p.x); v0[2] += bflo(p.y); v0[3] += bfhi(p.y);
                        v1[0] += bflo(p.z); v1[1] += bfhi(p.z); v1[2] += bflo(p.w); v1[3] += bfhi(p.w); }
                    u32x4 w; w.x = pk2(v0[0], v0[1]); w.y = pk2(v0[2], v0[3]); w.z = pk2(v1[0], v1[1]); w.w = pk2(v1[2], v1[3]);
                    *(u32x4*)(O + off) = w;
                }
            }
    }
};

struct EpiGateFused {
    static constexpr bool PERM = true, HAS_PRE = false, HAS_ROWS = false;
    const unsigned char* GA; const unsigned char* GB; unsigned char* O;
    __device__ __forceinline__ static bool keeps(const pg8::Unit& u) { return u.e == 0; }
    __device__ __forceinline__ void operator()(AccT& acc, const pg8::Unit& u, int wr, int wc, int fr, int fq) const {
        const size_t base = (size_t)(u.pml * 256 + wr * 64 + fr) * DM + u.pn * 256 + wc * 32 + 8 * fq;
        if (u.e == 0) {
#pragma unroll
            for (int ai = 0; ai < 2; ++ai)
#pragma unroll
                for (int m = 0; m < 4; ++m)
#pragma unroll
                    for (int bj = 0; bj < 2; ++bj) {
                        const size_t off = base + (size_t)(ai * 128 + m * 16) * DM + bj * 128;
                        const u32x2 a = *(const u32x2*)(GA + off), b = *(const u32x2*)(GB + off);
                        const f32x2 a0 = __builtin_amdgcn_cvt_pk_f32_fp8((int)a.x, false), a1 = __builtin_amdgcn_cvt_pk_f32_fp8((int)a.x, true), a2 = __builtin_amdgcn_cvt_pk_f32_fp8((int)a.y, false), a3 = __builtin_amdgcn_cvt_pk_f32_fp8((int)a.y, true);
                        const f32x2 b0 = __builtin_amdgcn_cvt_pk_f32_fp8((int)b.x, false), b1 = __builtin_amdgcn_cvt_pk_f32_fp8((int)b.x, true), b2 = __builtin_amdgcn_cvt_pk_f32_fp8((int)b.y, false), b3 = __builtin_amdgcn_cvt_pk_f32_fp8((int)b.y, true);
                        f32x4& v0 = acc[ai][bj][m][0]; f32x4& v1 = acc[ai][bj][m][1];
                        v0[0] *= b0.x * __builtin_amdgcn_rcpf(fmaxf(a0.x, 1e-30f)); v0[1] *= b0.y * __builtin_amdgcn_rcpf(fmaxf(a0.y, 1e-30f)); v0[2] *= b1.x * __builtin_amdgcn_rcpf(fmaxf(a1.x, 1e-30f)); v0[3] *= b1.y * __builtin_amdgcn_rcpf(fmaxf(a1.y, 1e-30f));
                        v1[0] *= b2.x * __builtin_amdgcn_rcpf(fmaxf(a2.x, 1e-30f)); v1[1] *= b2.y * __builtin_amdgcn_rcpf(fmaxf(a2.y, 1e-30f)); v1[2] *= b3.x * __builtin_amdgcn_rcpf(fmaxf(a3.x, 1e-30f)); v1[3] *= b3.y * __builtin_amdgcn_rcpf(fmaxf(a3.y, 1e-30f));
                    }
        } else {
#pragma unroll
            for (int ai = 0; ai < 2; ++ai)
#pragma unroll
                for (int m = 0; m < 4; ++m)
                {
                    u32x2 w[2];
#pragma unroll
                    for (int bj = 0; bj < 2; ++bj) {
                        const size_t off = base + (size_t)(ai * 128 + m * 16) * DM + bj * 128;
                        const u32x2 a = *(const u32x2*)(GA + off);
                        const f32x2 a0 = __builtin_amdgcn_cvt_pk_f32_fp8((int)a.x, false), a1 = __builtin_amdgcn_cvt_pk_f32_fp8((int)a.x, true), a2 = __builtin_amdgcn_cvt_pk_f32_fp8((int)a.y, false), a3 = __builtin_amdgcn_cvt_pk_f32_fp8((int)a.y, true);
                        const f32x4 v0 = acc[ai][bj][m][0] * 32.0f, v1 = acc[ai][bj][m][1] * 32.0f;
                        w[bj].x = pk4_fp8(v0[0] * a0.x, v0[1] * a0.y, v0[2] * a1.x, v0[3] * a1.y); w[bj].y = pk4_fp8(v1[0] * a2.x, v1[1] * a2.y, v1[2] * a3.x, v1[3] * a3.y);
                    }
                    const u32x4 q = swap16_pair(w[0], w[1]);
                    *(u32x4*)(O + (size_t)(u.pml * 256 + wr * 64 + fr + ai * 128 + m * 16) * DM + u.pn * 256 + (fq & 1) * 128 + wc * 32 + 16 * (fq >> 1)) = q;
                }
        }
    }
};

struct EpiResid {
    static constexpr bool PERM = true, HAS_PRE = false, HAS_ROWS = false;
    __device__ __forceinline__ static bool keeps(const pg8::Unit&) { return false; }
    const float* X; bf16_t* O;
    __device__ __forceinline__ void operator()(const AccT& acc, const pg8::Unit& u, int wr, int wc, int fr, int fq) const {
#pragma unroll
        for (int ai = 0; ai < 2; ++ai)
#pragma unroll
            for (int m = 0; m < 4; ++m) {
                const size_t row = (size_t)(u.pm * 256 + ai * 128 + wr * 64 + m * 16 + fr);
#pragma unroll
                for (int bj = 0; bj < 2; ++bj) {
                    const size_t off = row * DM + u.pn * 256 + bj * 128 + wc * 32 + 8 * fq;
                    const f32x4 v0 = __builtin_nontemporal_load((const f32x4*)(X + off)) + acc[ai][bj][m][0], v1 = __builtin_nontemporal_load((const f32x4*)(X + off + 4)) + acc[ai][bj][m][1];
                    u32x4 w; w.x = pk2(v0[0], v0[1]); w.y = pk2(v0[2], v0[3]); w.z = pk2(v1[0], v1[1]); w.w = pk2(v1[2], v1[3]);
                    *(u32x4*)(O + off) = w;
                }
            }
    }
};

struct EpiSwiglu {
    static constexpr bool PERM = true, HAS_PRE = true, HAS_ROWS = false;
    __device__ __forceinline__ static bool keeps(const pg8::Unit&) { return false; }
    const float* bgu; unsigned char* ACT;
    __device__ __forceinline__ void pre(const pg8::Unit& u, LAS unsigned char* dst, int lane) const {
        const float* src = bgu + (size_t)u.e * 2048 + (lane >> 5) * 1024 + u.pn * 128 + 4 * (lane & 31);
        __builtin_amdgcn_global_load_lds((const unsigned*)src, (LAS unsigned*)dst, 16, 0, 0);
    }
    __device__ __forceinline__ void init(AccT& acc, const LAS float* pb, int wc, int fq) const {
        const int cl = wc * 32 + 8 * fq;
#pragma unroll
        for (int n = 0; n < 2; ++n) { const f32x4 bg = *(const LAS f32x4*)(pb + cl + 4 * n) * SWI_C, bu = (*(const LAS f32x4*)(pb + 128 + cl + 4 * n) + 1.0f) * (1.0f / SWI_C);
#pragma unroll
            for (int ai = 0; ai < 2; ++ai)
#pragma unroll
                for (int m = 0; m < 4; ++m) { acc[ai][0][m][n] = bg; acc[ai][1][m][n] = bu; } }
    }
    __device__ __forceinline__ void operator()(const AccT& acc, const pg8::Unit& u, int wr, int wc, int fr, int fq) const {
#pragma unroll
        for (int ai = 0; ai < 2; ++ai)
#pragma unroll
            for (int mp = 0; mp < 2; ++mp) {
                u32x2 w[2];
#pragma unroll
                for (int mm = 0; mm < 2; ++mm) { const int m = 2 * mp + mm; float a[8];
#pragma unroll
                    for (int n = 0; n < 2; ++n)
#pragma unroll
                        for (int j = 0; j < 4; ++j) {
                            const float g = fmaxf(acc[ai][0][m][n][j], 7.0f * SWI_C), up1 = __builtin_amdgcn_fmed3f(acc[ai][1][m][n][j], 8.0f / SWI_C, -6.0f / SWI_C);
                            a[4 * n + j] = up1 * (g * __builtin_amdgcn_rcpf(1.0f + __builtin_amdgcn_exp2f(g)));
                        }
                    w[mm].x = pk4_fp8(a[0], a[1], a[2], a[3]); w[mm].y = pk4_fp8(a[4], a[5], a[6], a[7]); }
                const u32x4 q = swap16_pair(w[0], w[1]);
                const size_t row = (size_t)(u.pm * 256 + ai * 128 + wr * 64 + (2 * mp + (fq & 1)) * 16 + fr);
                *(u32x4*)(ACT + row * DFF + u.pn * 128 + wc * 32 + 16 * (fq >> 1)) = q;
            }
    }
};

struct EpiDown {
    static constexpr bool PERM = true, HAS_PRE = true, HAS_ROWS = true;
    __device__ __forceinline__ static bool keeps(const pg8::Unit&) { return false; }
    const float* bd; const u32x2* list2; const LAS int* cnt; unsigned char* Y;
    __device__ __forceinline__ void pre(const pg8::Unit& u, LAS unsigned char* dst, int lane) const {
        const float* src = bd + (size_t)u.e * DM + u.pn * 256 + 4 * lane;
        __builtin_amdgcn_global_load_lds((const unsigned*)src, (LAS unsigned*)dst, 16, 0, 0);
    }
    __device__ __forceinline__ void init(AccT& acc, const LAS float* pb, int wc, int fq) const {
        const int cl = wc * 32 + 8 * fq;
#pragma unroll
        for (int bj = 0; bj < 2; ++bj)
#pragma unroll
            for (int n = 0; n < 2; ++n) { const f32x4 bv = *(const LAS f32x4*)(pb + bj * 128 + cl + 4 * n);
#pragma unroll
                for (int ai = 0; ai < 2; ++ai)
#pragma unroll
                    for (int m = 0; m < 4; ++m) acc[ai][bj][m][n] = bv; }
    }
    __device__ __forceinline__ void rows(const pg8::Unit& u, LAS unsigned char* dst, int wid, int lane) const {
        if (wid < 2) __builtin_amdgcn_global_load_lds((const unsigned*)(list2 + (size_t)u.e * MTOK + u.pml * 256 + wid * 128 + lane * 2), (LAS unsigned*)(dst + wid * 1024), 16, 0, 0);
    }
    __device__ __forceinline__ void operator()(const AccT& acc, const pg8::Unit& u, int wr, int wc, int fr, int fq, const LAS unsigned char* rl) const {
        const int ne = cnt[u.e];
        u32x2 sg[2][4];
#pragma unroll
        for (int ai = 0; ai < 2; ++ai)
#pragma unroll
            for (int m = 0; m < 4; ++m) { const int rloc = ai * 128 + wr * 64 + m * 16 + fr;
                sg[ai][m] = *(const LAS u32x2*)(rl + rloc * 8); if (u.pml * 256 + rloc >= ne) sg[ai][m].x = 0xffffffffu; }
#pragma unroll
        for (int ai = 0; ai < 2; ++ai)
#pragma unroll
            for (int m = 0; m < 4; ++m) {
                const float gg = __uint_as_float(sg[ai][m].y) * 4.0f;
                u32x2 w[2];
#pragma unroll
                for (int bj = 0; bj < 2; ++bj) {
                    const f32x4 v0 = acc[ai][bj][m][0] * gg, v1 = acc[ai][bj][m][1] * gg;
                    w[bj].x = pk4_fp8(v0[0], v0[1], v0[2], v0[3]); w[bj].y = pk4_fp8(v1[0], v1[1], v1[2], v1[3]); }
                const u32x4 q = swap16_pair(w[0], w[1]);
                if (sg[ai][m].x != 0xffffffffu)
                    *(u32x4*)(Y + (size_t)sg[ai][m].x * DM + u.pn * 256 + (fq & 1) * 128 + wc * 32 + 16 * (fq >> 1)) = q;
            }
    }
};

namespace attn_body {
using bf16 = __hip_bfloat16;
using s16x4 = __attribute__((ext_vector_type(4))) short;
using f32x16 = __attribute__((ext_vector_type(16))) float;
constexpr int D = 64, QP = QW, KP = KVW;
constexpr int NW = 8, QBLK = 32, QB = QBLK * NW, KVBLK = 64;
__device__ __forceinline__ int crow(int r, int hi) { return (r & 3) + 8 * (r >> 2) + 4 * hi; }
#define SBAR() __builtin_amdgcn_sched_barrier(0)
constexpr int NSLOT = 3, SLOTB = 8192;
constexpr int LDS_K = 0, LDS_V = NSLOT * SLOTB, LDS_WS = 2 * NSLOT * SLOTB, LDS_OST = LDS_WS + NW * 64 * 4, LDS_BYTES = LDS_OST + NW * 4096;
__device__ __forceinline__ void glds16(const void* gsrc, unsigned lds_dst) { unsigned keep;
    asm volatile("s_mov_b32 %0, m0\n\ts_mov_b32 m0, %2\n\ts_nop 0\n\tglobal_load_lds_dwordx4 %1, off\n\ts_mov_b32 m0, %0" : "=&s"(keep) : "v"(gsrc), "s"(lds_dst) : "memory"); }
__device__ __forceinline__ float max3f(float a, float b, float c) { float r; asm("v_max3_f32 %0, %1, %2, %3" : "=v"(r) : "v"(a), "v"(b), "v"(c)); return r; }
__device__ __forceinline__ float max2f(float a, float b) { float r; asm("v_max_f32_e32 %0, %1, %2" : "=v"(r) : "v"(a), "v"(b)); return r; }
__device__ __forceinline__ float fadd_s(float a, float b) { float r; asm("v_add_f32_e32 %0, %1, %2" : "=v"(r) : "v"(a), "v"(b)); return r; }
__device__ __forceinline__ float fsub_s(float a, float b) { float r; asm("v_sub_f32_e32 %0, %1, %2" : "=v"(r) : "v"(a), "v"(b)); return r; }
typedef float f32x2_t __attribute__((ext_vector_type(2))); typedef __bf16 bf16x2_t __attribute__((ext_vector_type(2)));
__device__ __forceinline__ unsigned cvtpk_s(float lo, float hi) { f32x2_t v = {lo, hi}; bf16x2_t b = __builtin_convertvector(v, bf16x2_t); return __builtin_bit_cast(unsigned, b); }
#define WAIT_BAR(N) asm volatile("s_waitcnt vmcnt(" #N ") lgkmcnt(0)\n\ts_barrier" ::: "memory")

__device__ __forceinline__ void qkt(f32x16& p0, f32x16& p1, const char* Kslot, const bf16x8* qr, const f32x16& negm, int r32, int hi) {
    const char* kb = Kslot + hi * 1024 + r32 * 16;
#pragma unroll
    for (int d0 = 0; d0 < 4; ++d0) {
        const bf16x8 b0 = *reinterpret_cast<const bf16x8*>(kb + d0 * 2048);
        const bf16x8 b1 = *reinterpret_cast<const bf16x8*>(kb + d0 * 2048 + 512);
        if (d0 == 0) { p0 = __builtin_amdgcn_mfma_f32_32x32x16_bf16(b0, qr[0], negm, 0, 0, 0); p1 = __builtin_amdgcn_mfma_f32_32x32x16_bf16(b1, qr[0], negm, 0, 0, 0); }
        else { p0 = __builtin_amdgcn_mfma_f32_32x32x16_bf16(b0, qr[d0], p0, 0, 0, 0); p1 = __builtin_amdgcn_mfma_f32_32x32x16_bf16(b1, qr[d0], p1, 0, 0, 0); } }
}
typedef __attribute__((address_space(3))) const char* lds_cptr;
typedef short v4i16_t __attribute__((ext_vector_type(4)));
__device__ __forceinline__ void kload8(bf16x8* kf, lds_cptr kp) {
    kf[0] = *(const LAS bf16x8*)(kp);        kf[1] = *(const LAS bf16x8*)(kp + 512);
    kf[2] = *(const LAS bf16x8*)(kp + 2048); kf[3] = *(const LAS bf16x8*)(kp + 2560);
    kf[4] = *(const LAS bf16x8*)(kp + 4096); kf[5] = *(const LAS bf16x8*)(kp + 4608);
    kf[6] = *(const LAS bf16x8*)(kp + 6144); kf[7] = *(const LAS bf16x8*)(kp + 6656);
}
__device__ __forceinline__ void kload2(bf16x8* kf, lds_cptr kp, int j) { kf[2 * j] = *(const LAS bf16x8*)(kp + j * 2048); kf[2 * j + 1] = *(const LAS bf16x8*)(kp + j * 2048 + 512); }
__device__ __forceinline__ s16x4 vtr(lds_cptr p) { return __builtin_bit_cast(s16x4, __builtin_amdgcn_ds_read_tr16_b64_v4i16((LAS v4i16_t*)p)); }
__device__ __forceinline__ float rowmax(const f32x16& p0, const f32x16& p1) {
    float a = max3f(p0[0], p0[1], p1[0]), b = max3f(p0[2], p0[3], p1[1]); a = max3f(a, p1[2], p1[3]);
#pragma unroll
    for (int r = 4; r < 16; r += 4) { a = max3f(a, p0[r], p0[r + 1]); b = max3f(b, p0[r + 2], p0[r + 3]); a = max3f(a, p1[r], p1[r + 1]); b = max3f(b, p1[r + 2], p1[r + 3]); }
    const float m = max2f(a, b);
    auto rr = __builtin_amdgcn_permlane32_swap(__float_as_uint(m), __float_as_uint(m), false, false);
    return max2f(__uint_as_float(rr[0]), __uint_as_float(rr[1]));
}
__device__ __forceinline__ void pv(f32x16* o, int vb, bf16x8 pa0, bf16x8 pa1, bf16x8 pa2, bf16x8 pa3) {
#pragma unroll
    for (int d0 = 0; d0 < 2; ++d0) { s16x4 lo[4], hi[4];
#pragma unroll
        for (int ks = 0; ks < 4; ++ks) {
            asm volatile("ds_read_b64_tr_b16 %0,%1 offset:%c2" : "=&v"(lo[ks]) : "v"(vb), "i"(d0 * 4096 + ks * 1024) : "memory");
            asm volatile("ds_read_b64_tr_b16 %0,%1 offset:%c2" : "=&v"(hi[ks]) : "v"(vb), "i"(d0 * 4096 + ks * 1024 + 512) : "memory"); }
        asm volatile("s_waitcnt lgkmcnt(0)" ::: "memory"); SBAR();
#define PK(k) (bf16x8){lo[k][0], lo[k][1], lo[k][2], lo[k][3], hi[k][0], hi[k][1], hi[k][2], hi[k][3]}
        o[d0] = __builtin_amdgcn_mfma_f32_32x32x16_bf16(pa0, PK(0), o[d0], 0, 0, 0);
        o[d0] = __builtin_amdgcn_mfma_f32_32x32x16_bf16(pa1, PK(1), o[d0], 0, 0, 0);
        o[d0] = __builtin_amdgcn_mfma_f32_32x32x16_bf16(pa2, PK(2), o[d0], 0, 0, 0);
        o[d0] = __builtin_amdgcn_mfma_f32_32x32x16_bf16(pa3, PK(3), o[d0], 0, 0, 0);
#undef PK
    }
}
__device__ __forceinline__ void wmask(f32x16& p0, f32x16& p1, int base) {
    const float NEG = -INFINITY;
#pragma unroll
    for (int r = 0; r < 16; ++r) { const int d0 = base + (r & 3) + 8 * (r >> 2), d1 = d0 + 32;
        if (d0 > 128 || d0 < -128) p0[r] = NEG; if (d1 > 128 || d1 < -128) p1[r] = NEG; }
}

template <int MODE, int THRL, bool NOMAX = false> __device__ __forceinline__ void attn_unit(int b, int h, int qb, const unsigned char* Q, const bf16* __restrict__ K, const bf16* __restrict__ V, unsigned char* O, char* shm, int wave_, float sink2, float mref = 0.f) {
    const int wid = wave_, lane = lane_fresh(), tid = wid * 64 + lane, r32 = lane & 31, hi = lane >> 5;
    const long rowbase = (long)b * SEQ; const int q0 = qb * QB; const int kvh = h >> 2;
    int kt0 = 0, NT = SEQ / KVBLK;
    if (MODE == 1) { kt0 = 4 * qb - 2; int kt1 = 4 * qb + 6; if (kt0 < 0) kt0 = 0; if (kt1 > SEQ / KVBLK) kt1 = SEQ / KVBLK; NT = kt1 - kt0; }
    const unsigned char* Qw = Q + (rowbase + q0 + wid * QBLK) * QP + h * D;
    const unsigned lds0 = (unsigned)(uintptr_t)shm;
    float* wsf = (float*)(shm + LDS_WS) + wid * 64;
    const char* ksrc = (const char*)K + ((size_t)((b * NKVH + kvh) * (SEQ / KVBLK) + kt0)) * 8192 + wid * 1024 + lane * 16;
    const char* vsrc = (const char*)V + ((size_t)((b * NKVH + kvh) * (SEQ / KVBLK) + kt0)) * 8192 + wid * 1024 + lane * 16;
    const unsigned kdst = lds0 + LDS_K + wid * 1024, vdst = lds0 + LDS_V + wid * 1024;
#define DMA_K(t, slot) glds16(ksrc + (size_t)(t) * 8192, (unsigned)__builtin_amdgcn_readfirstlane(kdst + (slot)))
#define DMA_V(t, slot) glds16(vsrc + (size_t)(t) * 8192, (unsigned)__builtin_amdgcn_readfirstlane(vdst + (slot)))
    const int vb0 = (int)(lds0 + LDS_V) + ((lane >> 4) & 1) * 32 + (lane & 3) * 8 + (4 * hi + ((lane & 15) >> 2)) * 64;
    const char* Kbase = shm + LDS_K; bf16x8 kf[8];
    const lds_cptr shm3 = (lds_cptr)shm; const lds_cptr kp0 = shm3 + LDS_K + hi * 1024 + r32 * 16; const lds_cptr vp0 = shm3 + LDS_V + ((lane >> 4) & 1) * 32 + (lane & 3) * 8 + (4 * hi + ((lane & 15) >> 2)) * 64;
    DMA_K(0, 0); DMA_V(0, 0); DMA_K(1, SLOTB);
    bf16x8 qr[4];
#pragma unroll
    for (int d0 = 0; d0 < 4; ++d0) { const u32x2 w8 = *reinterpret_cast<const u32x2*>(&Qw[(long)r32 * QP + d0 * 16 + hi * 8]);
        const f32x2_t a0 = __builtin_amdgcn_cvt_pk_f32_fp8((int)w8.x, false), a1 = __builtin_amdgcn_cvt_pk_f32_fp8((int)w8.x, true), a2 = __builtin_amdgcn_cvt_pk_f32_fp8((int)w8.y, false), a3 = __builtin_amdgcn_cvt_pk_f32_fp8((int)w8.y, true);
        const u32x4 qw = {cvtpk_s(a0.x * 0.125f, a0.y * 0.125f), cvtpk_s(a1.x * 0.125f, a1.y * 0.125f), cvtpk_s(a2.x * 0.125f, a2.y * 0.125f), cvtpk_s(a3.x * 0.125f, a3.y * 0.125f)};
        qr[d0] = __builtin_bit_cast(bf16x8, qw); }
    float mhat = 0.f, l_reg = 0.f; f32x16 o[2]; o[0] = f32x16{}; o[1] = f32x16{}; f32x16 negm = f32x16{}; asm volatile("" : "+v"(negm));
    const int mbase = kt0 * KVBLK + 4 * hi - (q0 + wid * QBLK + r32);
#define CMASK(P0, P1, t) do { if (MODE == 1) wmask(P0, P1, mbase + (t) * KVBLK); } while (0)
    bool resc = false;
#define START(P0, P1) do { const float rm = NOMAX ? mref : rowmax(P0, P1); resc = false; \
    { const float dl = (MODE == 1) ? __builtin_fmaxf(rm, -500.f) : rm; mhat = fadd_s(mhat, dl); \
      _Pragma("unroll") for (int r = 0; r < 16; ++r) { P0[r] = fsub_s(P0[r], dl); P1[r] = fsub_s(P1[r], dl); } \
      _Pragma("unroll") for (int r = 0; r < 16; ++r) negm[r] = -mhat; asm volatile("" : "+v"(negm)); } \
    _Pragma("unroll") for (int r = 0; r < 16; ++r) P0[r] = __builtin_amdgcn_exp2f(P0[r]); } while (0)
#define RESC() do { if (resc) { asm volatile("s_waitcnt lgkmcnt(0)" ::: "memory"); \
      _Pragma("unroll") for (int d_ = 0; d_ < 2; ++d_) _Pragma("unroll") for (int r = 0; r < 16; ++r) o[d_][r] *= wsf[crow(r, hi)]; } } while (0)
    f32x16 pA0, pA1, pB0, pB1;
    int sl_prev = 0, sl_cur = 0, sl_next = SLOTB;
#define ROT() do { sl_prev = sl_cur; sl_cur = sl_next; sl_next = (sl_next == (NSLOT - 1) * SLOTB) ? 0 : sl_next + SLOTB; } while (0)
    DMA_K(2, 2 * SLOTB);
    WAIT_BAR(3);
    qkt(pA0, pA1, Kbase, qr, negm, r32, hi); asm volatile("s_nop 15\n\ts_nop 7" : "+v"(pA0), "+v"(pA1)); CMASK(pA0, pA1, 0);
    START(pA0, pA1);
    _Pragma("unroll") for (int r = 0; r < 16; ++r) pA1[r] = __builtin_amdgcn_exp2f(pA1[r]);
    WAIT_BAR(0);
    DMA_K(3, 0); DMA_V(1, SLOTB);
    ROT();
    kload8(kf, kp0 + sl_cur);
    WAIT_BAR(2);
    s16x4 vlo[8], vhi[8]; u32x4 pw0, pw1, pw2, pw3;
#define PKW(P, B) cvtpk_s(P[B], P[B + 1])
#define PAF(k) __builtin_bit_cast(bf16x8, pw##k)
#define VFR(i) (bf16x8){vlo[i][0], vlo[i][1], vlo[i][2], vlo[i][3], vhi[i][0], vhi[i][1], vhi[i][2], vhi[i][3]}
#define PIN(x) asm volatile("" : "+v"(x))
#define MX3(a, b, c) __builtin_fmaxf(__builtin_fmaxf((a), (b)), (c))
#define GAPA(MF, A0, A1, A2, A3, W0, W1, PW) do { MF; sacc += A0; sacc += A1; sacc += A2; sacc += A3; PIN(sacc); W0; W1; PIN(PW); SBAR(); } while (0)
#define EX(v) __builtin_amdgcn_exp2f(v)
#define GAPB(MF, X, B) do { MF; X[B] = EX(X[B]); X[B + 1] = EX(X[B + 1]); X[B + 2] = EX(X[B + 2]); X[B + 3] = EX(X[B + 3]); PIN(X); SBAR(); } while (0)
#define VRD(i) do { vlo[i] = vtr(vp_ + (((i) >> 2) * 4096 + ((i) & 3) * 1024)); vhi[i] = vtr(vp_ + (((i) >> 2) * 4096 + ((i) & 3) * 1024 + 512)); } while (0)
#define KRD(G, j) do { if (G) { kload2(kf, kp0 + sl_next, j); SBAR(); } } while (0)
#define STEP(C0, C1, P0, P1, t, GK, GV, GL) do { SBAR(); \
    const lds_cptr vp_ = vp0 + sl_prev; \
    VRD(0); SBAR(); float sacc = (P0[0] + P0[1]); \
    GAPA(C0 = __builtin_amdgcn_mfma_f32_32x32x16_bf16(kf[0], qr[0], negm, 0, 0, 0), P0[2], P0[3], P0[4], P0[5],     pw0[0] = PKW(P0, 0), pw0[1] = PKW(P0, 2), pw0); \
    VRD(4); SBAR(); GAPA(C1 = __builtin_amdgcn_mfma_f32_32x32x16_bf16(kf[1], qr[0], negm, 0, 0, 0), P0[6], P0[7], P0[8], P0[9],     pw0[2] = PKW(P0, 4), pw0[3] = PKW(P0, 6), pw0); \
    VRD(1); SBAR(); GAPA(C0 = __builtin_amdgcn_mfma_f32_32x32x16_bf16(kf[2], qr[1], C0, 0, 0, 0),   P0[10], P0[11], P0[12], P0[13], pw1[0] = PKW(P0, 8), pw1[1] = PKW(P0, 10), pw1); \
    VRD(5); SBAR(); GAPA(C1 = __builtin_amdgcn_mfma_f32_32x32x16_bf16(kf[3], qr[1], C1, 0, 0, 0),   P0[14], P0[15], P1[0], P1[1],   pw1[2] = PKW(P0, 12), pw1[3] = PKW(P0, 14), pw1); \
    VRD(2); SBAR(); GAPA(C0 = __builtin_amdgcn_mfma_f32_32x32x16_bf16(kf[4], qr[2], C0, 0, 0, 0),   P1[2], P1[3], P1[4], P1[5],     pw2[0] = PKW(P1, 0), pw2[1] = PKW(P1, 2), pw2); \
    VRD(6); SBAR(); GAPA(C1 = __builtin_amdgcn_mfma_f32_32x32x16_bf16(kf[5], qr[2], C1, 0, 0, 0),   P1[6], P1[7], P1[8], P1[9],     pw2[2] = PKW(P1, 4), pw2[3] = PKW(P1, 6), pw2); \
    VRD(3); SBAR(); GAPA(C0 = __builtin_amdgcn_mfma_f32_32x32x16_bf16(kf[6], qr[3], C0, 0, 0, 0),   P1[10], P1[11], P1[12], P1[13], pw3[0] = PKW(P1, 8), pw3[1] = PKW(P1, 10), pw3); \
    VRD(7); SBAR(); GAPA(C1 = __builtin_amdgcn_mfma_f32_32x32x16_bf16(kf[7], qr[3], C1, 0, 0, 0),   P1[14], P1[15], 0.f, 0.f,       pw3[2] = PKW(P1, 12), pw3[3] = PKW(P1, 14), pw3); \
    l_reg += sacc; \
    if (GK) { DMA_K((t) + 3, sl_cur); } if (GV) { DMA_V((t) + 1, sl_next); } \
    CMASK(C0, C1, t); \
    if (!NOMAX) { float a = MX3(C0[0], C0[1], C1[0]), b = MX3(C0[2], C0[3], C1[1]); a = MX3(a, C1[2], C1[3]); \
      _Pragma("unroll") for (int r = 4; r < 16; r += 4) { a = MX3(a, C0[r], C0[r + 1]); b = MX3(b, C0[r + 2], C0[r + 3]); a = MX3(a, C1[r], C1[r + 1]); b = MX3(b, C1[r + 2], C1[r + 3]); } \
      float rm = __builtin_fmaxf(a, b); { auto rr = __builtin_amdgcn_permlane32_swap(__float_as_uint(rm), __float_as_uint(rm), false, false); rm = __builtin_fmaxf(__uint_as_float(rr[0]), __uint_as_float(rr[1])); } \
      resc = false; \
      if (__builtin_expect(__any(rm > (float)THRL), 0)) { const float dl = __builtin_fmaxf(rm, 0.f); mhat += dl; \
        _Pragma("unroll") for (int r = 0; r < 16; ++r) { C0[r] -= dl; C1[r] -= dl; } \
        _Pragma("unroll") for (int r = 0; r < 16; ++r) negm[r] = -mhat; asm volatile("" : "+v"(negm)); \
        const float f = __builtin_amdgcn_exp2f(-dl); l_reg *= f; if (hi == 0) wsf[r32] = f; resc = true; } } \
    SBAR(); \
    GAPB(o[0] = __builtin_amdgcn_mfma_f32_32x32x16_bf16(PAF(0), VFR(0), o[0], 0, 0, 0), C0, 0); \
    GAPB(o[1] = __builtin_amdgcn_mfma_f32_32x32x16_bf16(PAF(0), VFR(4), o[1], 0, 0, 0), C0, 4); \
    KRD(GL, 0); GAPB(o[0] = __builtin_amdgcn_mfma_f32_32x32x16_bf16(PAF(1), VFR(1), o[0], 0, 0, 0), C0, 8); \
    KRD(GL, 1); GAPB(o[1] = __builtin_amdgcn_mfma_f32_32x32x16_bf16(PAF(1), VFR(5), o[1], 0, 0, 0), C0, 12); \
    KRD(GL, 2); GAPB(o[0] = __builtin_amdgcn_mfma_f32_32x32x16_bf16(PAF(2), VFR(2), o[0], 0, 0, 0), C1, 0); \
    KRD(GL, 3); GAPB(o[1] = __builtin_amdgcn_mfma_f32_32x32x16_bf16(PAF(2), VFR(6), o[1], 0, 0, 0), C1, 4); \
    GAPB(o[0] = __builtin_amdgcn_mfma_f32_32x32x16_bf16(PAF(3), VFR(3), o[0], 0, 0, 0), C1, 8); \
    GAPB(o[1] = __builtin_amdgcn_mfma_f32_32x32x16_bf16(PAF(3), VFR(7), o[1], 0, 0, 0), C1, 12); \
    } while (0)
    int t = 1;
    for (; t + 5 < NT; t += 2) {
        STEP(pB0, pB1, pA0, pA1, t, true, true, true);     WAIT_BAR(2); RESC(); ROT();
        STEP(pA0, pA1, pB0, pB1, t + 1, true, true, true); WAIT_BAR(2); RESC(); ROT();
    }
#define ENDW(tt) do { if ((tt) + 3 < NT) { WAIT_BAR(2); } else if ((tt) + 2 < NT) { WAIT_BAR(1); } else { WAIT_BAR(0); } } while (0)
    for (; t + 1 < NT; t += 2) {
        STEP(pB0, pB1, pA0, pA1, t, (t + 3 < NT), (t + 1 < NT), (t + 1 < NT));         ENDW(t);     RESC(); ROT();
        STEP(pA0, pA1, pB0, pB1, t + 1, (t + 4 < NT), (t + 2 < NT), (t + 2 < NT));     ENDW(t + 1); RESC(); ROT();
    }
    STEP(pB0, pB1, pA0, pA1, NT - 1, false, false, false); RESC();
    { float sacc = pB0[0] + pB0[1]; _Pragma("unroll") for (int r = 2; r < 16; ++r) sacc += pB0[r]; _Pragma("unroll") for (int r = 0; r < 16; ++r) sacc += pB1[r]; l_reg += sacc;
      pw0 = (u32x4){PKW(pB0, 0), PKW(pB0, 2), PKW(pB0, 4), PKW(pB0, 6)}; pw1 = (u32x4){PKW(pB0, 8), PKW(pB0, 10), PKW(pB0, 12), PKW(pB0, 14)}; pw2 = (u32x4){PKW(pB1, 0), PKW(pB1, 2), PKW(pB1, 4), PKW(pB1, 6)}; pw3 = (u32x4){PKW(pB1, 8), PKW(pB1, 10), PKW(pB1, 12), PKW(pB1, 14)};
      SBAR(); pv(o, vb0 + sl_cur, PAF(0), PAF(1), PAF(2), PAF(3)); }
#undef PKW
#undef PAF
#undef VFR
#undef PIN
#undef MX3
#undef GAPA
#undef GAPB
#undef EX
#undef VRD
#undef KRD
#undef STEP
#undef ENDW
    { auto rr = __builtin_amdgcn_permlane32_swap(__float_as_uint(l_reg), __float_as_uint(l_reg), false, false); l_reg = __uint_as_float(rr[0]) + __uint_as_float(rr[1]); }
    if (MODE == 1) l_reg += __builtin_amdgcn_exp2f(sink2 - mhat);
    if (hi == 0) wsf[32 + r32] = l_reg; asm volatile("s_waitcnt lgkmcnt(0)" ::: "memory");
    float rli[16];
#pragma unroll
    for (int r = 0; r < 16; ++r) rli[r] = __builtin_amdgcn_rcpf(wsf[32 + crow(r, hi)]);
    unsigned char* Ow = O + (rowbase + q0 + wid * QBLK) * QP + h * D;
    { unsigned char* stg = (unsigned char*)(shm + LDS_OST) + wid * 2048;
#pragma unroll
      for (int r = 0; r < 16; ++r) { const int orow = crow(r, hi); const float sc = rli[r] * 32.0f;
        const unsigned pk = (unsigned)__builtin_amdgcn_cvt_pk_fp8_f32(o[0][r] * sc, o[1][r] * sc, 0, false);
        stg[orow * 64 + r32] = (unsigned char)(pk & 0xffu); stg[orow * 64 + 32 + r32] = (unsigned char)((pk >> 8) & 0xffu); }
      asm volatile("s_waitcnt lgkmcnt(0)" ::: "memory");
#pragma unroll
      for (int i = 0; i < 2; ++i) { const int row = i * 16 + (lane >> 2), ch = lane & 3; const u32x4 v = *(const u32x4*)(stg + row * 64 + ch * 16); *(u32x4*)(Ow + (long)row * QP + ch * 16) = v; } }
    asm volatile("s_waitcnt lgkmcnt(0)\n\ts_barrier" ::: "memory");
#undef DMA_K
#undef DMA_V
#undef CMASK
#undef START
#undef RESC
#undef ROT
}
#undef SBAR
#undef WAIT_BAR
}

constexpr size_t MiB = 1u << 20;
constexpr size_t WS_CTL = 0, CTL_ZERO_BYTES = 32768;
constexpr size_t WS_RSTD = 1 * MiB;
constexpr size_t WS_ROPE = 2 * MiB;
constexpr size_t WS_GATEW = 6 * MiB;
constexpr size_t WS_LIST = 7 * MiB;
constexpr size_t WS_WIN = 10 * MiB;
constexpr size_t WS_WA = 18 * MiB, WS_WB = WS_WA + MiB / 2, WS_WOUT = 20 * MiB;
constexpr size_t WS_XB = 24 * MiB;
constexpr size_t WS_QA = 56 * MiB, WS_QB = 72 * MiB;
constexpr size_t WS_KA = 88 * MiB, WS_VA = 92 * MiB, WS_KB = 96 * MiB, WS_VB = 100 * MiB;
constexpr size_t WS_GA = 104 * MiB, WS_GB = 136 * MiB;
constexpr size_t WS_MERGED = 168 * MiB;
constexpr size_t WS_H2 = 200 * MiB;
constexpr size_t WS_WGU = 232 * MiB;
constexpr size_t WS_WD = 360 * MiB;
constexpr size_t WS_ACT = 424 * MiB;
constexpr size_t WS_Y = 568 * MiB;
constexpr size_t WS_OA = 696 * MiB, WS_OB = 704 * MiB;
constexpr size_t WS_X1 = 728 * MiB;
constexpr size_t WS_LIST2 = 792 * MiB;
constexpr size_t WS_END = 796 * MiB;
static_assert((size_t)ACT_ROWS * DFF * 2 <= WS_Y - WS_ACT, "ACT fits");
constexpr int CW_ECNT = 64;
constexpr int CW_TKT = 512;
constexpr int WD_ITEMS = NEXP * (DFF / 64) * (DM / 32), WD_DEFER = 6144, WD_P0 = WD_ITEMS - WD_DEFER, WD_SEAM = WD_P0 / 5;
constexpr int CW_BAR = 4096;

constexpr int RING_OFF = 0, RING_BYTES = 131072;
constexpr int LDSCTL_OFF = RING_BYTES;
constexpr int L_BARST = 0;
constexpr int L_TKT = 8;
constexpr int L_PRE = 16;
constexpr int L_CNT = 64;
constexpr int L_LCNT = 96;
constexpr int L_LBASE = 128;
constexpr int L_SELE = 256, L_SELR = 512, L_SELG = 768;
constexpr int LDS_BYTES = 147456;
static_assert(LDSCTL_OFF + 1024 * 4 <= LDS_BYTES, "LDS map");

#define XB_TMO      128
#define XB_XCNT(j)  (256  + 64 * (j))
#define XB_XSUB(j)  (1280 + 64 * (j))
#define XB_XGEN(j)  (2304 + 64 * (j))
#define XB_TOP      3328
#define XB_TOPGEN   3392
#define XCD_BAR_WORDS 3456
#define XB_SPIN_CAP (1u << 22)
__device__ __forceinline__ unsigned xb_ld(unsigned* p)              { return __hip_atomic_load(p, __ATOMIC_RELAXED, __HIP_MEMORY_SCOPE_AGENT); }
__device__ __forceinline__ unsigned xb_add(unsigned* p, unsigned v) { return __hip_atomic_fetch_add(p, v, __ATOMIC_RELAXED, __HIP_MEMORY_SCOPE_AGENT); }
__device__ __forceinline__ unsigned xb_xcc_id() { return (unsigned)__builtin_amdgcn_s_getreg((3 << 11) | 20) & 0xFu; }
#define XB_SPIN(cond, bar) do { unsigned _sp = 0; while (cond) { __builtin_amdgcn_s_sleep(1); \
    if ((++_sp & 255u) == 0u) { if (xb_ld(&(bar)[XB_TMO])) break; if (_sp > XB_SPIN_CAP) { atomicAdd(&(bar)[XB_TMO], 1u); break; } } } } while (0)
struct XcdBarrier { unsigned* bar; unsigned x; volatile LAS unsigned* st; };
__device__ __forceinline__ XcdBarrier xcd_barrier_post(unsigned* bar, volatile LAS unsigned* st, int wave) {
    XcdBarrier b; b.bar = bar; b.x = xb_xcc_id(); b.st = st;
    if (wave == 0 && lane_fresh() == 0) st[2] = xb_add(&bar[XB_XCNT(b.x)], 1u);
    return b;
}
__device__ __forceinline__ void xcd_barrier_complete(unsigned* bar, unsigned x, unsigned& nloc, unsigned& nx) {
    const unsigned G = gridDim.x * gridDim.y * gridDim.z;
    unsigned sum, cnt, mine, sp = 0u;
    for (;;) {
        sum = 0u; cnt = 0u; mine = 0u;
#pragma unroll
        for (unsigned j = 0; j < 16; ++j) { const unsigned c = xb_ld(&bar[XB_XCNT(j)]); sum += c; cnt += (c > 0u) ? 1u : 0u; mine = (j == x) ? c : mine; }
        if (sum == G) break;
        __builtin_amdgcn_s_sleep(1);
        if ((++sp & 255u) == 0u) { if (xb_ld(&bar[XB_TMO])) break; if (sp > XB_SPIN_CAP) { atomicAdd(&bar[XB_TMO], 1u); break; } }
    }
    nloc = mine > 0u ? mine : 1u; nx = cnt > 0u ? cnt : 1u;
}
__device__ __forceinline__ void xcd_arrive(const XcdBarrier& b, int wave) {
    asm volatile("s_waitcnt vmcnt(0)" ::: "memory");
    __syncthreads();
    if (wave == 0 && lane_fresh() == 0) {
        unsigned* bar = b.bar;
        __builtin_amdgcn_s_waitcnt(0);
        unsigned nloc = b.st[0], nx = b.st[1];
        if (nloc == 0u) { xcd_barrier_complete(bar, b.x, nloc, nx); b.st[0] = nloc; b.st[1] = nx; }
        const unsigned old = xb_add(&bar[XB_XSUB(b.x)], 1u);
        const unsigned gen = old / nloc;
        b.st[4] = gen;
        if (old + 1u == (gen + 1u) * nloc) {
            __builtin_amdgcn_fence(__ATOMIC_RELEASE, "agent");
            asm volatile("s_waitcnt vmcnt(0)" ::: "memory");
            const unsigned og = xb_add(&bar[XB_TOP], 1u);
            const unsigned tg = og / nx;
            if (og + 1u == (tg + 1u) * nx) {
                xb_add(&bar[XB_TOPGEN], 1u);
#pragma unroll
                for (unsigned j = 0; j < 16; ++j) xb_add(&bar[XB_XGEN(j)], 1u);
            }
        }
    }
}
__device__ __forceinline__ void xcd_wait(const XcdBarrier& b, int wave) {
    if (wave == 0 && lane_fresh() == 0) {
        unsigned* bar = b.bar;
        const unsigned gen = b.st[4];
        XB_SPIN(xb_ld(&bar[XB_XGEN(b.x)]) == gen, bar);
        __builtin_amdgcn_fence(__ATOMIC_ACQUIRE, "agent");
        asm volatile("s_waitcnt vmcnt(0)" ::: "memory");
    }
    __syncthreads();
}
__device__ __forceinline__ void xcd_barrier(const XcdBarrier& b, int wave) { xcd_arrive(b, wave); xcd_wait(b, wave); }

struct Args { const float* in[17]; float* out; unsigned char* ws; int ph_lo, ph_hi, li, pad; };
struct Frame {
    LAS unsigned char* lds; int tid, lane, wave, vcu, G;
};

__device__ __forceinline__ void p0_item(const float* W, int ldw, int k0, int nsrc0, bf16_t* WT, int K, int ndst0, const float* gk, LAS float* scr, int lane) {
    f32x4 v[8];
#pragma unroll
    for (int i = 0; i < 8; ++i) v[i] = *(const f32x4*)(W + (size_t)(k0 + 8 * i + (lane >> 3)) * ldw + nsrc0 + 4 * (lane & 7));
    if (gk) {
#pragma unroll
        for (int i = 0; i < 8; ++i) v[i] = v[i] * gk[k0 + 8 * i + (lane >> 3)];
    }
#pragma unroll
    for (int i = 0; i < 8; ++i) { LAS float* s = scr + (8 * i + (lane >> 3)) * 33 + 4 * (lane & 7); s[0] = v[i][0]; s[1] = v[i][1]; s[2] = v[i][2]; s[3] = v[i][3]; }
    asm volatile("s_waitcnt lgkmcnt(0)" ::: "memory");
    const int c = lane & 7;
#pragma unroll
    for (int j = 0; j < 4; ++j) { const int n = (lane >> 3) + 8 * j; const LAS float* s = scr + (8 * c) * 33 + n;
        u32x4 o; o.x = pk2(s[0 * 33], s[1 * 33]); o.y = pk2(s[2 * 33], s[3 * 33]); o.z = pk2(s[4 * 33], s[5 * 33]); o.w = pk2(s[6 * 33], s[7 * 33]);
        *(u32x4*)(WT + (size_t)(ndst0 + n) * K + k0 + 8 * c) = o; }
    asm volatile("s_waitcnt lgkmcnt(0)" ::: "memory");
}
__device__ __forceinline__ void p0_item8(const float* W, int ldw, int k0, int nsrc0, unsigned char* WT, int K, int ndst0, float scale, const float* gk, LAS float* scr, int lane) {
    f32x4 v[8];
#pragma unroll
    for (int i = 0; i < 8; ++i) v[i] = *(const f32x4*)(W + (size_t)(k0 + 8 * i + (lane >> 3)) * ldw + nsrc0 + 4 * (lane & 7));
    if (gk) {
#pragma unroll
        for (int i = 0; i < 8; ++i) v[i] = v[i] * gk[k0 + 8 * i + (lane >> 3)];
    }
#pragma unroll
    for (int i = 0; i < 8; ++i) { LAS float* s = scr + (8 * i + (lane >> 3)) * 33 + 4 * (lane & 7); s[0] = v[i][0] * scale; s[1] = v[i][1] * scale; s[2] = v[i][2] * scale; s[3] = v[i][3] * scale; }
    asm volatile("s_waitcnt lgkmcnt(0)" ::: "memory");
    const int c = lane & 7;
#pragma unroll
    for (int j = 0; j < 4; ++j) { const int n = (lane >> 3) + 8 * j; const LAS float* s = scr + (8 * c) * 33 + n;
        u32x2 o; o.x = pk4_fp8(s[0 * 33], s[1 * 33], s[2 * 33], s[3 * 33]); o.y = pk4_fp8(s[4 * 33], s[5 * 33], s[6 * 33], s[7 * 33]);
        *(u32x2*)(WT + (size_t)(ndst0 + n) * K + k0 + 8 * c) = o; }
    asm volatile("s_waitcnt lgkmcnt(0)" ::: "memory");
}
template <class SrcMap> __device__ __forceinline__ void p0_weight8(const Frame& F, const float* W, int K, int N, unsigned char* WT, float scale, const float* gk, LAS float* scr, SrcMap srcmap) {
    const int gw = F.vcu * 8 + F.wave, NGW = F.G * 8; const int nkb = K / 64, nnb = N / 32, nitems = nkb * nnb;
    for (int it = gw; it < nitems; it += NGW) { const int kb = it / nnb, nb = it % nnb; p0_item8(W, N, kb * 64, srcmap(nb * 32), WT, K, nb * 32, scale, gk, scr, F.lane); }
}
struct W8Task { const float* W; unsigned char* WT; int K, N, ngroups; float scale; const float* gk; int gu, nt; };
template <bool HAS_GK, class SrcMap> __device__ __forceinline__ void p0_w8_load(const W8Task& T, int it, f32x4 (&v)[8], float (&gv)[8], int lane, SrcMap srcmap) {
    const int nnb = T.N / 32, per = (T.K / 64) * nnb; const int g = it / per, r = it - g * per, kb = r / nnb, nb = r - kb * nnb;
    const float* W = T.W + (size_t)g * T.K * T.N; const int nsrc0 = srcmap(nb * 32), k0 = kb * 64;
#pragma unroll
    for (int i = 0; i < 8; ++i) { v[i] = __builtin_nontemporal_load((const f32x4*)(W + (size_t)(k0 + 8 * i + (lane >> 3)) * T.N + nsrc0 + 4 * (lane & 7))); if (HAS_GK) gv[i] = T.gk[k0 + 8 * i + (lane >> 3)]; }
}
template <bool HAS_GK> __device__ __forceinline__ void p0_w8_store(const W8Task& T, int it, const f32x4 (&v)[8], const float (&gv)[8], LAS float* scr, int lane) {
    const int nnb = T.N / 32, per = (T.K / 64) * nnb; const int g = it / per, r = it - g * per, kb = r / nnb, nb = r - kb * nnb;
    unsigned char* WT = T.WT + (size_t)g * T.K * T.N; const int k0 = kb * 64, ndst0 = nb * 32;
    const float gus = T.gu ? (((ndst0 >> 7) & 1) ? 1.0f / SWI_C : SWI_C) : 1.0f;
#pragma unroll
    for (int i = 0; i < 8; ++i) { float sc = T.scale * gus; if (HAS_GK) sc *= gv[i];
        LAS float* s = scr + (8 * i + (lane >> 3)) * 33 + 4 * (lane & 7); s[0] = v[i][0] * sc; s[1] = v[i][1] * sc; s[2] = v[i][2] * sc; s[3] = v[i][3] * sc; }
    asm volatile("s_waitcnt lgkmcnt(0)" ::: "memory");
    const int c = lane & 7;
#pragma unroll
    for (int j = 0; j < 4; ++j) { const int n = (lane >> 3) + 8 * j; const LAS float* s = scr + (8 * c) * 33 + n;
        u32x2 o; o.x = pk4_fp8(s[0 * 33], s[1 * 33], s[2 * 33], s[3 * 33]); o.y = pk4_fp8(s[4 * 33], s[5 * 33], s[6 * 33], s[7 * 33]);
        if (T.nt) __builtin_nontemporal_store(o, (u32x2*)(WT + (size_t)(ndst0 + n) * T.K + k0 + 8 * c)); else *(u32x2*)(WT + (size_t)(ndst0 + n) * T.K + k0 + 8 * c) = o; }
    asm volatile("s_waitcnt lgkmcnt(0)" ::: "memory");
}
template <bool HAS_GK, class SrcMap> __device__ __forceinline__ void p0_w8_run(const Frame& F, const W8Task& T, LAS float* scr, SrcMap srcmap, int gw = -1, int NGW = 0, int lim = 0x7fffffff, int first = 0) {
    if (gw < 0) { gw = F.vcu * 8 + F.wave; NGW = F.G * 8; } const int total_ = T.ngroups * (T.K / 64) * (T.N / 32), total = total_ < lim ? total_ : lim;
    f32x4 va[8], vb_[8]; float ga[8], gb[8]; int it = first + gw;
    if (it < total) p0_w8_load<HAS_GK>(T, it, va, ga, F.lane, srcmap);
    while (it < total) {
        const int i1 = it + NGW; if (i1 < total) p0_w8_load<HAS_GK>(T, i1, vb_, gb, F.lane, srcmap);
        p0_w8_store<HAS_GK>(T, it, va, ga, scr, F.lane);
        if (i1 >= total) break;
        const int i2 = i1 + NGW; if (i2 < total) p0_w8_load<HAS_GK>(T, i2, va, ga, F.lane, srcmap);
        p0_w8_store<HAS_GK>(T, i1, vb_, gb, scr, F.lane);
        it = i2;
    }
}
template <class SrcMap> __device__ __forceinline__ void p0_w8_run3(const Frame& F, const W8Task& T, LAS float* scr, SrcMap srcmap, int gw, int NGW, int first) {
    const int total = T.ngroups * (T.K / 64) * (T.N / 32);
    f32x4 va[8], vb_[8], vc_[8]; float ga[8], gb[8], gc[8]; int i0 = first + gw, i1 = i0 + NGW, i2 = i1 + NGW;
    if (i0 < total) p0_w8_load<false>(T, i0, va, ga, F.lane, srcmap);
    if (i1 < total) p0_w8_load<false>(T, i1, vb_, gb, F.lane, srcmap);
    for (;;) {
        if (i0 >= total) break; if (i2 < total) p0_w8_load<false>(T, i2, vc_, gc, F.lane, srcmap); p0_w8_store<false>(T, i0, va, ga, scr, F.lane); i0 += 3 * NGW;
        if (i1 >= total) break; if (i0 < total) p0_w8_load<false>(T, i0, va, ga, F.lane, srcmap); p0_w8_store<false>(T, i1, vb_, gb, scr, F.lane); i1 += 3 * NGW;
        if (i2 >= total) break; if (i1 < total) p0_w8_load<false>(T, i1, vb_, gb, F.lane, srcmap); p0_w8_store<false>(T, i2, vc_, gc, scr, F.lane); i2 += 3 * NGW;
    }
}
template <class SrcMap> __device__ __forceinline__ void p0_weight(const Frame& F, const float* W, int K, int N, bf16_t* WT, const float* gk, LAS float* scr, SrcMap srcmap) {
    const int gw = F.vcu * 8 + F.wave, NGW = F.G * 8; const int nkb = K / 64, nnb = N / 32, nitems = nkb * nnb;
    for (int it = gw; it < nitems; it += NGW) { const int kb = it / nnb, nb = it % nnb; p0_item(W, N, kb * 64, srcmap(nb * 32), WT, K, nb * 32, gk, scr, F.lane); }
}
struct MapId { __device__ __forceinline__ int operator()(int n) const { return n; } };
struct MapInProj { __device__ __forceinline__ int operator()(int n) const { const int pn = n >> 8, c = n & 255; return pn * 256 + 64 * ((c & 127) >> 5) + 32 * (c >> 7) + (c & 31); } };
struct MapGateUp { __device__ __forceinline__ int operator()(int n) const { const int pn = n >> 8, bj = (n >> 7) & 1, j = n & 127; return 1024 * bj + 128 * pn + j; } };

__device__ const double ROPE_INV[32] = {1.0, 0.7498942093324559, 0.5623413251903491, 0.4216965034285822, 0.31622776601683794, 0.23713737056616552, 0.1778279410038923, 0.1333521432163324, 0.1, 0.07498942093324558, 0.05623413251903491, 0.042169650342858224, 0.03162277660168379, 0.023713737056616554, 0.01778279410038923, 0.01333521432163324, 0.01, 0.007498942093324558, 0.005623413251903491, 0.004216965034285823, 0.0031622776601683794, 0.0023713737056616554, 0.0017782794100389228, 0.001333521432163324, 0.001, 0.0007498942093324559, 0.0005623413251903491, 0.00042169650342858224, 0.00031622776601683794, 0.00023713737056616554, 0.00017782794100389227, 0.0001333521432163324};

constexpr int NPHASE = 9;
#ifndef REP_PHASE
#define REP_PHASE -1
#endif
#define NREP(k) ((k) == REP_PHASE ? 2 : 1)
constexpr int N_LAUNCHES = MK_N_LAUNCHES;

__global__ void __launch_bounds__(512, 2) fwd_kernel(Args args) {
    extern __shared__ __attribute__((aligned(16))) unsigned char lds_raw[];
    Frame F;
    F.lds = (LAS unsigned char*)lds_raw;
    F.wave = __builtin_amdgcn_readfirstlane((int)threadIdx.x >> 6); F.lane = lane_fresh(); F.tid = F.wave * 64 + F.lane;
#define REFRESH_ID() do { F.lane = lane_fresh(); F.tid = F.wave * 64 + F.lane; } while (0)
    F.G = gridDim.x; { const int bx = blockIdx.x; F.vcu = (F.G % 8 == 0) ? (bx % 8) * (F.G / 8) + bx / 8 : bx; }
    unsigned char* ws = args.ws;
    unsigned* ctl = (unsigned*)(ws + WS_CTL);
    volatile LAS unsigned* LCTL = (volatile LAS unsigned*)(F.lds + LDSCTL_OFF);
    for (int u = F.tid; u < (LDS_BYTES - LDSCTL_OFF) / 4; u += 512) ((LAS unsigned*)(F.lds + LDSCTL_OFF))[u] = 0u;
    __syncthreads();
    XcdBarrier bar; bar.bar = ctl + CW_BAR; bar.x = 0; bar.st = nullptr;
    if (N_LAUNCHES == 1) bar = xcd_barrier_post(ctl + CW_BAR, LCTL + L_BARST, F.wave);
#define GRID_BAR() do { if (N_LAUNCHES == 1) xcd_barrier(bar, F.wave); } while (0)
    const int lo = args.ph_lo, hi = args.ph_hi;
#ifndef PHASE_MASK
#define PHASE_MASK 0x1ff
#endif
#define IN(k) (((PHASE_MASK >> (k)) & 1) && lo <= (k) && (k) < hi)
#define BOTH(k) (IN(k) && IN((k) + 1))

#define x_in ((const float*)args.in[0])
#define g_mix ((const float*)args.in[1])
#define w_in ((const float*)args.in[2])
#define qa_norm ((const float*)args.in[3])
#define ka_norm ((const float*)args.in[4])
#define sink_b ((const float*)args.in[5])
#define w_br_a ((const float*)args.in[6])
#define w_br_b ((const float*)args.in[7])
#define w_out ((const float*)args.in[8])
#define g_ffn ((const float*)args.in[9])
#define w_router ((const float*)args.in[10])
#define b_router ((const float*)args.in[11])
#define w_gate_up ((const float*)args.in[12])
#define b_gate_up ((const float*)args.in[13])
#define w_down ((const float*)args.in[14])
#define b_down ((const float*)args.in[15])
#define g_final ((const float*)args.in[16])
    float* out = args.out;
    float* RSTD = (float*)(ws + WS_RSTD); float* ROPE = (float*)(ws + WS_ROPE); u32x2* LIST2 = (u32x2*)(ws + WS_LIST2);
    unsigned char* WIN = (unsigned char*)(ws + WS_WIN); unsigned char* WA = (unsigned char*)(ws + WS_WA); unsigned char* WB = (unsigned char*)(ws + WS_WB); unsigned char* WOUT = (unsigned char*)(ws + WS_WOUT);
    unsigned char* XB = (unsigned char*)(ws + WS_XB); unsigned char* QA = (unsigned char*)(ws + WS_QA); unsigned char* QBb = (unsigned char*)(ws + WS_QB);
    bf16_t* KA = (bf16_t*)(ws + WS_KA); bf16_t* VA = (bf16_t*)(ws + WS_VA); bf16_t* KBb = (bf16_t*)(ws + WS_KB); bf16_t* VBb = (bf16_t*)(ws + WS_VB);
    unsigned char* GA = (unsigned char*)(ws + WS_GA); unsigned char* GB = (unsigned char*)(ws + WS_GB); unsigned char* MERGED = (unsigned char*)(ws + WS_MERGED); unsigned char* H2 = (unsigned char*)(ws + WS_H2);
    unsigned char* WGU = (unsigned char*)(ws + WS_WGU); unsigned char* WD = (unsigned char*)(ws + WS_WD); unsigned char* ACT = (unsigned char*)(ws + WS_ACT); unsigned char* YB = (unsigned char*)(ws + WS_Y);
    unsigned char* OA = (unsigned char*)(ws + WS_OA); unsigned char* OB = (unsigned char*)(ws + WS_OB); bf16_t* X1 = (bf16_t*)(ws + WS_X1);
    float* cosA = ROPE, *sinA = ROPE + SEQ * 32, *cosB = ROPE + 2 * SEQ * 32, *sinB = ROPE + 3 * SEQ * 32;
    const int gw = F.vcu * 8 + F.wave, NGW = F.G * 8;

    if (IN(0)) {
        REFRESH_ID();
        LAS float* scr = (LAS float*)(F.lds + RING_OFF + F.wave * 16384);
        for (int rep_ = 0; rep_ < NREP(0); ++rep_) {
        for (int m = gw; m < MTOK; m += 2 * NGW) {
            const int m1 = m + NGW; const bool has1 = m1 < MTOK;
            const f32x4* xr0 = (const f32x4*)(x_in + (size_t)m * DM) + F.lane; const f32x4* xr1 = (const f32x4*)(x_in + (size_t)(has1 ? m1 : m) * DM) + F.lane;
            f32x4 v0[4], v1[4]; float s0 = 0.f, s1 = 0.f;
#pragma unroll
            for (int j = 0; j < 4; ++j) { v0[j] = __builtin_nontemporal_load(xr0 + 64 * j); v1[j] = __builtin_nontemporal_load(xr1 + 64 * j); }
#pragma unroll
            for (int j = 0; j < 4; ++j) { s0 += (v0[j].x * v0[j].x + v0[j].y * v0[j].y) + (v0[j].z * v0[j].z + v0[j].w * v0[j].w); s1 += (v1[j].x * v1[j].x + v1[j].y * v1[j].y) + (v1[j].z * v1[j].z + v1[j].w * v1[j].w); }
            s0 = wave_sum(s0); s1 = wave_sum(s1);
            if (F.lane == 0) { RSTD[m] = rsqrtf(s0 * (1.0f / DM) + EPS); if (has1) RSTD[m1] = rsqrtf(s1 * (1.0f / DM) + EPS); }
            unsigned* o0 = (unsigned*)(XB + (size_t)m * DM) + F.lane; unsigned* o1 = (unsigned*)(XB + (size_t)m1 * DM) + F.lane;
#pragma unroll
            for (int j = 0; j < 4; ++j) { o0[64 * j] = pk4_fp8(v0[j].x, v0[j].y, v0[j].z, v0[j].w); if (has1) o1[64 * j] = pk4_fp8(v1[j].x, v1[j].y, v1[j].z, v1[j].w); }
        }
        { W8Task T{w_in, WIN, DM, IN_COLS, 1, 32.0f, g_mix}; p0_w8_run<true>(F, T, scr, MapInProj()); }
#define CONVERT_SMALL() do { \
        { W8Task T{w_br_a, WA, QW, DM, 1, 32.0f, nullptr}; p0_w8_run<false>(F, T, scr, MapId()); } \
        { W8Task T{w_br_b, WB, QW, DM, 1, 32.0f, nullptr}; p0_w8_run<false>(F, T, scr, MapId()); } \
        { W8Task T{w_out, WOUT, DM, DM, 1, 32.0f, nullptr}; p0_w8_run<false>(F, T, scr, MapId()); } } while (0)
        if (!(BOTH(0) && N_LAUNCHES == 1)) CONVERT_SMALL();
        if (!(BOTH(0) && N_LAUNCHES == 1)) { W8Task T{w_down, WD, DFF, DM, NEXP, 32.0f, nullptr, 0, 1}; p0_w8_run<false>(F, T, scr, MapId(), -1, 0, WD_P0); }
        {
            for (int it = gw; it < SEQ * 32 / 64; it += NGW) {
                const int idx = it * 64 + F.lane, t = idx >> 5, i = idx & 31;
                const double i2pi = 0.15915494309189535;
                { const double ang = (i < 16) ? (double)(t >> 6) * ROPE_INV[2 * i] : (double)(t & 63) * ROPE_INV[2 * (i - 16)];
                  double rev = ang * i2pi; rev -= rint(rev); const float fr_ = (float)rev;
                  ((unsigned*)ROPE)[idx] = pk2(__builtin_amdgcn_cosf(fr_), __builtin_amdgcn_sinf(fr_)); }
                { const double ang = (double)t * ROPE_INV[i];
                  double rev = ang * i2pi; rev -= rint(rev); const float fr_ = (float)rev;
                  ((unsigned*)ROPE)[SEQ * 32 + idx] = pk2(__builtin_amdgcn_cosf(fr_), __builtin_amdgcn_sinf(fr_)); }
            }
        }
        }
        if (BOTH(0) && N_LAUNCHES == 1) xcd_arrive(bar, F.wave);
    }
    int vb = (int)blockIdx.x;
    const bool early_conv = (N_LAUNCHES == 1) && BOTH(0);
    const bool seams = (N_LAUNCHES == 1) && lo == 0 && hi == NPHASE;
#define WD_SEAM_RUN(k) do { if (seams) { REFRESH_ID(); LAS float* scr_ = (LAS float*)(F.lds + RING_OFF + F.wave * 16384); \
        W8Task Td_{w_down, WD, DFF, DM, NEXP, 32.0f, nullptr, 0, 1}; W8Task Tg_{w_gate_up, WGU, DM, 2 * DFF, NEXP, 32.0f, nullptr, 1, 1}; \
        f32x4 va_[8], vb_[8], vc_[8]; float ga_[8], gb_[8], gc_[8]; \
        for (int it_ = (k) * WD_SEAM + F.vcu * 8 + F.wave; it_ < ((k) + 1) * WD_SEAM; it_ += F.G * 8) { const int ig_ = 2 * it_; \
            p0_w8_load<false>(Td_, it_, va_, ga_, F.lane, MapId()); \
            if ((k) < 4) { p0_w8_load<false>(Tg_, ig_, vb_, gb_, F.lane, MapGateUp()); p0_w8_load<false>(Tg_, ig_ + 1, vc_, gc_, F.lane, MapGateUp()); } \
            p0_w8_store<false>(Td_, it_, va_, ga_, scr_, F.lane); \
            if ((k) < 4) { p0_w8_store<false>(Tg_, ig_, vb_, gb_, scr_, F.lane); p0_w8_store<false>(Tg_, ig_ + 1, vc_, gc_, scr_, F.lane); } } } } while (0)
#define GRID_BAR_WD(k) do { if (N_LAUNCHES == 1) { xcd_arrive(bar, F.wave); WD_SEAM_RUN(k); xcd_wait(bar, F.wave); } } while (0)
    if (N_LAUNCHES == 1 && lo == 0 && hi > 1) {
        REFRESH_ID();
        __syncthreads();
        if (F.tid == 0) { unsigned base = 0; for (unsigned j = 0; j < 16; ++j) { const unsigned c = xb_ld(&bar.bar[XB_XCNT(j)]); if (j < bar.x) base += c; } LCTL[L_BARST + 3] = base + LCTL[L_BARST + 2]; }
        __syncthreads();
        F.vcu = (int)LCTL[L_BARST + 3];
        if (F.G % 8 == 0) vb = (F.vcu % (F.G / 8)) * 8 + F.vcu / (F.G / 8); else vb = F.vcu;
    }
    constexpr int NCONV = 16;
#define CONVERT_WGU() do { const int cpx_ = (F.G % 8 == 0) ? F.G / 8 : F.G, jj_ = F.vcu % cpx_, xg_ = F.vcu / cpx_, nconv_ = NCONV < cpx_ ? NCONV : cpx_; \
          if (jj_ < nconv_) { LAS float* scr = (LAS float*)(F.lds + RING_OFF + F.wave * 16384); const int ngrp_ = F.G / cpx_; \
              const int gwc = (xg_ * nconv_ + jj_) * 8 + F.wave, ngwc = ngrp_ * nconv_ * 8; \
              { W8Task T{w_gate_up, WGU, DM, 2 * DFF, NEXP, 32.0f, nullptr, 1, 1}; p0_w8_run3(F, T, scr, MapGateUp(), gwc, ngwc, seams ? 8 * WD_SEAM : 0); } \
              asm volatile("s_waitcnt vmcnt(0) lgkmcnt(0)" ::: "memory"); __syncthreads(); } } while (0)
    if (early_conv) {
        { LAS float* scr = (LAS float*)(F.lds + RING_OFF + F.wave * 16384); CONVERT_SMALL(); }
        if (!seams) { LAS float* scr = (LAS float*)(F.lds + RING_OFF + F.wave * 16384); W8Task T{w_down, WD, DFF, DM, NEXP, 32.0f, nullptr, 0, 1}; p0_w8_run<false>(F, T, scr, MapId(), -1, 0, WD_P0); }
        CONVERT_WGU(); xcd_wait(bar, F.wave); }

    if (IN(1)) {
        if (!early_conv) { CONVERT_WGU(); }
        pg8::TicketOrder S; S.init(MTOK, IN_COLS, F.G, F.vcu, ctl + CW_TKT, (volatile LAS int*)(LCTL + L_TKT), F.wave);
        EpiInProj E{RSTD, qa_norm, ka_norm, (const unsigned*)ROPE, (const unsigned*)ROPE + SEQ * 32, QA, KA, VA, QBb, KBb, VBb, GA, GB};
        for (int rep_ = 0; rep_ < NREP(1); ++rep_)
        pg8::gemm_phase<EpiInProj, pg8::TicketOrder, true, true, false, true>(F.lds + RING_OFF, XB, WIN, DM, IN_COLS / 256, S, E, F.wave);
        if (BOTH(1)) GRID_BAR_WD(0);
    }

    if (IN(2)) {
        REFRESH_ID();
        char* shm = (char*)lds_raw + RING_OFF;
        float gq_ = fabsf(qa_norm[F.lane]), gk_ = fabsf(ka_norm[F.lane]);
        gq_ = wave_max(gq_); gk_ = wave_max(gk_);
        const float mrefA = 64.0f * gq_ * gk_ * C2 * 1.0001f;
        const bool nomax = mrefA < 64.0f;
        for (int rep_ = 0; rep_ < NREP(2); ++rep_) {
        for (int i = 0; i < 2; ++i) {
            const int uu = F.vcu + F.G * i; if (uu >= 512) break;
            const int ii = uu >> 8, v = uu & 255, combo = v >> 6, w = (v & 63) + 64 * ii, g = w >> 5, qb = w & 31;
            const int b = combo >> 1, h = (combo & 1) * 4 + g;
            if (nomax) attn_body::attn_unit<0, 8, true>(b, h, qb, QA, (const attn_body::bf16*)KA, (const attn_body::bf16*)VA, OA, shm, F.wave, 0.f, mrefA);
            else attn_body::attn_unit<0, 8>(b, h, qb, QA, (const attn_body::bf16*)KA, (const attn_body::bf16*)VA, OA, shm, F.wave, 0.f);
        }
        for (int i = 0; i < 2; ++i) {
            const int uu = F.vcu + F.G * i; if (uu >= 512) break;
            const int qb = uu & 31, h = (uu >> 5) & 7, b = uu >> 8;
            attn_body::attn_unit<1, 8>(b, h, qb, QBb, (const attn_body::bf16*)KBb, (const attn_body::bf16*)VBb, OB, shm, F.wave, sink_b[h] * 1.4426950408889634f);
        }
        }
        if (BOTH(2)) GRID_BAR_WD(1);
    }

    if (IN(3)) {
        static_assert(WS_OB == WS_OA + (size_t)MTOK * QW && WS_WB == WS_WA + (size_t)DM * QW, "branch B operands follow branch A's");
        pg8::PairOrder S; S.init(MTOK, DM, F.G, vb);
        EpiGateFused E{GB, GA, MERGED};
        for (int rep_ = 0; rep_ < NREP(3); ++rep_)
        pg8::gemm_phase<EpiGateFused, pg8::PairOrder, true, true, false, true>(F.lds + RING_OFF, OA, WA, QW, DM / 256, S, E, F.wave, 0x7a7a7a7a);
        if (BOTH(3)) GRID_BAR_WD(2);
    }

    u32x4 whi[4][2], wlo[4][2]; float be_r = 0.f;
#define SPLIT2(a_, b_, hi_, lo_) do { const float _a = (a_), _b = (b_); hi_ = pk2(_a, _b); lo_ = pk2(_a - bflo(hi_), _b - bfhi(hi_)); } while (0)
#define LOAD_WREG() do { const float* wp = w_router + (size_t)(F.wave * 128 + 8 * (F.lane >> 4)) * NEXP + (F.lane & 15); \
        _Pragma("unroll") for (int s_ = 0; s_ < 4; ++s_) _Pragma("unroll") for (int h_ = 0; h_ < 2; ++h_) { float w8[8]; \
            _Pragma("unroll") for (int i_ = 0; i_ < 8; ++i_) w8[i_] = wp[(size_t)(32 * s_ + i_) * NEXP + 16 * h_]; \
            SPLIT2(w8[0], w8[1], whi[s_][h_].x, wlo[s_][h_].x); SPLIT2(w8[2], w8[3], whi[s_][h_].y, wlo[s_][h_].y); SPLIT2(w8[4], w8[5], whi[s_][h_].z, wlo[s_][h_].z); SPLIT2(w8[6], w8[7], whi[s_][h_].w, wlo[s_][h_].w); } \
        be_r = b_router[F.lane & 31]; } while (0)
    if (IN(4)) {
        pg8::StaticOrder S; S.init(MTOK, DM, F.G, vb);
        EpiResid E{x_in, X1};
        for (int rep_ = 0; rep_ < NREP(4); ++rep_)
        pg8::gemm_phase<EpiResid, pg8::StaticOrder, true, true, false, true>(F.lds + RING_OFF, MERGED, WOUT, DM, DM / 256, S, E, F.wave, 0x7a7a7a7a);
        if (BOTH(4)) { REFRESH_ID(); LOAD_WREG(); GRID_BAR_WD(3); }
    }

    if (IN(5)) {
        REFRESH_ID();
        constexpr int HP = 1028;
        LAS float* hs = (LAS float*)(F.lds + RING_OFF);
        LAS float* part = (LAS float*)(F.lds + RING_OFF + 66560);
        volatile LAS int* lcnt = (volatile LAS int*)(LCTL + L_LCNT); volatile LAS int* lbase = (volatile LAS int*)(LCTL + L_LBASE);
        volatile LAS int* sele = (volatile LAS int*)(LCTL + L_SELE); volatile LAS int* selr = (volatile LAS int*)(LCTL + L_SELR); volatile LAS float* selg = (volatile LAS float*)(LCTL + L_SELG);
        const int e = F.lane & 31, kh = F.lane >> 5;
        if (!IN(4)) { LOAD_WREG(); }
        const float be = be_r;
        f32x4 gff[4];
#pragma unroll
        for (int j = 0; j < 4; ++j) gff[j] = *((const f32x4*)g_ffn + F.lane + 64 * j);
        for (int chunk = F.vcu; chunk < MTOK / 64; chunk += F.G) {
            if (F.tid < 32) lcnt[F.tid] = 0;
            const int row0 = chunk * 64;
            u32x2 xn[2][4];
#pragma unroll
            for (int rr = 0; rr < 2; ++rr)
#pragma unroll
                for (int j = 0; j < 4; ++j) xn[rr][j] = *((const u32x2*)(X1 + (size_t)(row0 + F.wave * 2 + rr) * DM) + F.lane + 64 * j);
            for (int step = 0; step < 4; ++step) {
                u32x2 xc[2][4];
#pragma unroll
                for (int rr = 0; rr < 2; ++rr)
#pragma unroll
                    for (int j = 0; j < 4; ++j) xc[rr][j] = xn[rr][j];
                if (step < 3) {
#pragma unroll
                    for (int rr = 0; rr < 2; ++rr)
#pragma unroll
                        for (int j = 0; j < 4; ++j) xn[rr][j] = *((const u32x2*)(X1 + (size_t)(row0 + (step + 1) * 16 + F.wave * 2 + rr) * DM) + F.lane + 64 * j);
                }
#pragma unroll
                for (int rr = 0; rr < 2; ++rr) {
                    const int rl = F.wave * 2 + rr, m = row0 + step * 16 + rl;
                    f32x4 v[4]; float ssum = 0.f;
#pragma unroll
                    for (int j = 0; j < 4; ++j) { const u32x2 w_ = xc[rr][j]; v[j] = (f32x4){bflo(w_.x), bfhi(w_.x), bflo(w_.y), bfhi(w_.y)}; ssum += (v[j].x * v[j].x + v[j].y * v[j].y) + (v[j].z * v[j].z + v[j].w * v[j].w); }
                    ssum = wave_sum(ssum); const float rs = rsqrtf(ssum * (1.0f / DM) + EPS);
                    unsigned* o8 = (unsigned*)(H2 + (size_t)m * DM) + F.lane;
#pragma unroll
                    for (int j = 0; j < 4; ++j) { const f32x4 hv = v[j] * rs * gff[j];
                        o8[64 * j] = pk4_fp8(hv.x, hv.y, hv.z, hv.w);
                        *(LAS f32x4*)(hs + rl * HP + 4 * F.lane + 256 * j) = hv; }
                }
                __syncthreads();
                {
                    const LAS float* ha = hs + (F.lane & 15) * HP + F.wave * 128 + 8 * (F.lane >> 4);
                    f32x4 c0 = {0.f, 0.f, 0.f, 0.f}, c1 = {0.f, 0.f, 0.f, 0.f};
#pragma unroll
                    for (int s_ = 0; s_ < 4; ++s_) { const f32x4 x0 = *(const LAS f32x4*)(ha + 32 * s_), x1 = *(const LAS f32x4*)(ha + 32 * s_ + 4);
                        u32x4 ah, al; SPLIT2(x0[0], x0[1], ah.x, al.x); SPLIT2(x0[2], x0[3], ah.y, al.y); SPLIT2(x1[0], x1[1], ah.z, al.z); SPLIT2(x1[2], x1[3], ah.w, al.w);
                        const bf16x8 ah8 = __builtin_bit_cast(bf16x8, ah), al8 = __builtin_bit_cast(bf16x8, al);
                        c0 = __builtin_amdgcn_mfma_f32_16x16x32_bf16(al8, __builtin_bit_cast(bf16x8, whi[s_][0]), c0, 0, 0, 0);
                        c1 = __builtin_amdgcn_mfma_f32_16x16x32_bf16(al8, __builtin_bit_cast(bf16x8, whi[s_][1]), c1, 0, 0, 0);
                        c0 = __builtin_amdgcn_mfma_f32_16x16x32_bf16(ah8, __builtin_bit_cast(bf16x8, wlo[s_][0]), c0, 0, 0, 0);
                        c1 = __builtin_amdgcn_mfma_f32_16x16x32_bf16(ah8, __builtin_bit_cast(bf16x8, wlo[s_][1]), c1, 0, 0, 0);
                        c0 = __builtin_amdgcn_mfma_f32_16x16x32_bf16(ah8, __builtin_bit_cast(bf16x8, whi[s_][0]), c0, 0, 0, 0);
                        c1 = __builtin_amdgcn_mfma_f32_16x16x32_bf16(ah8, __builtin_bit_cast(bf16x8, whi[s_][1]), c1, 0, 0, 0); }
                    LAS float* pw_ = part + (F.wave * 16 + 4 * (F.lane >> 4)) * 32 + (F.lane & 15);
#pragma unroll
                    for (int r = 0; r < 4; ++r) { pw_[r * 32] = c0[r]; pw_[r * 32 + 16] = c1[r]; }
                }
                __syncthreads();
                {
                    const int rl = F.wave * 2 + kh;
                    float cur = be;
#pragma unroll
                    for (int w = 0; w < 8; ++w) cur += part[(w * 16 + rl) * 32 + e];
                    float tv[4]; int ti[4];
#pragma unroll
                    for (int kk = 0; kk < 4; ++kk) {
                        const float bv = swap16_max(row_max16(cur));
                        const unsigned long long bm = __ballot(cur == bv);
                        const int bi = __builtin_ctz(kh ? (unsigned)(bm >> 32) : (unsigned)bm);
                        tv[kk] = bv; ti[kk] = bi; if (e == bi) cur = -INFINITY;
                    }
                    const float e1 = __expf(tv[1] - tv[0]), e2 = __expf(tv[2] - tv[0]), e3 = __expf(tv[3] - tv[0]);
                    const float inv = 1.0f / (1.0f + e1 + e2 + e3);
                    if (e < 4) {
                        const int kk = e; const int ex = kk == 0 ? ti[0] : kk == 1 ? ti[1] : kk == 2 ? ti[2] : ti[3];
                        const float gx = (kk == 0 ? 1.0f : kk == 1 ? e1 : kk == 2 ? e2 : e3) * inv;
                        const int a = (step * 16 + rl) * 4 + kk;
                        const int rank = __hip_atomic_fetch_add((LAS int*)&lcnt[ex], 1, __ATOMIC_RELAXED, __HIP_MEMORY_SCOPE_WORKGROUP);
                        sele[a] = ex; selr[a] = rank; selg[a] = gx;
                    }
                }
            }
            __syncthreads();
            if (F.tid < 32) lbase[F.tid] = (int)xb_add(ctl + CW_ECNT + F.tid, (unsigned)lcnt[F.tid]);
            __syncthreads();
            if (F.tid < 256) { const int a = F.tid; const int ex = sele[a]; const int pos = lbase[ex] + selr[a]; const int slot = (row0 + (a >> 2)) * 4 + (a & 3);
                u32x2 pr; pr.x = (unsigned)slot; pr.y = __float_as_uint(selg[a]); LIST2[ex * MTOK + pos] = pr; }
            __syncthreads();
        }
        if (BOTH(5)) GRID_BAR_WD(4);
    }

    if (IN(6) || IN(7)) {
        REFRESH_ID();
        if (F.wave == 0) {
            const int e_ = F.lane & 31; const int c = (int)xb_ld(ctl + CW_ECNT + e_); const int tiles_ = (c + 255) >> 8;
            LAS int* tl = (LAS int*)(F.lds + LDSCTL_OFF) + L_LCNT;
            if (F.lane < 32) { LCTL[L_CNT + e_] = (unsigned)c; tl[e_] = tiles_; }
            asm volatile("s_waitcnt lgkmcnt(0)" ::: "memory");
            int pre_ = 0;
#pragma unroll
            for (int i = 0; i < NEXP; ++i) { const int t_ = tl[i]; pre_ += (i < e_) ? t_ : 0; }
            if (F.lane < 32) LCTL[L_PRE + e_] = (unsigned)pre_;
            if (F.lane == 31) LCTL[L_PRE + NEXP] = (unsigned)(pre_ + tiles_);
        }
        __syncthreads();
    }
    const LAS int* Lpre = (const LAS int*)(F.lds + LDSCTL_OFF) + L_PRE; const LAS int* Lcnt = (const LAS int*)(F.lds + LDSCTL_OFF) + L_CNT;

    if (IN(6)) {
        pg8::MoeOrder S; S.init(Lpre, Lcnt, LIST2, 2 * DFF / 256, F.G, F.vcu);
        EpiSwiglu E{b_gate_up, ACT};
        for (int rep_ = 0; rep_ < NREP(6); ++rep_)
        pg8::gemm_phase<EpiSwiglu, pg8::MoeOrder, true, true, true, true>(F.lds + RING_OFF, H2, WGU, DM, 2 * DFF / 256, S, E, F.wave);
        {
            REFRESH_ID();
            const int U = (int)Lpre[NEXP] * (2 * DFF / 256), cpx_ = S.cpx, nx_ = F.G / cpx_, x_ = F.vcu / cpx_;
            int n_early = 0, my_idx = -1;
            for (int g = 0; g < nx_; ++g) { const int ug = (int)((long)U * (g + 1) / nx_) - (int)((long)U * g / nx_), rem = ug % cpx_, eg = rem ? cpx_ - rem : 0;
                if (g == x_ && rem && S.j >= rem) my_idx = n_early + (S.j - rem);
                n_early += eg; }
            int fgw = -1, fngw = 0;
            if (n_early < F.G / 6) { fgw = F.vcu * 8 + F.wave; fngw = F.G * 8; }
            else if (my_idx >= 0) { fgw = my_idx * 8 + F.wave; fngw = n_early * 8; }
            if (fgw >= 0) {
                LAS float* scr = (LAS float*)(F.lds + RING_OFF + F.wave * 16384);
                W8Task T{w_down, WD, DFF, DM, NEXP, 32.0f, nullptr, 0, 1};
                for (int rep_ = 0; rep_ < NREP(6); ++rep_) p0_w8_run<false>(F, T, scr, MapId(), fgw, fngw, WD_ITEMS, WD_P0);
            }
        }
        if (BOTH(6)) GRID_BAR();
    }

    if (IN(7)) {
        pg8::MoeOrder S; S.init(Lpre, Lcnt, LIST2, DM / 256, F.G, F.vcu);
        EpiDown E{b_down, LIST2, Lcnt, YB};
        for (int rep_ = 0; rep_ < NREP(7); ++rep_)
        pg8::gemm_phase<EpiDown, pg8::MoeOrder, true, true, false, true>(F.lds + RING_OFF, ACT, WD, DFF, DM / 256, S, E, F.wave);
        if (BOTH(7)) GRID_BAR();
    }

    if (IN(8)) {
        const int lane8 = (int)__builtin_amdgcn_mbcnt_hi(~0u, __builtin_amdgcn_mbcnt_lo(~0u, 0u));
        f32x4 gfin[4];
#pragma unroll
        for (int j = 0; j < 4; ++j) gfin[j] = *((const f32x4*)g_final + lane8 + 64 * j);
        for (int rep_ = 0; rep_ < NREP(8); ++rep_)
        for (int m = gw; m < MTOK; m += NGW) {
            const u32x2* xin = (const u32x2*)(X1 + (size_t)m * DM) + lane8;
            f32x4* xr = (f32x4*)(out + (size_t)m * DM) + lane8;
            f32x4 v[4];
#pragma unroll
            for (int j = 0; j < 4; ++j) { const u32x2 w_ = xin[64 * j]; v[j] = (f32x4){bflo(w_.x), bfhi(w_.x), bflo(w_.y), bfhi(w_.y)}; }
#pragma unroll
            for (int k = 0; k < 4; ++k) { const unsigned* yr = (const unsigned*)(YB + ((size_t)m * 4 + k) * DM) + lane8;
#pragma unroll
                for (int j = 0; j < 4; ++j) { const int w = (int)yr[64 * j]; const f32x2 lo_ = __builtin_amdgcn_cvt_pk_f32_fp8(w, false), hi_ = __builtin_amdgcn_cvt_pk_f32_fp8(w, true);
                    v[j].x += 0.25f * lo_.x; v[j].y += 0.25f * lo_.y; v[j].z += 0.25f * hi_.x; v[j].w += 0.25f * hi_.y; } }
            float s = 0.f;
#pragma unroll
            for (int j = 0; j < 4; ++j) s += (v[j].x * v[j].x + v[j].y * v[j].y) + (v[j].z * v[j].z + v[j].w * v[j].w);
            s = wave_sum(s); const float rs = rsqrtf(s * (1.0f / DM) + EPS);
#pragma unroll
            for (int j = 0; j < 4; ++j) xr[64 * j] = v[j] * rs * gfin[j];
        }
    }
#undef IN
#undef BOTH
#undef GRID_BAR
#undef x_in
#undef g_mix
#undef w_in
#undef qa_norm
#undef ka_norm
#undef sink_b
#undef w_br_a
#undef w_br_b
#undef w_out
#undef g_ffn
#undef w_router
#undef b_router
#undef w_gate_up
#undef b_gate_up
#undef w_down
#undef b_down
#undef g_final
}

extern "C" void kernel_launch(void* const* d_in, const int* in_sizes, int n_in, void* d_out, int out_size, void* d_ws, size_t ws_size, hipStream_t stream) {
    static int grid = 0;
    if (grid == 0) {
        if (n_in != 17 || out_size != MTOK * DM || ws_size < WS_END) { fprintf(stderr, "kernel_launch: unexpected problem shape (n_in %d out %d ws %zu)\n", n_in, out_size, ws_size); grid = -1; return; }
        int dev = 0, cus = 0;
        if (hipGetDevice(&dev) != hipSuccess || hipDeviceGetAttribute(&cus, hipDeviceAttributeMultiprocessorCount, dev) != hipSuccess) { grid = -1; return; }
        if (hipFuncSetAttribute((const void*)fwd_kernel, hipFuncAttributeMaxDynamicSharedMemorySize, LDS_BYTES) != hipSuccess) { fprintf(stderr, "kernel_launch: hipFuncSetAttribute failed\n"); grid = -1; return; }
        int per_cu = 0;
        if (hipOccupancyMaxActiveBlocksPerMultiprocessor(&per_cu, (const void*)fwd_kernel, 512, LDS_BYTES) != hipSuccess || per_cu < 1) { fprintf(stderr, "kernel_launch: occupancy query says %d\n", per_cu); }
        (void)hipGetLastError();
        grid = cus;
    }
    if (grid < 0) return;
    (void)hipMemsetAsync((char*)d_ws + WS_CTL, 0, CTL_ZERO_BYTES, stream);
    Args a{};
    for (int i = 0; i < 17; ++i) a.in[i] = (const float*)d_in[i];
    a.out = (float*)d_out; a.ws = (unsigned char*)d_ws;
    if (N_LAUNCHES == 1) {
        a.ph_lo = 0; a.ph_hi = NPHASE; a.li = 0;
        hipLaunchKernelGGL(fwd_kernel, dim3(grid), dim3(512), LDS_BYTES, stream, a);
#if defined(PROBE_PHASE)
        a.ph_lo = PROBE_PHASE; a.ph_hi = PROBE_PHASE + 1; a.li = 1;
        hipLaunchKernelGGL(fwd_kernel, dim3(grid), dim3(512), LDS_BYTES, stream, a);
#endif
    } else {
        for (int li = 0; li < NPHASE; ++li) { a.ph_lo = li; a.ph_hi = li + 1; a.li = li; hipLaunchKernelGGL(fwd_kernel, dim3(grid), dim3(512), LDS_BYTES, stream, a); }
    }
}
```
